# Optimizing an MI355X kernel written in HIP

```python
import jax, jax.numpy as jnp
from jax import lax
import numpy as np

D_MODEL = 1024
BATCH = 4
SEQ = 8192
DEPTH = 2

N_POOL_LAYERS = DEPTH // 2
N_ATTN_LAYERS = DEPTH - N_POOL_LAYERS

POOL_WINDOWS = (2, 4, 8, 16)
N_POOL_GROUPS = len(POOL_WINDOWS)
POOL_GROUP_WIDTH = D_MODEL // N_POOL_GROUPS

HEAD_DIM = 64
N_HEADS = D_MODEL // HEAD_DIM
Q_BLOCK = 128
ATTN_SCALE = HEAD_DIM ** -0.5
NEG_BIG = -1e30

N_GROUPS = 4
EXPERTS_PER_GROUP = 4
N_EXPERTS = N_GROUPS * EXPERTS_PER_GROUP
TOP_K = 2
D_EXPERT = D_MODEL // 4

EPS = 1e-6

kernel_name = "yoco_pool_fox_hmoe_trunk"


def rmsnorm(x, g):
    xf = x.astype(jnp.float32)
    inv = lax.rsqrt(jnp.mean(xf * xf, axis=-1, keepdims=True) + EPS)
    return (xf * inv * g.astype(jnp.float32)).astype(x.dtype)


def pool_mixer(xn, w_pool, scale):
    B, S, D = xn.shape
    xg = xn.astype(jnp.float32).reshape(B, S, N_POOL_GROUPS, POOL_GROUP_WIDTH)
    cs = jnp.cumsum(xg, axis=1)
    pos1 = jnp.arange(1, S + 1)
    outs = []
    for g, w in enumerate(POOL_WINDOWS):
        c = cs[:, :, g]
        lag = jnp.pad(c, ((0, 0), (w, 0), (0, 0)))[:, :S]
        cnt = jnp.minimum(pos1, w).astype(jnp.float32)[None, :, None]
        outs.append((c - lag) / cnt)
    pooled = jnp.stack(outs, axis=2)
    diff = (pooled - xg).astype(xn.dtype)
    y = jnp.einsum('bsgc,gcd->bsgd', diff, w_pool).reshape(B, S, D)
    return y * scale


def shared_kv(h, kv_norm, w_k, w_v, w_f, b_f):
    B, S, _ = h.shape
    hn = rmsnorm(h, kv_norm)
    k = (hn @ w_k).reshape(B, S, N_HEADS, HEAD_DIM).transpose(0, 2, 1, 3)
    v = (hn @ w_v).reshape(B, S, N_HEADS, HEAD_DIM).transpose(0, 2, 1, 3)
    log_f = jax.nn.log_sigmoid((hn @ w_f).astype(jnp.float32) + b_f.astype(jnp.float32))
    F = jnp.cumsum(log_f, axis=1).transpose(0, 2, 1)
    return k, v, F


def forgetting_attention(xn, w_q, w_o, k, v, F):
    B, S, _ = xn.shape
    n_blk = S // Q_BLOCK
    q = (xn @ w_q).reshape(B, S, N_HEADS, HEAD_DIM).transpose(0, 2, 1, 3)
    q_blocks = q.reshape(B, N_HEADS, n_blk, Q_BLOCK, HEAD_DIM).transpose(2, 0, 1, 3, 4)
    F_blocks = F.reshape(B, N_HEADS, n_blk, Q_BLOCK).transpose(2, 0, 1, 3)
    k_pos = jnp.arange(S)

    def one_block(args):
        i, qb, Fb = args
        s = jnp.einsum('bhqd,bhkd->bhqk', qb, k).astype(jnp.float32) * ATTN_SCALE
        s = s + Fb[..., None] - F[:, :, None, :]
        q_pos = i * Q_BLOCK + jnp.arange(Q_BLOCK)
        mask = k_pos[None, :] <= q_pos[:, None]
        s = jnp.where(mask, s, NEG_BIG)
        p = jax.nn.softmax(s, axis=-1).astype(v.dtype)
        return jnp.einsum('bhqk,bhkd->bhqd', p, v)

    o = lax.map(one_block, (jnp.arange(n_blk), q_blocks, F_blocks))
    o = o.transpose(1, 0, 3, 2, 4).reshape(B, S, N_HEADS * HEAD_DIM)
    return o @ w_o


def hierarchical_moe(xn, wg, bg, we, be, w_gate, w_up, w_down):
    B, S, D = xn.shape
    N = B * S
    t = xn.reshape(N, D)
    g_logits = (t @ wg).astype(jnp.float32) + bg.astype(jnp.float32)
    g_prob = jax.nn.softmax(g_logits, axis=-1)
    g_idx = jnp.argmax(g_logits, axis=-1)
    g_w = jnp.take_along_axis(g_prob, g_idx[:, None], axis=1)
    e_logits = ((t @ we).astype(jnp.float32) + be.astype(jnp.float32)).reshape(N, N_GROUPS, EXPERTS_PER_GROUP)
    e_sel = jnp.take_along_axis(e_logits, g_idx[:, None, None], axis=1)[:, 0]
    top_v, top_i = lax.top_k(e_sel, TOP_K)
    top_w = jax.nn.softmax(top_v, axis=-1) * g_w
    expert_id = g_idx[:, None] * EXPERTS_PER_GROUP + top_i
    gates = jnp.sum(jax.nn.one_hot(expert_id, N_EXPERTS, dtype=jnp.float32) * top_w[..., None], axis=1)
    hg = jnp.einsum('nd,edf->nef', t, w_gate)
    hu = jnp.einsum('nd,edf->nef', t, w_up)
    h = jax.nn.silu(hg) * hu * gates[:, :, None].astype(hu.dtype)
    y = h.reshape(N, N_EXPERTS * D_EXPERT) @ w_down.reshape(N_EXPERTS * D_EXPERT, D)
    return y.reshape(B, S, D)


def setup_inputs(seed: int = 0) -> dict:
    key = jax.random.key(seed)
    ks = jax.random.split(key, 21)
    f32 = jnp.float32
    D = D_MODEL
    HD_ALL = N_HEADS * HEAD_DIM
    GW = POOL_GROUP_WIDTH

    def nrm(k, shape, fan_in):
        return jax.random.normal(k, shape, f32) * fan_in ** -0.5

    def gain(k, shape):
        return 1.0 + 0.02 * jax.random.normal(k, shape, f32)

    return {
        "x": jax.random.normal(ks[0], (BATCH, SEQ, D), f32),
        "mix_norm": gain(ks[1], (DEPTH, D)),
        "ffn_norm": gain(ks[2], (DEPTH, D)),
        "pool_w": nrm(ks[3], (N_POOL_LAYERS, N_POOL_GROUPS, GW, GW), GW),
        "pool_scale": 0.5 + 0.05 * jax.random.normal(ks[4], (N_POOL_LAYERS, D), f32),
        "kv_norm": gain(ks[5], (D,)),
        "w_k": nrm(ks[6], (D, HD_ALL), D),
        "w_v": nrm(ks[7], (D, HD_ALL), D),
        "w_f": nrm(ks[8], (D, N_HEADS), D),
        "b_f": 2.0 + 0.5 * jax.random.normal(ks[9], (N_HEADS,), f32),
        "w_q": nrm(ks[10], (N_ATTN_LAYERS, D, HD_ALL), D),
        "w_o": nrm(ks[11], (N_ATTN_LAYERS, HD_ALL, D), HD_ALL),
        "router_g": nrm(ks[12], (DEPTH, D, N_GROUPS), D),
        "router_g_b": 0.01 * jax.random.normal(ks[13], (DEPTH, N_GROUPS), f32),
        "router_e": nrm(ks[14], (DEPTH, D, N_EXPERTS), D),
        "router_e_b": 0.01 * jax.random.normal(ks[15], (DEPTH, N_EXPERTS), f32),
        "w_gate": nrm(ks[16], (DEPTH, N_EXPERTS, D, D_EXPERT), D),
        "w_up": nrm(ks[17], (DEPTH, N_EXPERTS, D, D_EXPERT), D),
        "w_down": nrm(ks[18], (DEPTH, N_EXPERTS, D_EXPERT, D), D_EXPERT),
        "final_norm": gain(ks[19], (D,)),
    }


def reference(x, mix_norm, ffn_norm, pool_w, pool_scale, kv_norm, w_k, w_v, w_f, b_f,
              w_q, w_o, router_g, router_g_b, router_e, router_e_b,
              w_gate, w_up, w_down, final_norm):
    h = x
    k = v = F = None
    for layer in range(DEPTH):
        if layer == N_POOL_LAYERS:
            k, v, F = shared_kv(h, kv_norm, w_k, w_v, w_f, b_f)
        hn = rmsnorm(h, mix_norm[layer])
        if layer < N_POOL_LAYERS:
            h = h + pool_mixer(hn, pool_w[layer], pool_scale[layer])
        else:
            j = layer - N_POOL_LAYERS
            h = h + forgetting_attention(hn, w_q[j], w_o[j], k, v, F)
        hn = rmsnorm(h, ffn_norm[layer])
        h = h + hierarchical_moe(hn, router_g[layer], router_g_b[layer], router_e[layer],
                                 router_e_b[layer], w_gate[layer], w_up[layer], w_down[layer])
    return rmsnorm(h, final_norm)
```

```cpp
#include <hip/hip_runtime.h>
#include <hip/hip_bf16.h>
#include <cstdio>
#include <cstdint>
#include <cmath>
namespace pg8 {
#define PG8_LAS __attribute__((address_space(3)))
typedef unsigned short bf16_t;
typedef short bf16x8 __attribute__((ext_vector_type(8)));
typedef float f32x4 __attribute__((ext_vector_type(4)));
typedef unsigned u32x4 __attribute__((ext_vector_type(4)));
constexpr int BM = 256, BK = 64, HALF = 128, HTB = HALF * BK * 2  , STAGE_BYTES = 8 * HTB, NXCD = 8, WGM = 8;

__host__ __device__ __forceinline__ int lds_byte(int r, int c) { const int st = (r >> 4) * 2 + (c >> 5), rr = r & 15, cc = c & 31, ob = rr * 64 + cc * 2; return st * 1024 + (ob ^ (((ob >> 9) & 1) << 5)); }
__host__ __device__ __forceinline__ void stage_rc(int b, int& R, int& C) { const int st = b / 1024, sb = b % 1024, swz = sb ^ (((sb >> 9) & 1) << 5); R = (st >> 1) * 16 + swz / 64; C = (st & 1) * 32 + (swz % 64) / 2; }
__host__ __device__ __forceinline__ int perm32(int rho) { const int n = rho >> 4, i = rho & 15; return 8 * (i >> 2) + 4 * n + (i & 3); }

struct Unit { int pm, pn, x0, x1, x2; };

struct StaticOrder {
    int nM, nN, nwg, G, c, nx;
    __device__ __forceinline__ void init(int M, int N, int G_, int c_, int nx_) { nM = M / BM; nN = N / BM; nwg = nM * nN; G = G_; c = c_; nx = nx_; }
    __device__ __forceinline__ bool next(int i, Unit& u) const {
        const long L = (long)i * G + c; if (L >= nwg) return false;
        int wgid = (int)L; { const int q = nwg / nx, r = nwg % nx, xcd = wgid % nx, off = wgid / nx; wgid = (xcd < r ? xcd * (q + 1) : r * (q + 1) + (xcd - r) * q) + off; }
        const int nig = WGM * nN, gid = wgid / nig, fm = gid * WGM, gsz = (nM - fm) < WGM ? (nM - fm) : WGM;
        u.pm = fm + ((wgid % nig) % gsz); u.pn = (wgid % nig) / gsz; u.x0 = 0; u.x1 = 0; u.x2 = 0; return true;
    }
};
struct MoeOrder {
    const PG8_LAS int* tbl; int G, c;
    __device__ __forceinline__ bool next(int i, Unit& u) const {
        const int L = i * G + c; const int ntl = __builtin_amdgcn_readfirstlane(tbl[0]);
        if (L >= ntl * 4) return false;
        const int rt = L >> 2; u.pm = rt; u.pn = L & 3; u.x0 = __builtin_amdgcn_readfirstlane(tbl[1 + 3 * rt]); u.x1 = __builtin_amdgcn_readfirstlane(tbl[2 + 3 * rt]); u.x2 = __builtin_amdgcn_readfirstlane(tbl[3 + 3 * rt]); return true;
    }
};

struct AdRow {
    static constexpr bool GATHER = false;
    const char* abase; const char* bbase; int lda, ldb, acolpn;
    __device__ __forceinline__ const char* a_ptr(const Unit& u, int h, int kt) const { return abase + ((size_t)(u.pm * BM + h * HALF) * lda + u.pn * acolpn) * 2 + (size_t)kt * (BK * 2); }
    __device__ __forceinline__ void a_offs(const Unit&, const int (&)[2], const int (&)[2], unsigned (&)[2][2]) const {}
    __device__ __forceinline__ const char* b_ptr(const Unit& u, int h, int kt) const { return bbase + (size_t)(u.pn * BM + h * HALF) * ldb * 2 + (size_t)kt * (BK * 2); }
};
struct AdMoeUp {
    static constexpr bool GATHER = true;
    const char* abase; const int* tokrow; const char* wg; const char* wu; int lda, ldb;
    __device__ __forceinline__ const char* a_ptr(const Unit&, int, int kt) const { return abase + (size_t)kt * (BK * 2); }
    __device__ __forceinline__ void a_offs(const Unit& u, const int (&R)[2], const int (&C)[2], unsigned (&v)[2][2]) const {
#pragma unroll
        for (int h = 0; h < 2; ++h)
#pragma unroll
            for (int i = 0; i < 2; ++i) { const int rl = h * HALF + R[i]; const int tok = rl < u.x1 ? tokrow[u.x2 + rl] : 0; v[h][i] = (unsigned)(tok * 1024 + C[i]) * 2u; }
    }
    __device__ __forceinline__ const char* b_ptr(const Unit& u, int h, int kt) const {
        const int e = (u.pn >> 1) ? ((u.x0 >> 8) & 0xff) : (u.x0 & 0xff);
        return (h ? wu : wg) + (size_t)(e * 256 + (u.pn & 1) * HALF) * 1024 * 2 + (size_t)kt * (BK * 2);
    }
};
struct AdMoeDown {
    static constexpr bool GATHER = false;
    const char* abase; const char* wd; int lda, ldb;
    __device__ __forceinline__ const char* a_ptr(const Unit& u, int h, int kt) const { return abase + (size_t)(u.pm * BM + h * HALF) * 512 * 2 + (size_t)kt * (BK * 2); }
    __device__ __forceinline__ void a_offs(const Unit&, const int (&)[2], const int (&)[2], unsigned (&)[2][2]) const {}
    __device__ __forceinline__ const char* b_ptr(const Unit& u, int h, int kt) const {
        const int e = (kt >> 2) ? ((u.x0 >> 8) & 0xff) : (u.x0 & 0xff);
        return wd + (size_t)(e * 1024 + u.pn * BM + h * HALF) * 256 * 2 + (size_t)(kt & 3) * (BK * 2);
    }
};

__device__ __forceinline__ unsigned cvt_pk_bf16(float lo, float hi) { unsigned r; asm volatile("v_cvt_pk_bf16_f32 %0, %1, %2" : "=v"(r) : "v"(lo), "v"(hi)); return r; }

struct EpiBf16 {
    static constexpr bool PERM = true;
    bf16_t* O; int ldc; int split_cols; size_t split_stride; float scale0; unsigned* nq; unsigned* nk;
    __device__ __forceinline__ void operator()(const f32x4 (&acc)[2][2][4][2], const Unit& u, int wr, int wc, int fr, int fq) const {
        const int row0 = u.pm * BM + wr * 64 + fr; int colt = u.pn * BM; bf16_t* base = O; int t = 0;
        float sc = 1.f; if (split_cols) { t = colt / split_cols; base += (size_t)t * split_stride; colt -= t * split_cols; if (t == 0) sc = scale0; }
        const int col0 = colt + wc * 32 + 8 * fq;
#pragma unroll
        for (int ai = 0; ai < 2; ++ai)
#pragma unroll
            for (int m = 0; m < 4; ++m) { bf16_t* rowp = base + (size_t)(row0 + ai * HALF + m * 16) * ldc + col0;
#pragma unroll
                for (int bj = 0; bj < 2; ++bj) { f32x4 v0 = acc[ai][bj][m][0] * sc, v1 = acc[ai][bj][m][1] * sc;
                    u32x4 w; w.x = cvt_pk_bf16(v0[0], v0[1]); w.y = cvt_pk_bf16(v0[2], v0[3]); w.z = cvt_pk_bf16(v1[0], v1[1]); w.w = cvt_pk_bf16(v1[2], v1[3]);
                    *(u32x4*)(rowp + bj * HALF) = w; } }
        if (nq && t < 2) {
#pragma unroll
            for (int bj = 0; bj < 2; ++bj) { float mx = 0.f;
#pragma unroll
                for (int ai = 0; ai < 2; ++ai)
#pragma unroll
                    for (int m = 0; m < 4; ++m) { const f32x4 v0 = acc[ai][bj][m][0] * sc, v1 = acc[ai][bj][m][1] * sc;
                        float s = (v0[0] * v0[0] + v0[1] * v0[1]) + (v0[2] * v0[2] + v0[3] * v0[3]) + (v1[0] * v1[0] + v1[1] * v1[1]) + (v1[2] * v1[2] + v1[3] * v1[3]);
                        s += __shfl_xor(s, 16); s += __shfl_xor(s, 32); mx = fmaxf(mx, s); }
                mx = fmaxf(mx, __shfl_xor(mx, 1)); mx = fmaxf(mx, __shfl_xor(mx, 2)); mx = fmaxf(mx, __shfl_xor(mx, 4)); mx = fmaxf(mx, __shfl_xor(mx, 8));
                if (fr == 0 && fq == 0) { const int head = (colt >> 8) * 4 + 2 * bj + (wc >> 1), half = wc & 1;
                    unsigned* p = t == 0 ? nq + ((u.pm * 16 + head) * 2 + half) : nk + (((u.pm >> 5) * 16 + head) * 2 + half);
                    __hip_atomic_fetch_max(p, __float_as_uint(mx), __ATOMIC_RELAXED, __HIP_MEMORY_SCOPE_AGENT); } }
        }
    }
};
struct EpiResF32 {
    static constexpr bool PERM = false;
    const float* base; float* out; int ldc;
    __device__ __forceinline__ void operator()(const f32x4 (&acc)[2][2][4][2], const Unit& u, int wr, int wc, int fr, int fq) const {
        const size_t off0 = (size_t)(u.pm * BM + wr * 64 + fr) * ldc + u.pn * BM + wc * 32 + 4 * fq;
        f32x4 buf[3][4];
#define PG8_RES_LOAD(g) do { const size_t o_ = off0 + (size_t)(((g) >> 2) * HALF + ((g) & 3) * 16) * ldc; _Pragma("unroll") for (int q_ = 0; q_ < 4; ++q_) buf[(g) % 3][q_] = *(const f32x4*)(base + o_ + (q_ >> 1) * HALF + (q_ & 1) * 16); } while (0)
        PG8_RES_LOAD(0); PG8_RES_LOAD(1);
#pragma unroll
        for (int g = 0; g < 8; ++g) {
            if (g + 2 < 8) PG8_RES_LOAD(g + 2);
            const size_t o = off0 + (size_t)((g >> 2) * HALF + (g & 3) * 16) * ldc;
#pragma unroll
            for (int q = 0; q < 4; ++q) *(f32x4*)(out + o + (q >> 1) * HALF + (q & 1) * 16) = buf[g % 3][q] + acc[g >> 2][q >> 1][g & 3][q & 1];
            asm volatile("" ::: "memory");
        }
#undef PG8_RES_LOAD
    }
};
__device__ __forceinline__ float silu_mul(float g, float u) { return g * u * __builtin_amdgcn_rcpf(1.0f + __builtin_amdgcn_exp2f(-1.4426950408889634f * g)); }
struct EpiMoeH {
    static constexpr bool PERM = true;
    bf16_t* H; const float* gaterow;
    __device__ __forceinline__ void operator()(const f32x4 (&acc)[2][2][4][2], const Unit& u, int wr, int wc, int fr, int fq) const {
        const int half = u.pn >> 1, col0 = half * 256 + (u.pn & 1) * HALF + wc * 32 + 8 * fq;
#pragma unroll
        for (int ai = 0; ai < 2; ++ai)
#pragma unroll
            for (int m = 0; m < 4; ++m) { const int rl = ai * HALF + wr * 64 + m * 16 + fr, row = u.pm * BM + rl; const float gw = rl < u.x1 ? gaterow[(size_t)(u.x2 + rl) * 2 + half] : 0.f;
                const f32x4 g0 = acc[ai][0][m][0], g1 = acc[ai][0][m][1], u0 = acc[ai][1][m][0], u1 = acc[ai][1][m][1];
                u32x4 w; w.x = cvt_pk_bf16(silu_mul(g0[0], u0[0]) * gw, silu_mul(g0[1], u0[1]) * gw); w.y = cvt_pk_bf16(silu_mul(g0[2], u0[2]) * gw, silu_mul(g0[3], u0[3]) * gw);
                w.z = cvt_pk_bf16(silu_mul(g1[0], u1[0]) * gw, silu_mul(g1[1], u1[1]) * gw); w.w = cvt_pk_bf16(silu_mul(g1[2], u1[2]) * gw, silu_mul(g1[3], u1[3]) * gw);
                *(u32x4*)(H + (size_t)row * 512 + col0) = w; }
    }
};
struct EpiMoeOutBf16 {
    static constexpr bool PERM = true;
    bf16_t* Y; const int* tokrow; bf16_t* trash;
    __device__ __forceinline__ void operator()(const f32x4 (&acc)[2][2][4][2], const Unit& u, int wr, int wc, int fr, int fq) const {
        const int col0 = u.pn * BM + wc * 32 + 8 * fq, nvalid = u.x1;
#pragma unroll
        for (int ai = 0; ai < 2; ++ai)
#pragma unroll
            for (int m = 0; m < 4; ++m) { const int rl = ai * HALF + wr * 64 + m * 16 + fr; const int tok = rl < nvalid ? tokrow[u.x2 + rl] : 0;
                bf16_t* rowp = (rl < nvalid ? Y + (size_t)tok * 1024 : trash) + col0;
#pragma unroll
                for (int bj = 0; bj < 2; ++bj) { const f32x4 v0 = acc[ai][bj][m][0], v1 = acc[ai][bj][m][1];
                    u32x4 w; w.x = cvt_pk_bf16(v0[0], v0[1]); w.y = cvt_pk_bf16(v0[2], v0[3]); w.z = cvt_pk_bf16(v1[0], v1[1]); w.w = cvt_pk_bf16(v1[2], v1[3]);
                    *(u32x4*)(rowp + bj * HALF) = w; } }
    }
};

template <class Epi, class Sched, class AD, bool ALIGN_EPI>
__device__ __forceinline__ void gemm_phase(PG8_LAS unsigned char* lds, const int nt, const Sched& S, const Epi& E, const AD& ad) {
    int tid = threadIdx.x; asm volatile("" : "+v"(tid));
    const int wid = __builtin_amdgcn_readfirstlane(tid >> 6), lane = tid & 63, wr = wid >> 2, wc = wid & 3, fr = lane & 15, fq = lane >> 4;
    int Rs[2], Cs[2]; unsigned voffA[2], voffB[2];
#pragma unroll
    for (int i = 0; i < 2; ++i) { stage_rc(tid * 16 + i * 8192, Rs[i], Cs[i]); const int Rb = Epi::PERM ? ((Rs[i] & ~31) + perm32(Rs[i] & 31)) : Rs[i];
        voffA[i] = (unsigned)(Rs[i] * ad.lda + Cs[i]) * 2u; voffB[i] = (unsigned)(Rb * ad.ldb + Cs[i]) * 2u; }
    const unsigned ldsw = (unsigned)wid * 1024u;
    const int aoff = lds_byte(wr * 64 + fr, fq * 8), boff = lds_byte(wc * 32 + fr, fq * 8);
#define PG8_SA(b, h) (((b) * 2 + (h)) * HTB)
#define PG8_SB(b, h) ((4 + (b) * 2 + (h)) * HTB)
#define PG8_STAGE(bufoff, gbase, voff) do { _Pragma("unroll") for (int _i = 0; _i < 2; ++_i) \
        __builtin_amdgcn_global_load_lds((const unsigned*)((const char*)(gbase) + (voff)[_i]), (PG8_LAS unsigned*)(lds + (bufoff) + ldsw + _i * 8192), 16, 0, 0); } while (0)
#define PG8_STAGE_A(bufoff, U, h, kt, VG) do { if constexpr (AD::GATHER) PG8_STAGE(bufoff, ad.a_ptr(U, h, kt), (VG)[h]); else PG8_STAGE(bufoff, ad.a_ptr(U, h, kt), voffA); } while (0)
#define PG8_LDA(dst, b, h) do { _Pragma("unroll") for (int m = 0; m < 4; ++m) _Pragma("unroll") for (int k = 0; k < 2; ++k) dst[m][k] = *(const PG8_LAS bf16x8*)(lds + PG8_SA(b, h) + aoff + m * 2048 + k * 1024); } while (0)
#define PG8_LDB(dst, b, h) do { _Pragma("unroll") for (int n = 0; n < 2; ++n) _Pragma("unroll") for (int k = 0; k < 2; ++k) dst[n][k] = *(const PG8_LAS bf16x8*)(lds + PG8_SB(b, h) + boff + n * 2048 + k * 1024); } while (0)
#define PG8_MMA(ai, bj, At, Bt) do { __builtin_amdgcn_s_setprio(1); _Pragma("unroll") for (int m = 0; m < 4; ++m) _Pragma("unroll") for (int n = 0; n < 2; ++n) _Pragma("unroll") for (int k = 0; k < 2; ++k) \
        acc[ai][bj][m][n] = __builtin_amdgcn_mfma_f32_16x16x32_bf16(Bt[n][k], At[m][k], acc[ai][bj][m][n], 0, 0, 0); __builtin_amdgcn_s_setprio(0); } while (0)
#define PG8_WAIT_V(n) asm volatile("s_waitcnt vmcnt(" #n ")" ::: "memory")
#define PG8_WAIT_L(n) asm volatile("s_waitcnt lgkmcnt(" #n ")" ::: "memory")
#define PG8_BAR __builtin_amdgcn_s_barrier()
#define PG8_SCHED __builtin_amdgcn_sched_barrier(0)
    Unit cur, nxt; int ui = 0;
    if (!S.next(0, cur)) return;
    f32x4 acc[2][2][4][2];
#pragma unroll
    for (int a = 0; a < 2; ++a)
#pragma unroll
        for (int b = 0; b < 2; ++b)
#pragma unroll
            for (int m = 0; m < 4; ++m)
#pragma unroll
                for (int n = 0; n < 2; ++n) acc[a][b][m][n] = (f32x4){0.f, 0.f, 0.f, 0.f};
    bf16x8 At[4][2], B0[2][2], B1[2][2];
    unsigned vAc[2][2], vAn[2][2];
    ad.a_offs(cur, Rs, Cs, vAc);
    PG8_STAGE(PG8_SB(0, 0), ad.b_ptr(cur, 0, 0), voffB); PG8_STAGE(PG8_SB(0, 1), ad.b_ptr(cur, 1, 0), voffB); PG8_STAGE_A(PG8_SA(0, 0), cur, 0, 0, vAc); PG8_STAGE_A(PG8_SA(0, 1), cur, 1, 0, vAc);
    if (wr == 1) PG8_BAR;
    PG8_WAIT_V(2); PG8_BAR;
    PG8_STAGE(PG8_SB(1, 0), ad.b_ptr(cur, 0, 1), voffB); PG8_STAGE_A(PG8_SA(1, 0), cur, 0, 1, vAc); PG8_STAGE(PG8_SB(1, 1), ad.b_ptr(cur, 1, 1), voffB);
    PG8_WAIT_V(6); PG8_BAR;
    for (;;) {
        const bool has_next = S.next(ui + 1, nxt);
        if (!has_next) nxt = cur;
        if constexpr (AD::GATHER) {
            if (has_next) ad.a_offs(nxt, Rs, Cs, vAn);
            else {
#pragma unroll
                for (int h = 0; h < 2; ++h)
#pragma unroll
                    for (int i = 0; i < 2; ++i) vAn[h][i] = vAc[h][i]; } }
#pragma clang loop unroll(disable)
        for (int t = 0; t < nt; t += 2) {
            const bool last = (t == nt - 2);
            const Unit u2 = last ? nxt : cur; const int k2 = last ? 0 : t + 2, k3 = k2 + 1;
            unsigned v2[2][2];
            if constexpr (AD::GATHER) {
#pragma unroll
                for (int h = 0; h < 2; ++h)
#pragma unroll
                    for (int i = 0; i < 2; ++i) v2[h][i] = last ? vAn[h][i] : vAc[h][i]; }
            PG8_LDB(B0, 0, 0); PG8_LDB(B1, 0, 1); PG8_SCHED; PG8_LDA(At, 0, 0); PG8_STAGE_A(PG8_SA(1, 1), cur, 1, t + 1, vAc);
            PG8_WAIT_V(8); PG8_WAIT_L(0); PG8_BAR; PG8_MMA(0, 0, At, B0); PG8_MMA(0, 1, At, B1); PG8_BAR; PG8_SCHED;
            PG8_LDA(At, 0, 1); PG8_STAGE(PG8_SB(0, 0), ad.b_ptr(u2, 0, k2), voffB); PG8_STAGE(PG8_SB(0, 1), ad.b_ptr(u2, 1, k2), voffB); PG8_STAGE_A(PG8_SA(0, 0), u2, 0, k2, v2);
            PG8_WAIT_V(8); PG8_WAIT_L(0); PG8_BAR; PG8_MMA(1, 0, At, B0); PG8_MMA(1, 1, At, B1); PG8_BAR; PG8_SCHED;
            PG8_LDB(B0, 1, 0); PG8_LDB(B1, 1, 1); PG8_SCHED; PG8_LDA(At, 1, 0); PG8_STAGE_A(PG8_SA(0, 1), u2, 1, k2, v2);
            PG8_WAIT_V(8); PG8_WAIT_L(0); PG8_BAR; PG8_MMA(0, 0, At, B0); PG8_MMA(0, 1, At, B1); PG8_BAR; PG8_SCHED;
            PG8_LDA(At, 1, 1); PG8_STAGE(PG8_SB(1, 0), ad.b_ptr(u2, 0, k3), voffB); PG8_STAGE(PG8_SB(1, 1), ad.b_ptr(u2, 1, k3), voffB); PG8_STAGE_A(PG8_SA(1, 0), u2, 0, k3, v2);
            PG8_WAIT_V(8); PG8_WAIT_L(0); PG8_BAR; PG8_MMA(1, 0, At, B0); PG8_MMA(1, 1, At, B1); PG8_BAR; PG8_SCHED;
        }
        if constexpr (ALIGN_EPI) { if (wr == 0) PG8_BAR; }
        E(acc, cur, wr, wc, fr, fq);
        if (!has_next) break;
#pragma unroll
        for (int a = 0; a < 2; ++a)
#pragma unroll
            for (int b = 0; b < 2; ++b)
#pragma unroll
                for (int m = 0; m < 4; ++m)
#pragma unroll
                    for (int n = 0; n < 2; ++n) acc[a][b][m][n] = (f32x4){0.f, 0.f, 0.f, 0.f};
        cur = nxt; ++ui;
        if constexpr (AD::GATHER) {
#pragma unroll
            for (int h = 0; h < 2; ++h)
#pragma unroll
                for (int i = 0; i < 2; ++i) vAc[h][i] = vAn[h][i]; }
        if constexpr (ALIGN_EPI) { if (wr == 1) PG8_BAR; }
    }
    PG8_WAIT_V(0);
    if constexpr (!ALIGN_EPI) { if (wr == 0) PG8_BAR; }
    PG8_BAR;
#undef PG8_SA
#undef PG8_SB
#undef PG8_STAGE
#undef PG8_STAGE_A
#undef PG8_LDA
#undef PG8_LDB
#undef PG8_MMA
#undef PG8_WAIT_V
#undef PG8_WAIT_L
#undef PG8_BAR
#undef PG8_SCHED
}
}
namespace attn_body {
using bf16=__hip_bfloat16;
using bf16x8=__attribute__((ext_vector_type(8)))short;
using s16x4=__attribute__((ext_vector_type(4)))short;
using f32x16=__attribute__((ext_vector_type(16)))float;
using f32x2_t=__attribute__((ext_vector_type(2)))float;
using u32x4=__attribute__((ext_vector_type(4)))unsigned;
constexpr int BATCH=2,NHEAD=16,SEQ=8192,D=64,DM=NHEAD*D;
constexpr int NW=8,QBLK=32,QB=QBLK*NW,KVBLK=64,NQB=SEQ/QB;
constexpr int ATTN_PITCH=DM, ATTN_UNIT_ROWS=QB;
__device__ __forceinline__ int crow(int r,int hi){return (r&3)+8*(r>>2)+4*hi;}
#define SBAR() __builtin_amdgcn_sched_barrier(0)
__device__ __forceinline__ void cmask(f32x16&p0,f32x16&p1,int jb,int qrel,int hi){
  const float NEG=-INFINITY; int kb=64*jb+4*hi;
  #pragma unroll
  for(int r=0;r<16;++r){int kv=kb+(r&3)+8*(r>>2); if(kv>qrel)p0[r]=NEG; if(kv+32>qrel)p1[r]=NEG;}
}

constexpr int NSLOT=3, SLOTB=8192;
constexpr int LDS_K=0, LDS_V=NSLOT*SLOTB, LDS_WS=2*NSLOT*SLOTB, LDS_OST=LDS_WS+NW*64*4, LDS_BIAS=LDS_OST+NW*4096, LDS_TKT=LDS_BIAS+SEQ*4, LDS_BYTES=LDS_TKT+16;
constexpr float C2=0.125f*1.4426950408889634f;
__device__ __forceinline__ void glds16(const void*gsrc,unsigned lds_dst){unsigned keep;
  asm volatile("s_mov_b32 %0, m0\n\ts_mov_b32 m0, %2\n\ts_nop 0\n\tglobal_load_lds_dwordx4 %1, off\n\ts_mov_b32 m0, %0":"=&s"(keep):"v"(gsrc),"s"(lds_dst):"memory");}
__device__ __forceinline__ void glds16s(const void*sbase,unsigned voff,unsigned lds_dst){unsigned keep;
  asm volatile("s_mov_b32 %0, m0\n\ts_mov_b32 m0, %3\n\ts_nop 0\n\tglobal_load_lds_dwordx4 %1, %2\n\ts_mov_b32 m0, %0":"=&s"(keep):"v"(voff),"s"(sbase),"s"(lds_dst):"memory");}
__device__ __forceinline__ float max3f(float a,float b,float c){float r;asm("v_max3_f32 %0, %1, %2, %3":"=v"(r):"v"(a),"v"(b),"v"(c));return r;}
__device__ __forceinline__ float max2f(float a,float b){float r;asm("v_max_f32_e32 %0, %1, %2":"=v"(r):"v"(a),"v"(b));return r;}
__device__ __forceinline__ float fadd_s(float a,float b){float r;asm("v_add_f32_e32 %0, %1, %2":"=v"(r):"v"(a),"v"(b));return r;}
__device__ __forceinline__ float fsub_s(float a,float b){float r;asm("v_sub_f32_e32 %0, %1, %2":"=v"(r):"v"(a),"v"(b));return r;}
typedef float f32x2_t __attribute__((ext_vector_type(2))); typedef __bf16 bf16x2_t __attribute__((ext_vector_type(2)));
__device__ __forceinline__ unsigned cvtpk_s(float lo,float hi){f32x2_t v={lo,hi};bf16x2_t b=__builtin_convertvector(v,bf16x2_t);return __builtin_bit_cast(unsigned,b);}
#define WAIT_BAR(N) asm volatile("s_waitcnt vmcnt(" #N ") lgkmcnt(0)\n\ts_barrier":::"memory")

__device__ __forceinline__ void qkt(f32x16&p0,f32x16&p1,const char*Kslot,const bf16x8*qr,const f32x16&negm,int r32,int hi){
  const char*kb=Kslot+hi*1024+r32*16;
  #pragma unroll
  for(int d0=0;d0<4;++d0){
    const bf16x8 b0=*reinterpret_cast<const bf16x8*>(kb+d0*2048);
    const bf16x8 b1=*reinterpret_cast<const bf16x8*>(kb+d0*2048+512);
    if(d0==0){p0=__builtin_amdgcn_mfma_f32_32x32x16_bf16(b0,qr[0],negm,0,0,0);p1=__builtin_amdgcn_mfma_f32_32x32x16_bf16(b1,qr[0],negm,0,0,0);}
    else{p0=__builtin_amdgcn_mfma_f32_32x32x16_bf16(b0,qr[d0],p0,0,0,0);p1=__builtin_amdgcn_mfma_f32_32x32x16_bf16(b1,qr[d0],p1,0,0,0);}}
}
typedef __attribute__((address_space(3))) const char* lds_cptr;
typedef short v4i16_t __attribute__((ext_vector_type(4)));
__device__ __forceinline__ void kload8(bf16x8*kf,lds_cptr kp){
  kf[0]=*(const __attribute__((address_space(3))) bf16x8*)(kp);      kf[1]=*(const __attribute__((address_space(3))) bf16x8*)(kp+512);
  kf[2]=*(const __attribute__((address_space(3))) bf16x8*)(kp+2048); kf[3]=*(const __attribute__((address_space(3))) bf16x8*)(kp+2560);
  kf[4]=*(const __attribute__((address_space(3))) bf16x8*)(kp+4096); kf[5]=*(const __attribute__((address_space(3))) bf16x8*)(kp+4608);
  kf[6]=*(const __attribute__((address_space(3))) bf16x8*)(kp+6144); kf[7]=*(const __attribute__((address_space(3))) bf16x8*)(kp+6656);
}
__device__ __forceinline__ void kload2(bf16x8*kf,lds_cptr kp,int j){ kf[2*j]=*(const __attribute__((address_space(3))) bf16x8*)(kp+j*2048); kf[2*j+1]=*(const __attribute__((address_space(3))) bf16x8*)(kp+j*2048+512); }
__device__ __forceinline__ s16x4 vtr(lds_cptr p){ return __builtin_bit_cast(s16x4,__builtin_amdgcn_ds_read_tr16_b64_v4i16((__attribute__((address_space(3))) v4i16_t*)p)); }
__device__ __forceinline__ float rowmax(const f32x16&p0,const f32x16&p1){
  float a=max3f(p0[0],p0[1],p1[0]),b=max3f(p0[2],p0[3],p1[1]);a=max3f(a,p1[2],p1[3]);
  #pragma unroll
  for(int r=4;r<16;r+=4){a=max3f(a,p0[r],p0[r+1]);b=max3f(b,p0[r+2],p0[r+3]);a=max3f(a,p1[r],p1[r+1]);b=max3f(b,p1[r+2],p1[r+3]);}
  const float m=max2f(a,b);
  auto rr=__builtin_amdgcn_permlane32_swap(__float_as_uint(m),__float_as_uint(m),false,false);
  return max2f(__uint_as_float(rr[0]),__uint_as_float(rr[1]));
}
__device__ __forceinline__ void pv(f32x16*o,int vb,bf16x8 pa0,bf16x8 pa1,bf16x8 pa2,bf16x8 pa3){
  #pragma unroll
  for(int d0=0;d0<2;++d0){s16x4 lo[4],hi[4];
    #pragma unroll
    for(int ks=0;ks<4;++ks){
      asm volatile("ds_read_b64_tr_b16 %0,%1 offset:%c2":"=&v"(lo[ks]):"v"(vb),"i"(d0*4096+ks*1024):"memory");
      asm volatile("ds_read_b64_tr_b16 %0,%1 offset:%c2":"=&v"(hi[ks]):"v"(vb),"i"(d0*4096+ks*1024+512):"memory");}
    asm volatile("s_waitcnt lgkmcnt(0)":::"memory");SBAR();
    #define PK(k) (bf16x8){lo[k][0],lo[k][1],lo[k][2],lo[k][3],hi[k][0],hi[k][1],hi[k][2],hi[k][3]}
    o[d0]=__builtin_amdgcn_mfma_f32_32x32x16_bf16(pa0,PK(0),o[d0],0,0,0);
    o[d0]=__builtin_amdgcn_mfma_f32_32x32x16_bf16(pa1,PK(1),o[d0],0,0,0);
    o[d0]=__builtin_amdgcn_mfma_f32_32x32x16_bf16(pa2,PK(2),o[d0],0,0,0);
    o[d0]=__builtin_amdgcn_mfma_f32_32x32x16_bf16(pa3,PK(3),o[d0],0,0,0);
    #undef PK
  }
}

#ifndef ATTN_STORE16
#define ATTN_STORE16(p,v) (*(u32x4*)(p)=(v))
#endif
template<int THRL> __device__ __forceinline__ void attn_unit(int b,int h,int qb,const bf16*Q,const bf16*__restrict__ K,const bf16*__restrict__ V,bf16*O,const float*Fm,const unsigned*NQ,const unsigned*NK,unsigned*ctr,char*shm){
  int tid=threadIdx.x; asm volatile("":"+v"(tid));
  const int lane=tid&63,r32=lane&31,hi=lane>>5; const int wid=__builtin_amdgcn_readfirstlane(tid>>6);
  const long rowbase=(long)b*SEQ; const int q0=qb*QB;
  typedef __attribute__((address_space(3))) float lds_f32; typedef __attribute__((address_space(3))) const f32x2_t* lds_cf2;
  int t_start; const float*Fh=Fm+(long)(b*NHEAD+h)*SEQ; float fref;
  int tid2=tid; asm volatile("":"+v"(tid2));
  { fref=__hip_atomic_load(Fh+q0,__ATOMIC_RELAXED,__HIP_MEMORY_SCOPE_AGENT);
    const unsigned*nq=NQ+((b*NQB+qb)*NHEAD+h)*2; const unsigned*nk=NK+(b*NHEAD+h)*2;
    const float q2=__uint_as_float(__hip_atomic_load(nq,__ATOMIC_RELAXED,__HIP_MEMORY_SCOPE_AGENT))+__uint_as_float(__hip_atomic_load(nq+1,__ATOMIC_RELAXED,__HIP_MEMORY_SCOPE_AGENT));
    const float k2=__uint_as_float(__hip_atomic_load(nk,__ATOMIC_RELAXED,__HIP_MEMORY_SCOPE_AGENT))+__uint_as_float(__hip_atomic_load(nk+1,__ATOMIC_RELAXED,__HIP_MEMORY_SCOPE_AGENT));
    const float thr=43.3f+2.02f*sqrtf(q2*k2);
    const int NTf=(q0+QB)/KVBLK; int cnt=0;
    _Pragma("unroll") for(int jj=0;jj<2;++jj){ const int j=1+(tid2&63)+64*jj; bool ok=false; if(j<=NTf-4) ok=((fref-Fh[64*j-1])*1.4426950408889634f<=-thr); cnt+=__popcll(__ballot(ok)); }
    t_start=__builtin_amdgcn_readfirstlane(cnt&~1);
  }
  const lds_cf2 bias2=(lds_cf2)((__attribute__((address_space(3))) const char*)shm+LDS_BIAS)+2*hi+t_start*32;
  const bf16*Qw=Q+(rowbase+q0+wid*QBLK)*DM+h*D;
  const bf16*Kh=K+(rowbase+(long)t_start*KVBLK)*DM+h*D,*Vh=V+(rowbase+(long)t_start*KVBLK)*DM+h*D;
  const unsigned lds0=(unsigned)(uintptr_t)shm;
  float*wsf=(float*)(shm+LDS_WS)+wid*64;
  const bf16*ksrc=Kh+wid*8;
  const bf16*vsrc=Vh+(long)(16*(wid&3))*DM+(wid>>2)*32;
  const unsigned kvoff=(unsigned)lane*(DM*2), vvoff=(unsigned)((lane>>2)*DM+(lane&3)*8)*2u;
  const unsigned kdst=lds0+LDS_K+wid*1024, vdst=lds0+LDS_V+wid*1024;
  #define DMA_K(t,slot) glds16s(ksrc+(long)(t)*KVBLK*DM,kvoff,(unsigned)__builtin_amdgcn_readfirstlane(kdst+(slot)))
  #define DMA_V(t,slot) glds16s(vsrc+(long)(t)*KVBLK*DM,vvoff,(unsigned)__builtin_amdgcn_readfirstlane(vdst+(slot)))
  const char*Kbase=shm+LDS_K; bf16x8 kf[8];
  const lds_cptr shm3=(lds_cptr)shm; const lds_cptr kp0=shm3+LDS_K+hi*1024+r32*16; const lds_cptr vp0=shm3+LDS_V+((lane>>4)&1)*32+(lane&3)*8+(4*hi+((lane&15)>>2))*64;
  const int NT=(q0+QB)/KVBLK-t_start;
  DMA_K(0,0);DMA_V(0,0);DMA_K(1,SLOTB);
  bf16x8 qr[4];
  #pragma unroll
  for(int d0=0;d0<4;++d0)qr[d0]=*reinterpret_cast<const bf16x8*>(&Qw[(long)r32*DM+d0*16+hi*8]);
  { lds_f32*bl=(lds_f32*)((__attribute__((address_space(3))) char*)shm+LDS_BIAS);
    _Pragma("clang loop unroll(disable) vectorize(disable)")
    for(int s0=t_start*KVBLK+tid2;s0<q0+QB;s0+=4*NW*64){ float f_[4];
      _Pragma("unroll") for(int u_=0;u_<4;++u_){ const int s_=s0+u_*NW*64; f_[u_]=Fh[s_<q0+QB?s_:q0]; }
      _Pragma("unroll") for(int u_=0;u_<4;++u_){ const int s_=s0+u_*NW*64; if(s_<q0+QB)bl[s_]=(fref-f_[u_])*1.4426950408889634f; } } }
  float mhat=0.f,l_reg=0.f;f32x16 o[2];o[0]=f32x16{};o[1]=f32x16{};f32x16 negm=f32x16{};asm volatile("":"+v"(negm));
  const int qrel=wid*QBLK+r32;
  #define CMASK(P0,P1,t) do{int jb_=(t)-(NT-4); if(jb_>=0)cmask(P0,P1,jb_,qrel,hi);}while(0)
  #define BIASADD(P0,P1,t) do{ const lds_cf2 bp_=bias2+(t)*32; \
    _Pragma("unroll") for(int j_=0;j_<4;++j_){ \
      SBAR(); { const f32x2_t b_=bp_[4*j_];    P0[4*j_]+=b_[0];  P0[4*j_+1]+=b_[1]; } \
      SBAR(); { const f32x2_t b_=bp_[4*j_+1];  P0[4*j_+2]+=b_[0];P0[4*j_+3]+=b_[1]; } \
      SBAR(); { const f32x2_t b_=bp_[4*j_+16]; P1[4*j_]+=b_[0];  P1[4*j_+1]+=b_[1]; } \
      SBAR(); { const f32x2_t b_=bp_[4*j_+17]; P1[4*j_+2]+=b_[0];P1[4*j_+3]+=b_[1]; } } SBAR(); }while(0)
  bool resc=false;
  #define START(P0,P1) do{ const float rm=rowmax(P0,P1); resc=false; \
    { const float dl=rm; mhat=fadd_s(mhat,dl); \
      _Pragma("unroll") for(int r=0;r<16;++r){P0[r]=fsub_s(P0[r],dl);P1[r]=fsub_s(P1[r],dl);} \
      _Pragma("unroll") for(int r=0;r<16;++r)negm[r]=-mhat; asm volatile("":"+v"(negm)); } \
    _Pragma("unroll") for(int r=0;r<16;++r)P0[r]=__builtin_amdgcn_exp2f(P0[r]); }while(0)
  #define RESC() do{ if(resc){ asm volatile("s_waitcnt lgkmcnt(0)":::"memory"); \
      _Pragma("unroll") for(int d_=0;d_<2;++d_) _Pragma("unroll") for(int r=0;r<16;++r)o[d_][r]*=wsf[crow(r,hi)]; } }while(0)
  f32x16 pA0,pA1,pB0,pB1;
  int sl_prev=0,sl_cur=0,sl_next=SLOTB;
  #define ROT() do{sl_prev=sl_cur;sl_cur=sl_next;sl_next=(sl_next==(NSLOT-1)*SLOTB)?0:sl_next+SLOTB;}while(0)
  DMA_K(2,2*SLOTB);
  WAIT_BAR(3);
  qkt(pA0,pA1,Kbase,qr,negm,r32,hi);asm volatile("s_nop 15\n\ts_nop 7":"+v"(pA0),"+v"(pA1));BIASADD(pA0,pA1,0);CMASK(pA0,pA1,0);
  START(pA0,pA1);
  _Pragma("unroll") for(int r=0;r<16;++r)pA1[r]=__builtin_amdgcn_exp2f(pA1[r]);
  WAIT_BAR(0);
  DMA_K(3,0);DMA_V(1,SLOTB);
  ROT();
  kload8(kf,kp0+sl_cur);
  WAIT_BAR(2);
  s16x4 vlo[8],vhi[8]; u32x4 pw0,pw1,pw2,pw3;
  #define PKW(P,B) cvtpk_s(P[B],P[B+1])
  #define PAF(k) __builtin_bit_cast(bf16x8,pw##k)
  #define VFR(i) (bf16x8){vlo[i][0],vlo[i][1],vlo[i][2],vlo[i][3],vhi[i][0],vhi[i][1],vhi[i][2],vhi[i][3]}
  #define PIN(x) asm volatile("":"+v"(x))
  #define MX3(a,b,c) __builtin_fmaxf(__builtin_fmaxf((a),(b)),(c))
  #define GAPA(MF,A0,A1,A2,A3,W0,W1,PW) do{ MF; sacc+=A0; sacc+=A1; sacc+=A2; sacc+=A3; PIN(sacc); W0; W1; PIN(PW); SBAR(); }while(0)
  #define EX(v) __builtin_amdgcn_exp2f(v)
  #define GAPB(MF,X,B) do{ MF; X[B]=EX(X[B]); X[B+1]=EX(X[B+1]); X[B+2]=EX(X[B+2]); X[B+3]=EX(X[B+3]); PIN(X); SBAR(); }while(0)
  #define VRD(i) do{ vlo[i]=vtr(vp_+(((i)>>2)*4096+((i)&3)*1024)); vhi[i]=vtr(vp_+(((i)>>2)*4096+((i)&3)*1024+512)); }while(0)
  #define KRD(G,j) do{ if(G){ kload2(kf,kp0+sl_next,j); SBAR(); } }while(0)
  #define STEP(C0,C1,P0,P1,t,GK,GV,GL) do{ SBAR(); \
    const lds_cptr vp_=vp0+sl_prev; \
    VRD(0); SBAR(); float sacc=(P0[0]+P0[1]); \
    GAPA(C0=__builtin_amdgcn_mfma_f32_32x32x16_bf16(kf[0],qr[0],negm,0,0,0), P0[2],P0[3],P0[4],P0[5],     pw0[0]=PKW(P0,0), pw0[1]=PKW(P0,2), pw0); \
    VRD(4); SBAR(); GAPA(C1=__builtin_amdgcn_mfma_f32_32x32x16_bf16(kf[1],qr[0],negm,0,0,0), P0[6],P0[7],P0[8],P0[9],     pw0[2]=PKW(P0,4), pw0[3]=PKW(P0,6), pw0); \
    VRD(1); SBAR(); GAPA(C0=__builtin_amdgcn_mfma_f32_32x32x16_bf16(kf[2],qr[1],C0,0,0,0),   P0[10],P0[11],P0[12],P0[13], pw1[0]=PKW(P0,8), pw1[1]=PKW(P0,10), pw1); \
    VRD(5); SBAR(); GAPA(C1=__builtin_amdgcn_mfma_f32_32x32x16_bf16(kf[3],qr[1],C1,0,0,0),   P0[14],P0[15],P1[0],P1[1],   pw1[2]=PKW(P0,12),pw1[3]=PKW(P0,14), pw1); \
    VRD(2); SBAR(); GAPA(C0=__builtin_amdgcn_mfma_f32_32x32x16_bf16(kf[4],qr[2],C0,0,0,0),   P1[2],P1[3],P1[4],P1[5],     pw2[0]=PKW(P1,0), pw2[1]=PKW(P1,2), pw2); \
    VRD(6); SBAR(); GAPA(C1=__builtin_amdgcn_mfma_f32_32x32x16_bf16(kf[5],qr[2],C1,0,0,0),   P1[6],P1[7],P1[8],P1[9],     pw2[2]=PKW(P1,4), pw2[3]=PKW(P1,6), pw2); \
    VRD(3); SBAR(); GAPA(C0=__builtin_amdgcn_mfma_f32_32x32x16_bf16(kf[6],qr[3],C0,0,0,0),   P1[10],P1[11],P1[12],P1[13], pw3[0]=PKW(P1,8), pw3[1]=PKW(P1,10), pw3); \
    VRD(7); SBAR(); GAPA(C1=__builtin_amdgcn_mfma_f32_32x32x16_bf16(kf[7],qr[3],C1,0,0,0),   P1[14],P1[15],0.f,0.f,       pw3[2]=PKW(P1,12),pw3[3]=PKW(P1,14), pw3); \
    l_reg+=sacc; \
    if(GK){DMA_K((t)+3,sl_cur);} if(GV){DMA_V((t)+1,sl_next);} \
    BIASADD(C0,C1,t); CMASK(C0,C1,t); \
    { float a=MX3(C0[0],C0[1],C1[0]),b=MX3(C0[2],C0[3],C1[1]); a=MX3(a,C1[2],C1[3]); \
      _Pragma("unroll") for(int r=4;r<16;r+=4){a=MX3(a,C0[r],C0[r+1]);b=MX3(b,C0[r+2],C0[r+3]);a=MX3(a,C1[r],C1[r+1]);b=MX3(b,C1[r+2],C1[r+3]);} \
      float rm=__builtin_fmaxf(a,b); { auto rr=__builtin_amdgcn_permlane32_swap(__float_as_uint(rm),__float_as_uint(rm),false,false); rm=__builtin_fmaxf(__uint_as_float(rr[0]),__uint_as_float(rr[1])); } \
      resc=false; \
      if(__builtin_expect(__any(rm>(float)THRL),0)){ const float dl=__builtin_fmaxf(rm,0.f); mhat+=dl; \
        _Pragma("unroll") for(int r=0;r<16;++r){C0[r]-=dl;C1[r]-=dl;} \
        _Pragma("unroll") for(int r=0;r<16;++r)negm[r]=-mhat; asm volatile("":"+v"(negm)); \
        const float f=__builtin_amdgcn_exp2f(-dl); l_reg*=f; if(hi==0)wsf[r32]=f; resc=true; } } \
    SBAR(); \
    GAPB(o[0]=__builtin_amdgcn_mfma_f32_32x32x16_bf16(PAF(0),VFR(0),o[0],0,0,0), C0,0); \
    GAPB(o[1]=__builtin_amdgcn_mfma_f32_32x32x16_bf16(PAF(0),VFR(4),o[1],0,0,0), C0,4); \
    KRD(GL,0); GAPB(o[0]=__builtin_amdgcn_mfma_f32_32x32x16_bf16(PAF(1),VFR(1),o[0],0,0,0), C0,8); \
    KRD(GL,1); GAPB(o[1]=__builtin_amdgcn_mfma_f32_32x32x16_bf16(PAF(1),VFR(5),o[1],0,0,0), C0,12); \
    KRD(GL,2); GAPB(o[0]=__builtin_amdgcn_mfma_f32_32x32x16_bf16(PAF(2),VFR(2),o[0],0,0,0), C1,0); \
    KRD(GL,3); GAPB(o[1]=__builtin_amdgcn_mfma_f32_32x32x16_bf16(PAF(2),VFR(6),o[1],0,0,0), C1,4); \
    GAPB(o[0]=__builtin_amdgcn_mfma_f32_32x32x16_bf16(PAF(3),VFR(3),o[0],0,0,0), C1,8); \
    GAPB(o[1]=__builtin_amdgcn_mfma_f32_32x32x16_bf16(PAF(3),VFR(7),o[1],0,0,0), C1,12); \
    }while(0)
  int t=1;
  #undef CMASK
  #define CMASK(P0,P1,t) do{}while(0)
  for(;t+5<NT;t+=2){
    STEP(pB0,pB1,pA0,pA1,t,true,true,true);     WAIT_BAR(2); RESC(); ROT();
    STEP(pA0,pA1,pB0,pB1,t+1,true,true,true);   WAIT_BAR(2); RESC(); ROT();
  }
  #undef CMASK
  #define CMASK(P0,P1,t) do{int jb_=(t)-(NT-4); if(jb_>=0)cmask(P0,P1,jb_,qrel,hi);}while(0)
  #define ENDW(tt) do{ if((tt)+3<NT){WAIT_BAR(2);} else if((tt)+2<NT){WAIT_BAR(1);} else {WAIT_BAR(0);} }while(0)
  for(;t+1<NT;t+=2){
    STEP(pB0,pB1,pA0,pA1,t,(t+3<NT),(t+1<NT),(t+1<NT));       ENDW(t);   RESC(); ROT();
    STEP(pA0,pA1,pB0,pB1,t+1,(t+4<NT),(t+2<NT),(t+2<NT));     ENDW(t+1); RESC(); ROT();
  }
  STEP(pB0,pB1,pA0,pA1,NT-1,false,false,false); RESC();
  { float sacc=pB0[0]+pB0[1]; _Pragma("unroll") for(int r=2;r<16;++r)sacc+=pB0[r]; _Pragma("unroll") for(int r=0;r<16;++r)sacc+=pB1[r]; l_reg+=sacc;
    pw0=(u32x4){PKW(pB0,0),PKW(pB0,2),PKW(pB0,4),PKW(pB0,6)};pw1=(u32x4){PKW(pB0,8),PKW(pB0,10),PKW(pB0,12),PKW(pB0,14)};pw2=(u32x4){PKW(pB1,0),PKW(pB1,2),PKW(pB1,4),PKW(pB1,6)};pw3=(u32x4){PKW(pB1,8),PKW(pB1,10),PKW(pB1,12),PKW(pB1,14)};
    const int vb0=(int)(lds0+LDS_V)+((lane>>4)&1)*32+(lane&3)*8+(4*hi+((lane&15)>>2))*64;
    SBAR(); pv(o,vb0+sl_cur,PAF(0),PAF(1),PAF(2),PAF(3)); }
  #undef PKW
  #undef PAF
  #undef VFR
  #undef PIN
  #undef MX3
  #undef GAPA
  #undef GAPB
  #undef EX
  #undef VRD
  #undef KRD
  #undef STEP
  #undef ENDW
  unsigned tk_=0u; if(tid==0)tk_=__hip_atomic_fetch_add(ctr,1u,__ATOMIC_RELAXED,__HIP_MEMORY_SCOPE_AGENT);
  {auto rr=__builtin_amdgcn_permlane32_swap(__float_as_uint(l_reg),__float_as_uint(l_reg),false,false);l_reg=__uint_as_float(rr[0])+__uint_as_float(rr[1]);}
  if(hi==0)wsf[32+r32]=l_reg;asm volatile("s_waitcnt lgkmcnt(0)":::"memory");
  float rli[16];
  #pragma unroll
  for(int r=0;r<16;++r)rli[r]=__builtin_amdgcn_rcpf(wsf[32+crow(r,hi)]);
  bf16*Ow=O+(rowbase+q0+wid*QBLK)*DM+h*D;
  { bf16*stg=(bf16*)(shm+LDS_OST)+wid*2048;
    #pragma unroll
    for(int r=0;r<16;++r){const int orow=crow(r,hi);
      #pragma unroll
      for(int d0=0;d0<2;++d0)stg[orow*64+d0*32+r32]=__float2bfloat16(o[d0][r]*rli[r]);}
    asm volatile("s_waitcnt lgkmcnt(0)":::"memory");
    #pragma unroll
    for(int i=0;i<4;++i){const int row=i*8+(lane>>3),ch=lane&7; const u32x4 v=*(const u32x4*)(stg+row*64+ch*8); ATTN_STORE16(Ow+(long)row*DM+ch*8,v);} }
  if(tid==0)*(__attribute__((address_space(3))) unsigned*)((__attribute__((address_space(3))) char*)shm+LDS_TKT)=tk_;
  asm volatile("s_waitcnt lgkmcnt(0)\n\ts_barrier":::"memory");
  #undef DMA_K
  #undef BIASADD
  #undef DMA_V
  #undef CMASK
  #undef START
  #undef RESC
  #undef ROT
}
constexpr int ATTN_LDS_BYTES=LDS_BYTES;
struct AttnTensors { const bf16* Q; const bf16* K; const bf16* V; bf16* O; const float* F; const unsigned* NQ; const unsigned* NK; };
struct AttnUnit { int bh; int qb; };
struct StaticOrder {
  int vcu,G;
  __device__ __forceinline__ explicit StaticOrder(int grid,int vcu_):vcu(vcu_),G(grid){}
  __device__ __forceinline__ bool next(int i,AttnUnit&u)const{ const int quad=(i>>2)*G+vcu; if(quad>=BATCH*NHEAD*8)return false; const int s=quad&7,j=i&3; u.bh=quad>>3; u.qb=(j==0)?s:(j==1)?15-s:(j==2)?16+s:31-s; return true; }
  __device__ __forceinline__ void a_ready(const AttnUnit&)const{}
  __device__ __forceinline__ void done(const AttnUnit&)const{}
};
constexpr int NUNITS=BATCH*NHEAD*NQB;
template<int THRL=60> __device__ __forceinline__ void attn_phase(char*lds,const AttnTensors&T,unsigned*ctr){
  __attribute__((address_space(3))) unsigned*tkt=(__attribute__((address_space(3))) unsigned*)((__attribute__((address_space(3))) char*)lds+LDS_TKT);
  if(threadIdx.x==0)*tkt=__hip_atomic_fetch_add(ctr,1u,__ATOMIC_RELAXED,__HIP_MEMORY_SCOPE_AGENT);
  asm volatile("s_waitcnt vmcnt(0) lgkmcnt(0)\n\ts_barrier":::"memory");
  for(;;){ const unsigned n=(unsigned)__builtin_amdgcn_readfirstlane((int)*tkt); if(n>=(unsigned)NUNITS)break;
    const int bh=(int)(n&31u),qb=NQB-1-(int)(n>>5);
    attn_unit<THRL>(bh/NHEAD,bh%NHEAD,qb,T.Q,T.K,T.V,T.O,T.F,T.NQ,T.NK,ctr,lds); }
}
#undef SBAR
#undef WAIT_BAR
}
constexpr int NWAVES = 8;
#ifndef MK_PER_PHASE
#define MK_PER_PHASE 0
#endif
constexpr int NPHASE = 15;

constexpr int BATCH = 4, T = 8192, D = 1024, H = 16, HD = 64;
constexpr int M = BATCH * T;
constexpr int NQKV = 3 * D;
constexpr int MH = M / 2, BH = BATCH / 2;
constexpr int NEXP = 16, DEXP = 256, NBUCKET = 24, MAXTILES = 88, HROWS = MAXTILES * 256, BCAP = MH;
constexpr int NBLK = MH / 128;
constexpr float RMS_EPS = 1e-6f;

constexpr size_t MiB = 1u << 20, KiB = 1u << 10;
constexpr size_t WS_CTL = 0, CTL_ZERO_BYTES = 128 * KiB;
constexpr size_t WS_TOKINFO = 1 * MiB, WS_TOKGATE = WS_TOKINFO + 128 * KiB, WS_HIST = WS_TOKGATE + 256 * KiB, WS_TILETBL = WS_HIST + 32 * KiB, WS_TOKROW = WS_TILETBL + 4 * KiB,
                 WS_GATEROW = WS_TOKROW + 160 * KiB, WS_BLKSUM = WS_GATEROW + 320 * KiB, WS_RWG = WS_BLKSUM + 16 * KiB, WS_WFG = WS_RWG + 160 * KiB, WS_TRASH = WS_WFG + 64 * KiB, WS_SMALL_END = WS_TRASH + 4 * KiB;
static_assert(WS_SMALL_END <= 4 * MiB, "small tables");
constexpr size_t WS_LF = 4 * MiB, WS_FM = 6 * MiB;
constexpr size_t WS_WPOOL = 8 * MiB, WS_WQKV = 9 * MiB, WS_WO = 15 * MiB, WS_WG = 17 * MiB, WS_WU = 33 * MiB, WS_WD = 49 * MiB;
constexpr size_t WS_XN = 66 * MiB;
constexpr size_t WS_QO = 130 * MiB, WS_K = 194 * MiB, WS_V = 258 * MiB;
constexpr size_t WS_HMID = 322 * MiB, WS_Y0 = 370 * MiB, WS_DPOOL = 434 * MiB, WS_TOKROW2 = 498 * MiB, WS_GATEROW2 = 501 * MiB, WS_END = 508 * MiB;
static_assert(WS_HMID + (size_t)2 * HROWS * 512 * 2 <= WS_Y0 && WS_TOKROW2 + (size_t)2 * NBUCKET * BCAP * 4 <= WS_GATEROW2 && WS_GATEROW2 + (size_t)2 * NBUCKET * BCAP * 8 <= WS_END && WS_V - WS_K == WS_K - WS_QO, "d_ws map");
constexpr int CW_BAR = 4096;
constexpr int CW_NRM = 8192;
constexpr int CW_CNT = 12800;
constexpr int CW_CONV = 13120;
constexpr int CW_BARH = 16384;
constexpr int CW_ATQ = 12544;
static_assert(CW_NRM + 4096 + 128 <= CW_ATQ && (CW_BARH + 2 * 3456) * 4 <= (int)CTL_ZERO_BYTES, "CTL words inside the memset region");

constexpr int RING_OFF = 0, RING_BYTES = 131072;
constexpr int LDSCTL_OFF = RING_BYTES, MISC_OFF = LDSCTL_OFF + 320;
constexpr int TBL_OFF = RING_BYTES + 1024;
constexpr int LDS_BYTES = 147456;
static_assert(MISC_OFF + 128 <= TBL_OFF && TBL_OFF + (1 + 3 * MAXTILES) * 4 <= LDS_BYTES, "LDS map");

#define GAS __attribute__((address_space(1)))
#define LAS __attribute__((address_space(3)))
typedef unsigned short bf16;
typedef unsigned v4u __attribute__((ext_vector_type(4)));
typedef float f32x4 __attribute__((ext_vector_type(4)));
typedef float f32x2 __attribute__((ext_vector_type(2)));
typedef GAS unsigned gu32;
#define RLX_AGENT __ATOMIC_RELAXED, __HIP_MEMORY_SCOPE_AGENT
#define LDS_WAIT() asm volatile("s_waitcnt lgkmcnt(0)" ::: "memory")
__device__ __forceinline__ unsigned f2bf(float f) { unsigned u = __builtin_bit_cast(unsigned, f); return (u + 0x7fffu + ((u >> 16) & 1u)) >> 16; }
__device__ __forceinline__ unsigned pk2(float lo, float hi) { return f2bf(lo) | (f2bf(hi) << 16); }

#define XB_TMO      128
#define XB_XCNT(j)  (256  + 64 * (j))
#define XB_XSUB(j)  (1280 + 64 * (j))
#define XB_XGEN(j)  (2304 + 64 * (j))
#define XB_TOP      3328
#define XB_TOPGEN   3392
#define XCD_BAR_WORDS 3456
#define XB_SPIN_CAP (1u << 18)

__device__ __forceinline__ unsigned xb_ld(unsigned* p)              { return __hip_atomic_load(p, __ATOMIC_RELAXED, __HIP_MEMORY_SCOPE_AGENT); }
__device__ __forceinline__ unsigned xb_add(unsigned* p, unsigned v) { return __hip_atomic_fetch_add(p, v, __ATOMIC_RELAXED, __HIP_MEMORY_SCOPE_AGENT); }
__device__ __forceinline__ unsigned xb_xcc_id() { return (unsigned)__builtin_amdgcn_s_getreg((3 << 11) | 20) & 0xFu; }
#define XB_SPIN(cond, bar) do { unsigned _sp = 0; while (cond) { __builtin_amdgcn_s_sleep(1); \
    if ((++_sp & 255u) == 0u) { if (xb_ld(&(bar)[XB_TMO])) break; if (_sp > XB_SPIN_CAP) { atomicAdd(&(bar)[XB_TMO], 1u); break; } } } } while (0)

struct XcdBarrier {
    unsigned* bar; unsigned x; unsigned G;
    volatile LAS unsigned* st;
};

__device__ __forceinline__ XcdBarrier xcd_barrier_post(unsigned* bar, volatile LAS unsigned* st, unsigned G) {
    XcdBarrier b; b.bar = bar; b.x = xb_xcc_id(); b.st = st; b.G = G;
    if (threadIdx.x == 0) (void)xb_add(&bar[XB_XCNT(b.x)], 1u);
    return b;
}
__device__ __forceinline__ void xcd_barrier_complete(unsigned* bar, unsigned x, unsigned& nloc, unsigned& nx, const unsigned G) {
    unsigned sum, cnt, mine, sp = 0u;
    for (;;) {
        sum = 0u; cnt = 0u; mine = 0u;
#pragma unroll
        for (unsigned j = 0; j < 16; ++j) { const unsigned c = xb_ld(&bar[XB_XCNT(j)]); sum += c; cnt += (c > 0u) ? 1u : 0u; mine = (j == x) ? c : mine; }
        if (sum == G) break;
        __builtin_amdgcn_s_sleep(1);
        if ((++sp & 255u) == 0u) { if (xb_ld(&bar[XB_TMO])) break; if (sp > XB_SPIN_CAP) { atomicAdd(&bar[XB_TMO], 1u); break; } }
    }
    nloc = mine > 0u ? mine : 1u; nx = cnt > 0u ? cnt : 1u;
}

__device__ __forceinline__ void xcd_barrier(const XcdBarrier& b) {
    asm volatile("s_waitcnt vmcnt(0)" ::: "memory");
    __syncthreads();
    if (threadIdx.x == 0) {
        unsigned* bar = b.bar;
        __builtin_amdgcn_s_waitcnt(0);
        unsigned nloc = b.st[0], nx = b.st[1];
        if (nloc == 0u) { xcd_barrier_complete(bar, b.x, nloc, nx, b.G); b.st[0] = nloc; b.st[1] = nx; }
        const unsigned old = xb_add(&bar[XB_XSUB(b.x)], 1u);
        const unsigned gen = old / nloc;
        if (old + 1u == (gen + 1u) * nloc) {
            __builtin_amdgcn_fence(__ATOMIC_RELEASE, "agent");
            asm volatile("s_waitcnt vmcnt(0)" ::: "memory");
            const unsigned og = xb_add(&bar[XB_TOP], 1u);
            const unsigned tg = og / nx;
            if (og + 1u == (tg + 1u) * nx) xb_add(&bar[XB_TOPGEN], 1u);
            else XB_SPIN(xb_ld(&bar[XB_TOPGEN]) == tg, bar);
            __builtin_amdgcn_fence(__ATOMIC_ACQUIRE, "agent");
            xb_add(&bar[XB_XGEN(b.x)], 1u);
            asm volatile("s_waitcnt vmcnt(0)" ::: "memory");
        } else {
            XB_SPIN(xb_ld(&bar[XB_XGEN(b.x)]) == gen, bar);
            __builtin_amdgcn_fence(__ATOMIC_ACQUIRE, "agent");
            asm volatile("s_waitcnt vmcnt(0)" ::: "memory");
        }
    }
    __syncthreads();
}
template <int I> __device__ __forceinline__ const float* kin() {
    const __attribute__((address_space(4))) volatile unsigned long long* kp = (const __attribute__((address_space(4))) volatile unsigned long long*)__builtin_amdgcn_kernarg_segment_ptr();
    const unsigned long long v = kp[I];
    return (const float*)(GAS const float*)v;
}
enum InIdx { I_X = 0, I_MIXN, I_FFNN, I_POOLW, I_POOLS, I_KVN, I_WK, I_WV, I_WF, I_BF, I_WQ, I_WO, I_RG, I_RGB, I_RE, I_REB, I_WGATE, I_WUP, I_WDOWN, I_FINN };
struct Frame {
    LAS unsigned char* lds;
    volatile LAS unsigned* MISC;
    int tid, lane, wave;
    int vcu, G;
    int half;
    float* out;
    unsigned char* ws;
#define WSP(name, T, OFF) __device__ __forceinline__ T* name() const { return (T*)(ws + (OFF)); }
#define WSH(name, T, OFF, PERHALF) __device__ __forceinline__ T* name() const { return (T*)(ws + (OFF)) + (size_t)half * (PERHALF); }
    WSP(WPOOL, bf16, WS_WPOOL) WSP(WQKV, bf16, WS_WQKV) WSP(WO, bf16, WS_WO) WSP(WG, bf16, WS_WG) WSP(WU, bf16, WS_WU) WSP(WD, bf16, WS_WD)
    WSH(XN, bf16, WS_XN, (size_t)MH * D) WSH(QO, bf16, WS_QO, (size_t)MH * D) WSH(KB, bf16, WS_K, (size_t)MH * D) WSH(VB, bf16, WS_V, (size_t)MH * D) WSH(HMID, bf16, WS_HMID, (size_t)HROWS * 512)
    WSH(TOKROW, int, WS_TOKROW2, (size_t)NBUCKET * BCAP) WSH(GATEROW, float, WS_GATEROW2, (size_t)NBUCKET * BCAP * 2)
    WSH(BLKSUM, float, WS_BLKSUM, NBLK * 16) WSP(RWG, float, WS_RWG) WSP(WFG, float, WS_WFG) WSH(LF, float, WS_LF, (size_t)MH * 16) WSH(FM, float, WS_FM, (size_t)BH * H * T) WSP(TRASH, bf16, WS_TRASH)
    WSH(DPOOL, bf16, WS_DPOOL, (size_t)MH * D) WSH(Y0, bf16, WS_Y0, (size_t)MH * D) WSH(DATT, bf16, WS_V, (size_t)MH * D) WSH(Y1, bf16, WS_QO, (size_t)MH * D) WSH(H3B, bf16, WS_K, (size_t)MH * D)
    __device__ __forceinline__ const float* X() const { return kin<I_X>() + (size_t)half * MH * D; }
#undef WSH
#undef WSP
};

__device__ __forceinline__ float wave_sum(float v) {
#pragma unroll
    for (int o = 1; o < 64; o <<= 1) v += __shfl_xor(v, o);
    return v;
}
template <int N> __device__ __forceinline__ void halve(float (&v)[80], int mask, int lane) {
    const bool hi = (lane & mask) != 0;
#pragma unroll
    for (int k = 0; k < N / 2; ++k) { const float keep = hi ? v[2 * k + 1] : v[2 * k], send = hi ? v[2 * k] : v[2 * k + 1]; v[k] = keep + __shfl_xor(send, mask); }
}

__device__ __forceinline__ void p0_transpose_item(const float* W, int K, int N, bf16* WT, const float* ks, const float* ns, LAS float* scr, int item, int lane) {
    const int nblk = N / 32, kb = item / nblk, nb = item % nblk, k0 = 64 * kb, n0 = 32 * nb;
    const float nsv = ns ? ns[n0 + (lane & 31)] : 1.0f;
    float wv[32], kv[32];
    const float* wp = W + (size_t)(k0 + (lane >> 5)) * N + n0 + (lane & 31);
#pragma unroll
    for (int i = 0; i < 32; ++i) wv[i] = wp[(size_t)(2 * i) * N];
#pragma unroll
    for (int i = 0; i < 32; ++i) kv[i] = ks ? ks[k0 + 2 * i + (lane >> 5)] : 1.0f;
#pragma unroll
    for (int i = 0; i < 32; ++i) scr[(2 * i + (lane >> 5)) * 33 + (lane & 31)] = wv[i] * (kv[i] * nsv);
    LDS_WAIT(); asm volatile("" ::: "memory");
    const int c = lane & 7;
#pragma unroll
    for (int j = 0; j < 4; ++j) { const int n = (lane >> 3) + 8 * j; const LAS float* s = scr + (8 * c) * 33 + n;
        v4u o; o.x = pk2(s[0 * 33], s[1 * 33]); o.y = pk2(s[2 * 33], s[3 * 33]); o.z = pk2(s[4 * 33], s[5 * 33]); o.w = pk2(s[6 * 33], s[7 * 33]);
        *(v4u*)(WT + (size_t)(n0 + n) * K + k0 + 8 * c) = o; }
    LDS_WAIT(); asm volatile("" ::: "memory");
}
template <int W> __device__ __forceinline__ void pool_walk(const float* xb, int t0, const LAS float* invs, bf16* outp) {
    f32x2 ring[16], cur[16], nxt[16];
#pragma unroll
    for (int u = 0; u < 16; ++u) { ring[u] = (f32x2){0.f, 0.f}; const int t = t0 - 16 + u; cur[u] = *(const f32x2*)(xb + (size_t)(t < 0 ? 0 : t) * D); }
    for (int base = -16; base < 128; base += 16) {
        if (base + 16 < 128) {
#pragma unroll
            for (int u = 0; u < 16; ++u) nxt[u] = *(const f32x2*)(xb + (size_t)(t0 + base + 16 + u) * D); }
#pragma unroll
        for (int u = 0; u < 16; ++u) {
            const int tt = base + u, t = t0 + tt;
            const f32x2 v = cur[u] * invs[tt + 16];
            ring[u] = v;
            if (base >= 0) {
                f32x2 s = v;
#pragma unroll
                for (int j = 1; j < W; ++j) s += ring[(u - j) & 15];
                const float cnt = (float)((t + 1 < W) ? (t + 1) : W);
                const f32x2 d = (f32x2){s.x / cnt, s.y / cnt} - v;
                *(unsigned*)(outp + (size_t)t * D) = pg8::cvt_pk_bf16(d.x, d.y);
            }
        }
#pragma unroll
        for (int u = 0; u < 16; ++u) cur[u] = nxt[u];
    }
}
__device__ __forceinline__ void p0_pool_diff(Frame& F) {
    LAS float* invs = (LAS float*)(F.lds + RING_OFF);
    for (int blk = F.vcu; blk < NBLK; blk += F.G) {
        const int b = blk >> 6, t0 = (blk & 63) * 128;
        const float* xb = F.X() + (size_t)b * T * D;
        for (int kb = 0; kb < 18; kb += 6) {
            f32x4 v[6][4];
#pragma unroll
            for (int q = 0; q < 6; ++q) { const int t = t0 - 16 + F.wave + 8 * (kb + q); const f32x4* xr = (const f32x4*)(xb + (size_t)(t < 0 ? 0 : t) * D) + F.lane;
#pragma unroll
                for (int j = 0; j < 4; ++j) v[q][j] = xr[64 * j]; }
#pragma unroll
            for (int q = 0; q < 6; ++q) { const int tt = -16 + F.wave + 8 * (kb + q); float s = 0.f;
#pragma unroll
                for (int j = 0; j < 4; ++j) s += (v[q][j].x * v[q][j].x + v[q][j].y * v[q][j].y) + (v[q][j].z * v[q][j].z + v[q][j].w * v[q][j].w);
                const float inv = (t0 + tt >= 0) ? 1.0f / sqrtf(wave_sum(s) * (1.0f / D) + RMS_EPS) : 0.f;
                if (F.lane == 0) invs[tt + 16] = inv; }
        }
        __syncthreads();
        const float* xt = xb + 2 * F.tid; bf16* op = F.XN() + (size_t)b * T * D + 2 * F.tid;
        const int grp = F.wave >> 1;
        if (grp == 0) pool_walk<2>(xt, t0, invs, op); else if (grp == 1) pool_walk<4>(xt, t0, invs, op); else if (grp == 2) pool_walk<8>(xt, t0, invs, op); else pool_walk<16>(xt, t0, invs, op);
        __syncthreads();
    }
}
constexpr int CONV_EARLY = 4224, CONV_ALL = 14464;
__device__ __forceinline__ void p0_convert(Frame& F, int it0, int it1, int gw, int ngw) {
    LAS float* scr = (LAS float*)(F.lds + RING_OFF + 4096 + F.wave * 12288);
    for (int it = it0 + gw; it < it1; it += ngw) {
        int r = it;
        if (r < 128) { const int g = r >> 5; p0_transpose_item(kin<I_POOLW>() + g * 65536, 256, 256, F.WPOOL() + g * 65536, kin<I_MIXN>() + g * 256, kin<I_POOLS>() + g * 256, scr, r & 31, F.lane); continue; } r -= 128;
        if (r < 4096) { const int up = r >> 11, mat = (r >> 7) & 15;
            p0_transpose_item((up ? kin<I_WUP>() : kin<I_WGATE>()) + (size_t)mat * 262144, D, DEXP, (up ? F.WU() : F.WG()) + (size_t)mat * 262144, kin<I_FFNN>(), nullptr, scr, r & 127, F.lane); continue; } r -= 4096;
        if (r < 2048) { const int mat = r >> 7; p0_transpose_item(kin<I_WDOWN>() + (size_t)mat * 262144, DEXP, D, F.WD() + (size_t)mat * 262144, nullptr, nullptr, scr, r & 127, F.lane); continue; } r -= 2048;
        if (r < 2048) { const int mt = r >> 9, item = r & 511;
            const float* W = mt == 0 ? kin<I_WQ>() : mt == 1 ? kin<I_WK>() : mt == 2 ? kin<I_WV>() : kin<I_WO>(); bf16* WT = mt < 3 ? F.WQKV() + (size_t)mt * D * D : F.WO();
            const float* ks = mt == 0 ? kin<I_MIXN>() + D : (mt < 3 ? kin<I_KVN>() : nullptr);
            p0_transpose_item(W, D, D, WT, ks, nullptr, scr, item, F.lane); continue; } r -= 2048;
        if (r < 4096) { const int up = r >> 11, mat = 16 + ((r >> 7) & 15);
            p0_transpose_item((up ? kin<I_WUP>() : kin<I_WGATE>()) + (size_t)mat * 262144, D, DEXP, (up ? F.WU() : F.WG()) + (size_t)mat * 262144, kin<I_FFNN>() + D, nullptr, scr, r & 127, F.lane); continue; } r -= 4096;
        { const int mat = 16 + (r >> 7); p0_transpose_item(kin<I_WDOWN>() + (size_t)mat * 262144, DEXP, D, F.WD() + (size_t)mat * 262144, nullptr, nullptr, scr, r & 127, F.lane); }
    }
}
__device__ __forceinline__ void p0_small(Frame& F, int gt, int NT) {
    const float* rg = kin<I_RG>(); const float* re = kin<I_RE>(); const float* ffnn = kin<I_FFNN>(); const float* kvn = kin<I_KVN>(); const float* wf = kin<I_WF>();
    float* RWG = F.RWG(); float* WFG = F.WFG();
    for (int i = gt; i < 2 * 20 * D; i += NT) { const int l = i / (20 * D), rem = i % (20 * D), col = rem / D, c = rem % D;
        const float w = col < 4 ? rg[(size_t)(l * D + c) * 4 + col] : re[(size_t)(l * D + c) * 16 + (col - 4)]; RWG[i] = ffnn[l * D + c] * w; }
    for (int i = gt; i < 16 * D; i += NT) { const int h = i / D, c = i % D; WFG[i] = kvn[c] * wf[c * 16 + h]; }
}

struct RowSrc { const float* base; const bf16* d1; const bf16* d2; const bf16* d3; bf16* hwb; };
__device__ __forceinline__ f32x4 bf4_to_f32(unsigned long long w) { const unsigned lo = (unsigned)w, hi = (unsigned)(w >> 32);
    return (f32x4){__uint_as_float(lo << 16), __uint_as_float(lo & 0xffff0000u), __uint_as_float(hi << 16), __uint_as_float(hi & 0xffff0000u)}; }
__device__ __forceinline__ void row_load(const RowSrc& S, size_t row, int lane, f32x4 (&v)[4]) {
    if (S.base) { const f32x4* xr = (const f32x4*)(S.base + row * D) + lane;
#pragma unroll
        for (int j = 0; j < 4; ++j) v[j] = xr[64 * j]; }
    else {
#pragma unroll
        for (int j = 0; j < 4; ++j) v[j] = (f32x4){0.f, 0.f, 0.f, 0.f}; }
    if (S.d1) { const unsigned long long* dr = (const unsigned long long*)(S.d1 + row * D) + lane;
#pragma unroll
        for (int j = 0; j < 4; ++j) v[j] += bf4_to_f32(dr[64 * j]); }
    if (S.d2) { const unsigned long long* dr = (const unsigned long long*)(S.d2 + row * D) + lane;
#pragma unroll
        for (int j = 0; j < 4; ++j) v[j] += bf4_to_f32(dr[64 * j]); }
    if (S.d3) { const unsigned long long* dr = (const unsigned long long*)(S.d3 + row * D) + lane;
#pragma unroll
        for (int j = 0; j < 4; ++j) v[j] += bf4_to_f32(dr[64 * j]); }
    if (S.hwb) { unsigned long long* hr = (unsigned long long*)(S.hwb + row * D) + lane;
#pragma unroll
        for (int j = 0; j < 4; ++j) hr[64 * j] = (unsigned long long)pg8::cvt_pk_bf16(v[j].x, v[j].y) | ((unsigned long long)pg8::cvt_pk_bf16(v[j].z, v[j].w) << 32); }
}
__device__ __forceinline__ void rows4_load_norm(Frame& F, const RowSrc& S, int row0, f32x4 (&xv)[4][4], float (&inv)[4]) {
#pragma unroll
    for (int r = 0; r < 4; ++r) row_load(S, (size_t)(row0 + r), F.lane, xv[r]);
#pragma unroll
    for (int r = 0; r < 4; ++r) { float s = 0.f;
#pragma unroll
        for (int j = 0; j < 4; ++j) s += (xv[r][j].x * xv[r][j].x + xv[r][j].y * xv[r][j].y) + (xv[r][j].z * xv[r][j].z + xv[r][j].w * xv[r][j].w);
        inv[r] = 1.0f / sqrtf(wave_sum(s) * (1.0f / D) + RMS_EPS); }
#pragma unroll
    for (int r = 0; r < 4; ++r) { unsigned long long* o8 = (unsigned long long*)(F.XN() + (size_t)(row0 + r) * D) + F.lane;
#pragma unroll
        for (int j = 0; j < 4; ++j) o8[64 * j] = (unsigned long long)pg8::cvt_pk_bf16(xv[r][j].x * inv[r], xv[r][j].y * inv[r]) | ((unsigned long long)pg8::cvt_pk_bf16(xv[r][j].z * inv[r], xv[r][j].w * inv[r]) << 32); }
}
template <int NCOL> __device__ __forceinline__ void rows4_dots(const LAS float* Wl, int lane, const f32x4 (&xv)[4][4], float (&acc)[80]) {
#pragma unroll
    for (int j = 0; j < 4; ++j)
#pragma unroll
        for (int col = 0; col < NCOL; ++col) { const f32x4 w = ((const LAS f32x4*)(Wl + col * D))[lane + 64 * j];
#pragma unroll
            for (int r = 0; r < 4; ++r) { float a = acc[4 * col + r]; a = __builtin_fmaf(xv[r][j].x, w.x, a); a = __builtin_fmaf(xv[r][j].y, w.y, a); a = __builtin_fmaf(xv[r][j].z, w.z, a); a = __builtin_fmaf(xv[r][j].w, w.w, a); acc[4 * col + r] = a; }
            if ((col & 3) == 3) __builtin_amdgcn_sched_barrier(0); }
}
__device__ __forceinline__ void row_router_phase(Frame& F, int l, const RowSrc& RS, unsigned* cnt) {
    LAS float* Wl = (LAS float*)(F.lds + RING_OFF);
    LAS float* sc = (LAS float*)(F.lds + RING_OFF + 81920);
    LAS int* hl = (LAS int*)(F.lds + RING_OFF + 81920 + 4096);
    LAS int* tb = hl + 64;
    LAS float* tg = (LAS float*)(tb + 128);
    { const f32x4* rw = (const f32x4*)(F.RWG() + (size_t)l * 20 * D) + F.tid; f32x4 t[10];
#pragma unroll
      for (int i = 0; i < 10; ++i) t[i] = rw[i * NWAVES * 64];
#pragma unroll
      for (int i = 0; i < 10; ++i) ((LAS f32x4*)Wl)[F.tid + i * NWAVES * 64] = t[i]; }
    const float* gb = kin<I_RGB>() + l * 4; const float* eb = kin<I_REB>() + l * 16;
    for (int blk = F.vcu; blk < NBLK; blk += F.G) {
        if (F.tid < 32) hl[F.tid] = 0;
        __syncthreads();
        for (int pass = 0; pass < 4; ++pass) {
            asm volatile("" ::: "memory");
            const int row0 = blk * 128 + F.wave * 16 + pass * 4;
            f32x4 xv[4][4]; float inv[4];
            rows4_load_norm(F, RS, row0, xv, inv);
            LAS float* sw = sc + F.wave * 80;
            float acc[80];
#pragma unroll
            for (int i = 0; i < 16; ++i) acc[i] = 0.f;
            rows4_dots<4>(Wl, F.lane, xv, acc);
            halve<16>(acc, 1, F.lane); halve<8>(acc, 2, F.lane); halve<4>(acc, 4, F.lane); halve<2>(acc, 8, F.lane);
            acc[0] += __shfl_xor(acc[0], 16); acc[0] += __shfl_xor(acc[0], 32);
            { const int p = F.lane & 15, r = p & 3, c = p >> 2; const float iv = r == 0 ? inv[0] : r == 1 ? inv[1] : r == 2 ? inv[2] : inv[3];
              if (F.lane < 16) sw[r * 8 + c] = acc[0] * iv + gb[c]; }
            LDS_WAIT(); asm volatile("" ::: "memory");
            int gsel[4];
#pragma unroll
            for (int r = 0; r < 4; ++r) { const f32x4 g = *(const LAS f32x4*)(sw + r * 8); int gi = 0; float gm = g.x; if (g.y > gm) { gm = g.y; gi = 1; } if (g.z > gm) { gm = g.z; gi = 2; } if (g.w > gm) { gm = g.w; gi = 3; }
                gsel[r] = __builtin_amdgcn_readfirstlane(gi); }
#pragma unroll
            for (int i = 0; i < 16; ++i) acc[i] = 0.f;
#pragma unroll
            for (int j = 0; j < 4; ++j)
#pragma unroll
                for (int r = 0; r < 4; ++r) {
#pragma unroll
                    for (int c = 0; c < 4; ++c) { const f32x4 w = ((const LAS f32x4*)(Wl + (4 + 4 * gsel[r] + c) * D))[F.lane + 64 * j];
                        float a = acc[4 * c + r]; a = __builtin_fmaf(xv[r][j].x, w.x, a); a = __builtin_fmaf(xv[r][j].y, w.y, a); a = __builtin_fmaf(xv[r][j].z, w.z, a); a = __builtin_fmaf(xv[r][j].w, w.w, a); acc[4 * c + r] = a; }
                    __builtin_amdgcn_sched_barrier(0); }
            halve<16>(acc, 1, F.lane); halve<8>(acc, 2, F.lane); halve<4>(acc, 4, F.lane); halve<2>(acc, 8, F.lane);
            acc[0] += __shfl_xor(acc[0], 16); acc[0] += __shfl_xor(acc[0], 32);
            if (F.lane < 16) sw[(F.lane & 3) * 8 + 4 + (F.lane >> 2)] = acc[0];
            LDS_WAIT(); asm volatile("" ::: "memory");
            if (F.lane < 4) {
                const int r = F.lane; const LAS float* sr = sw + r * 8;
                const float iv = r == 0 ? inv[0] : r == 1 ? inv[1] : r == 2 ? inv[2] : inv[3];
                const float g0 = sr[0], g1 = sr[1], g2 = sr[2], g3 = sr[3];
                int gi = 0; float gm = g0; if (g1 > gm) { gm = g1; gi = 1; } if (g2 > gm) { gm = g2; gi = 2; } if (g3 > gm) { gm = g3; gi = 3; }
                const float gwt = 1.0f / (expf(g0 - gm) + expf(g1 - gm) + expf(g2 - gm) + expf(g3 - gm));
                const LAS float* se = sr + 4; const float* ebg = eb + gi * 4;
                const float e0 = se[0] * iv + ebg[0], e1 = se[1] * iv + ebg[1], e2 = se[2] * iv + ebg[2], e3 = se[3] * iv + ebg[3];
                int i1 = 0; float v1 = e0; if (e1 > v1) { v1 = e1; i1 = 1; } if (e2 > v1) { v1 = e2; i1 = 2; } if (e3 > v1) { v1 = e3; i1 = 3; }
                int i2 = -1; float v2 = -INFINITY;
                if (i1 != 0 && e0 > v2) { v2 = e0; i2 = 0; } if (i1 != 1 && e1 > v2) { v2 = e1; i2 = 1; } if (i1 != 2 && e2 > v2) { v2 = e2; i2 = 2; } if (i1 != 3 && e3 > v2) { v2 = e3; i2 = 3; }
                const float p1 = 1.0f / (1.0f + expf(v2 - v1)), p2 = 1.0f - p1;
                const int lo = i1 < i2 ? i1 : i2, hi = i1 < i2 ? i2 : i1;
                const float wlo = (i1 < i2 ? p1 : p2) * gwt, whi = (i1 < i2 ? p2 : p1) * gwt;
                const int pidx = lo == 0 ? hi - 1 : (lo == 1 ? hi + 1 : 5);
                const int bucket = gi * 6 + pidx, tok = row0 + r;
                const int rank = __hip_atomic_fetch_add(hl + bucket, 1, __ATOMIC_RELAXED, __HIP_MEMORY_SCOPE_WORKGROUP);
                const int ti = tok - blk * 128; tb[ti] = bucket | (rank << 8); tg[2 * ti] = wlo; tg[2 * ti + 1] = whi;
            }
        }
        __syncthreads();
        if (F.tid < NBUCKET) { const int n = hl[F.tid]; hl[32 + F.tid] = n ? (int)__hip_atomic_fetch_add(cnt + F.tid, (unsigned)n, RLX_AGENT) : 0; }
        __syncthreads();
        if (F.tid < 128) { const int v = tb[F.tid], b = v & 0xff, pos = b * BCAP + hl[32 + b] + (v >> 8);
            F.TOKROW()[pos] = blk * 128 + F.tid; *(f32x2*)(F.GATEROW() + 2 * (size_t)pos) = (f32x2){tg[2 * F.tid], tg[2 * F.tid + 1]}; }
        __syncthreads();
    }
}
__device__ __forceinline__ void row_forget_phase(Frame& F, const RowSrc& RS) {
    LAS float* Wl = (LAS float*)(F.lds + RING_OFF);
    LAS float* wsum = (LAS float*)(F.lds + RING_OFF + 81920);
    { const f32x4* rw = (const f32x4*)F.WFG() + F.tid; f32x4 t[8];
#pragma unroll
      for (int i = 0; i < 8; ++i) t[i] = rw[i * NWAVES * 64];
#pragma unroll
      for (int i = 0; i < 8; ++i) ((LAS f32x4*)Wl)[F.tid + i * NWAVES * 64] = t[i]; }
    __syncthreads();
    const int h = F.lane >> 2, r = F.lane & 3; const float bfh = kin<I_BF>()[h];
    for (int blk = F.vcu; blk < NBLK; blk += F.G) {
        float bsum = 0.f;
        for (int pass = 0; pass < 4; ++pass) {
            asm volatile("" ::: "memory");
            const int row0 = blk * 128 + F.wave * 16 + pass * 4;
            f32x4 xv[4][4]; float inv[4];
            rows4_load_norm(F, RS, row0, xv, inv);
            float acc[80];
#pragma unroll
            for (int i = 0; i < 80; ++i) acc[i] = 0.f;
            rows4_dots<16>(Wl, F.lane, xv, acc);
            halve<64>(acc, 1, F.lane); halve<32>(acc, 2, F.lane); halve<16>(acc, 4, F.lane); halve<8>(acc, 8, F.lane); halve<4>(acc, 16, F.lane); halve<2>(acc, 32, F.lane);
            const float iv = r == 0 ? inv[0] : r == 1 ? inv[1] : r == 2 ? inv[2] : inv[3];
            const float z = acc[0] * iv + bfh;
            const float lf = fminf(z, 0.f) - log1pf(expf(-fabsf(z)));
            F.LF()[(size_t)(row0 + r) * 16 + h] = lf; bsum += lf;
        }
        bsum += __shfl_xor(bsum, 1); bsum += __shfl_xor(bsum, 2);
        if (r == 0) wsum[F.wave * 16 + h] = bsum;
        __syncthreads();
        if (F.tid < 16) { float s = 0.f;
#pragma unroll
            for (int w = 0; w < NWAVES; ++w) s += wsum[w * 16 + F.tid];
            F.BLKSUM()[blk * 16 + F.tid] = s; }
        __syncthreads();
    }
}
__device__ __forceinline__ void final_norm_phase(Frame& F, const RowSrc& RS, float* dst) {
    const int gw = F.vcu * NWAVES + F.wave, NGW = F.G * NWAVES;
    f32x4 g[4];
#pragma unroll
    for (int j = 0; j < 4; ++j) g[j] = ((const f32x4*)kin<I_FINN>())[F.lane + 64 * j];
    for (int m0 = gw * 4; m0 < MH; m0 += NGW * 4) {
        f32x4 v[4][4]; float inv[4];
#pragma unroll
        for (int r = 0; r < 4; ++r) row_load(RS, (size_t)(m0 + r), F.lane, v[r]);
#pragma unroll
        for (int r = 0; r < 4; ++r) { float s = 0.f;
#pragma unroll
            for (int j = 0; j < 4; ++j) s += (v[r][j].x * v[r][j].x + v[r][j].y * v[r][j].y) + (v[r][j].z * v[r][j].z + v[r][j].w * v[r][j].w);
            inv[r] = 1.0f / sqrtf(wave_sum(s) * (1.0f / D) + RMS_EPS); }
#pragma unroll
        for (int r = 0; r < 4; ++r)
#pragma unroll
            for (int j = 0; j < 4; ++j) ((f32x4*)(dst + (size_t)(m0 + r) * D) + F.lane)[64 * j] = v[r][j] * inv[r] * g[j];
    }
}
__device__ __forceinline__ void build_tile_table(Frame& F, const unsigned* cnt) {
    LAS int* tbl = (LAS int*)(F.lds + TBL_OFF);
    LAS int* cn = (LAS int*)(F.lds + RING_OFF);
    if (F.tid < NBUCKET) cn[F.tid] = (int)__hip_atomic_load(cnt + F.tid, RLX_AGENT);
    __syncthreads();
    if (F.tid == 0) { int ntl = 0; for (int b = 0; b < NBUCKET; ++b) { cn[32 + b] = ntl; ntl += (cn[b] + 255) >> 8; } tbl[0] = ntl < MAXTILES ? ntl : MAXTILES; }
    __syncthreads();
    if (F.tid < NBUCKET) { const int b = F.tid, g = b / 6, p = b % 6, lo = p < 3 ? 0 : (p < 5 ? 1 : 2), hi = p < 3 ? p + 1 : (p < 5 ? p - 1 : 3), n = cn[b]; int t = cn[32 + b];
        for (int k = 0; k * 256 < n && t < MAXTILES; ++k, ++t) { tbl[1 + 3 * t] = (g * 4 + lo) | ((g * 4 + hi) << 8); tbl[2 + 3 * t] = (n - 256 * k) < 256 ? (n - 256 * k) : 256; tbl[3 + 3 * t] = b * BCAP + 256 * k; } }
    __syncthreads();
}
__device__ __forceinline__ void fscan_phase(Frame& F) {
    LAS float* bs = (LAS float*)(F.lds + RING_OFF);
    LAS float* sg = bs + 16;
    for (int blk = F.vcu; blk < NBLK; blk += F.G) {
        const int b = blk >> 6, first = b * 64, tid = F.tid;
        { LAS float* ps = sg + 128;
          for (int i = tid; i < 64 * 16; i += NWAVES * 64) { const int j = first + (i >> 4); ps[i] = j < blk ? F.BLKSUM()[j * 16 + (i & 15)] : 0.f; }
          __syncthreads();
          if (tid < 16) { float s = 0.f; for (int j = 0; j < 64; ++j) s += ps[j * 16 + tid]; bs[tid] = s; } }
        const int h = tid & 15, seg = tid >> 4;
        float v[16];
        if (tid < 128) { float s = 0.f;
#pragma unroll
            for (int k = 0; k < 16; ++k) { v[k] = F.LF()[(size_t)(blk * 128 + seg * 16 + k) * 16 + h]; s += v[k]; }
            sg[seg * 16 + h] = s; }
        __syncthreads();
        if (tid < 128) { float run = bs[h]; for (int s2 = 0; s2 < seg; ++s2) run += sg[s2 * 16 + h];
            float* fo = F.FM() + (size_t)(b * 16 + h) * T + (blk & 63) * 128 + seg * 16;
#pragma unroll
            for (int k = 0; k < 16; ++k) { run += v[k]; fo[k] = run; } }
        __syncthreads();
    }
}
struct Args { const float* in[20]; float* out; unsigned char* ws; };
__global__ void __launch_bounds__(NWAVES * 64, 2) yoco_fwd(Args args) {
    extern __shared__ __attribute__((aligned(16))) unsigned char lds[];
    Frame F;
    F.lds = (LAS unsigned char*)lds;
    F.MISC = (volatile LAS unsigned*)(F.lds + MISC_OFF);
    F.tid = threadIdx.x; F.lane = F.tid & 63; F.wave = __builtin_amdgcn_readfirstlane(F.tid >> 6);
    const int GA = gridDim.x, bx = blockIdx.x, li = bx >> 1;
    F.half = bx & 1; F.G = GA >> 1; F.vcu = (F.G % 4 == 0) ? (li % 4) * (F.G / 4) + li / 4 : li;
    unsigned char* ws = args.ws;
    F.ws = ws; F.out = args.out + (size_t)F.half * MH * D;
    gu32* const ctl = (gu32*)(ws + WS_CTL);
    { int t0 = threadIdx.x; asm volatile("" : "+v"(t0));
      for (int u = t0; u < (LDS_BYTES - LDSCTL_OFF) / 4; u += NWAVES * 64) ((LAS unsigned*)(F.lds + LDSCTL_OFF))[u] = 0u; }
    __syncthreads();
    const XcdBarrier barAll = xcd_barrier_post((unsigned*)(ctl + CW_BAR), F.MISC + 8, (unsigned)GA);
    const XcdBarrier bar = xcd_barrier_post((unsigned*)(ctl + CW_BARH) + F.half * XCD_BAR_WORDS, F.MISC + 12, (unsigned)F.G);
    unsigned* const cnt0 = (unsigned*)(ctl + CW_CNT + 64 * (2 * F.half)); unsigned* const cnt1 = cnt0 + 64;
    unsigned* const nq = (unsigned*)(ctl + CW_NRM) + F.half * 2048; unsigned* const nk = (unsigned*)(ctl + CW_NRM) + 4096 + F.half * 64;

#ifndef PH_MASK
#define PH_MASK 0x7fff
#endif
#define IN(k) ((PH_MASK >> (k)) & 1)
#define RETID() Frame Fq = F; { int t_ = threadIdx.x; asm volatile("" : "+v"(t_)); Fq.tid = t_; Fq.lane = t_ & 63; }
#define SEAM(k) do { xcd_barrier(bar); } while (0)
    PG8_LAS unsigned char* ring = F.lds + RING_OFF;

    if (IN(0)) { RETID();
        p0_convert(Fq, 0, CONV_EARLY, bx * NWAVES + Fq.wave, GA * NWAVES);
        p0_small(Fq, bx * (NWAVES * 64) + Fq.tid, GA * NWAVES * 64);
        xcd_barrier(barAll);
        if (Fq.half == 1) {
            p0_convert(Fq, CONV_EARLY, CONV_ALL, li * NWAVES + Fq.wave, Fq.G * NWAVES);
            asm volatile("s_waitcnt vmcnt(0)" ::: "memory"); __syncthreads();
            if (Fq.tid == 0) { __builtin_amdgcn_fence(__ATOMIC_RELEASE, "agent"); asm volatile("s_waitcnt vmcnt(0)" ::: "memory"); __hip_atomic_fetch_add((unsigned*)(ctl + CW_CONV), 1u, RLX_AGENT); }
        }
        p0_pool_diff(Fq);
    } SEAM(0);

    if (IN(1)) { RETID();
        pg8::StaticOrder S; S.init(MH, D, Fq.G, li, 4);
        pg8::AdRow ad{(const char*)Fq.XN(), (const char*)Fq.WPOOL(), D, 256, 256};
        pg8::EpiBf16 E{Fq.DPOOL(), D, 0, 0, 1.f, nullptr, nullptr};
        pg8::gemm_phase<pg8::EpiBf16, pg8::StaticOrder, pg8::AdRow, true>(ring, 4, S, E, ad);
    } SEAM(1);

    if (IN(2)) { RETID(); const RowSrc RS{Fq.X(), Fq.DPOOL(), nullptr, nullptr, nullptr}; row_router_phase(Fq, 0, RS, cnt0); } SEAM(2);
    if (IN(4)) { RETID();
        build_tile_table(Fq, cnt0);
        pg8::MoeOrder S{(const PG8_LAS int*)(Fq.lds + TBL_OFF), Fq.G, Fq.vcu};
        pg8::AdMoeUp ad{(const char*)Fq.XN(), Fq.TOKROW(), (const char*)Fq.WG(), (const char*)Fq.WU(), D, D};
        pg8::EpiMoeH E{Fq.HMID(), Fq.GATEROW()};
        pg8::gemm_phase<pg8::EpiMoeH, pg8::MoeOrder, pg8::AdMoeUp, true>(ring, 16, S, E, ad);
    } SEAM(4);
    if (F.half == 0) {
        if (F.tid == 0) { unsigned sp = 0; while (__hip_atomic_load((unsigned*)(ctl + CW_CONV), RLX_AGENT) < (unsigned)F.G) { __builtin_amdgcn_s_sleep(2); if (++sp > (1u << 22)) break; }
            __builtin_amdgcn_fence(__ATOMIC_ACQUIRE, "agent"); asm volatile("s_waitcnt vmcnt(0)" ::: "memory"); }
        __syncthreads();
    }
    if (IN(5)) { RETID();
        build_tile_table(Fq, cnt0);
        pg8::MoeOrder S{(const PG8_LAS int*)(Fq.lds + TBL_OFF), Fq.G, Fq.vcu};
        pg8::AdMoeDown ad{(const char*)Fq.HMID(), (const char*)Fq.WD(), 512, 256};
        pg8::EpiMoeOutBf16 E{Fq.Y0(), Fq.TOKROW(), Fq.TRASH()};
        pg8::gemm_phase<pg8::EpiMoeOutBf16, pg8::MoeOrder, pg8::AdMoeDown, true>(ring, 8, S, E, ad);
    } SEAM(5);

    if (IN(6)) { RETID(); const RowSrc RS{Fq.X(), Fq.DPOOL(), Fq.Y0(), nullptr, nullptr}; row_forget_phase(Fq, RS); } SEAM(6);
    if (IN(7)) { RETID();
        fscan_phase(Fq);
        pg8::StaticOrder S; S.init(MH, NQKV, Fq.G, li, 4);
        pg8::AdRow ad{(const char*)Fq.XN(), (const char*)Fq.WQKV(), D, D, 0};
        pg8::EpiBf16 E{Fq.QO(), D, D, (size_t)(WS_K - WS_QO) / 2, attn_body::C2, nq, nk};
        pg8::gemm_phase<pg8::EpiBf16, pg8::StaticOrder, pg8::AdRow, true>(ring, 16, S, E, ad);
    } SEAM(7);

    if (IN(8)) { RETID();
        static_assert(attn_body::ATTN_LDS_BYTES <= RING_BYTES && attn_body::ATTN_PITCH == D && attn_body::BATCH == BH, "attention body geometry vs frame");
        const attn_body::AttnTensors AT{(const attn_body::bf16*)Fq.QO(), (const attn_body::bf16*)Fq.KB(), (const attn_body::bf16*)Fq.VB(), (attn_body::bf16*)Fq.XN(), Fq.FM(), nq, nk};
        attn_body::attn_phase<>((char*)lds + RING_OFF, AT, (unsigned*)(ctl + CW_ATQ + 64 * Fq.half));
    } SEAM(8);

    if (IN(9)) { RETID();
        pg8::StaticOrder S; S.init(MH, D, Fq.G, li, 4);
        pg8::AdRow ad{(const char*)Fq.XN(), (const char*)Fq.WO(), D, D, 0};
        pg8::EpiBf16 E{Fq.DATT(), D, 0, 0, 1.f, nullptr, nullptr};
        pg8::gemm_phase<pg8::EpiBf16, pg8::StaticOrder, pg8::AdRow, true>(ring, 16, S, E, ad);
    } SEAM(9);

    if (IN(10)) { RETID(); const RowSrc RS{Fq.X(), Fq.DPOOL(), Fq.Y0(), Fq.DATT(), Fq.H3B()}; row_router_phase(Fq, 1, RS, cnt1); } SEAM(10);
    if (IN(12)) { RETID();
        build_tile_table(Fq, cnt1);
        pg8::MoeOrder S{(const PG8_LAS int*)(Fq.lds + TBL_OFF), Fq.G, Fq.vcu};
        pg8::AdMoeUp ad{(const char*)Fq.XN(), Fq.TOKROW(), (const char*)(Fq.WG() + (size_t)NEXP * DEXP * D), (const char*)(Fq.WU() + (size_t)NEXP * DEXP * D), D, D};
        pg8::EpiMoeH E{Fq.HMID(), Fq.GATEROW()};
        pg8::gemm_phase<pg8::EpiMoeH, pg8::MoeOrder, pg8::AdMoeUp, true>(ring, 16, S, E, ad);
    } SEAM(12);
    if (IN(13)) { RETID();
        build_tile_table(Fq, cnt1);
        pg8::MoeOrder S{(const PG8_LAS int*)(Fq.lds + TBL_OFF), Fq.G, Fq.vcu};
        pg8::AdMoeDown ad{(const char*)Fq.HMID(), (const char*)(Fq.WD() + (size_t)NEXP * DEXP * D), 512, 256};
        pg8::EpiMoeOutBf16 E{Fq.Y1(), Fq.TOKROW(), Fq.TRASH()};
        pg8::gemm_phase<pg8::EpiMoeOutBf16, pg8::MoeOrder, pg8::AdMoeDown, true>(ring, 8, S, E, ad);
    } SEAM(13);

    if (IN(14)) { RETID(); const RowSrc RS{nullptr, Fq.H3B(), Fq.Y1(), nullptr, nullptr}; final_norm_phase(Fq, RS, Fq.out); }
#undef IN
#undef SEAM
}

extern "C" void kernel_launch(void* const* d_in, const int* in_sizes, int n_in, void* d_out, int out_size, void* d_ws, size_t ws_size, hipStream_t stream) {
    static int grid = 0;
    if (grid == 0) {
        if (n_in != 20 || in_sizes[0] != M * D || out_size != M * D || ws_size < WS_END) { fprintf(stderr, "kernel_launch: unexpected shapes (n_in %d, in0 %d, out %d, ws %zu); nothing launched\n", n_in, n_in > 0 ? in_sizes[0] : -1, out_size, ws_size); grid = -1; return; }
        int dev = 0, cus = 0, per_cu = 0;
        if (hipGetDevice(&dev) != hipSuccess || hipDeviceGetAttribute(&cus, hipDeviceAttributeMultiprocessorCount, dev) != hipSuccess) { fprintf(stderr, "kernel_launch: hipGetDevice / hipDeviceGetAttribute failed\n"); grid = -1; return; }
        if (hipFuncSetAttribute((const void*)yoco_fwd, hipFuncAttributeMaxDynamicSharedMemorySize, LDS_BYTES) != hipSuccess) { fprintf(stderr, "kernel_launch: hipFuncSetAttribute failed\n"); grid = -1; return; }
        if (hipOccupancyMaxActiveBlocksPerMultiprocessor(&per_cu, (const void*)yoco_fwd, NWAVES * 64, LDS_BYTES) != hipSuccess || per_cu < 1)
            fprintf(stderr, "kernel_launch: note: occupancy query reports %d workgroups per CU\n", per_cu);
        (void)hipGetLastError();
        grid = cus & ~1;
    }
    if (grid < 0) return;
    if (hipMemsetAsync((char*)d_ws + WS_CTL, 0, CTL_ZERO_BYTES, stream) != hipSuccess) { fprintf(stderr, "kernel_launch: hipMemsetAsync failed\n"); return; }
    Args a{};
    for (int i = 0; i < 20; ++i) a.in[i] = (const float*)d_in[i];
    a.out = (float*)d_out; a.ws = (unsigned char*)d_ws;
    hipLaunchKernelGGL(yoco_fwd, dim3(grid), dim3(NWAVES * 64), LDS_BYTES, stream, a);
    const hipError_t le = hipPeekAtLastError();
    if (le != hipSuccess) fprintf(stderr, "kernel_launch: launch failed: %s\n", hipGetErrorName(le));
}
```

```cpp
#include <hip/hip_runtime.h>
#include <hip/hip_bf16.h>
#include <cstdio>
#include <cstdint>
#include <cmath>
namespace pg8 {
#define PG8_LAS __attribute__((address_space(3)))
typedef unsigned short bf16_t;
typedef short bf16x8 __attribute__((ext_vector_type(8)));
typedef float f32x4 __attribute__((ext_vector_type(4)));
typedef unsigned u32x4 __attribute__((ext_vector_type(4)));
constexpr int BM = 256, BK = 64, HALF = 128, HTB = HALF * BK * 2  , STAGE_BYTES = 8 * HTB, NXCD = 8, WGM = 8;

__host__ __device__ __forceinline__ int lds_byte(int r, int c) { const int st = (r >> 4) * 2 + (c >> 5), rr = r & 15, cc = c & 31, ob = rr * 64 + cc * 2; return st * 1024 + (ob ^ (((ob >> 9) & 1) << 5)); }
__host__ __device__ __forceinline__ void stage_rc(int b, int& R, int& C) { const int st = b / 1024, sb = b % 1024, swz = sb ^ (((sb >> 9) & 1) << 5); R = (st >> 1) * 16 + swz / 64; C = (st & 1) * 32 + (swz % 64) / 2; }
__host__ __device__ __forceinline__ int perm32(int rho) { const int n = rho >> 4, i = rho & 15; return 8 * (i >> 2) + 4 * n + (i & 3); }

struct Unit { int pm, pn, x0, x1, x2; };

struct StaticOrder {
    int nM, nN, nwg, G, c, nx;
    __device__ __forceinline__ void init(int M, int N, int G_, int c_, int nx_) { nM = M / BM; nN = N / BM; nwg = nM * nN; G = G_; c = c_; nx = nx_; }
    __device__ __forceinline__ bool next(int i, Unit& u) const {
        const long L = (long)i * G + c; if (L >= nwg) return false;
        int wgid = (int)L; { const int q = nwg / nx, r = nwg % nx, xcd = wgid % nx, off = wgid / nx; wgid = (xcd < r ? xcd * (q + 1) : r * (q + 1) + (xcd - r) * q) + off; }
        const int nig = WGM * nN, gid = wgid / nig, fm = gid * WGM, gsz = (nM - fm) < WGM ? (nM - fm) : WGM;
        u.pm = fm + ((wgid % nig) % gsz); u.pn = (wgid % nig) / gsz; u.x0 = 0; u.x1 = 0; u.x2 = 0; return true;
    }
};
struct MoeOrder {
    const PG8_LAS int* tbl; int G, c;
    __device__ __forceinline__ bool next(int i, Unit& u) const {
        const int L = i * G + c; const int ntl = __builtin_amdgcn_readfirstlane(tbl[0]);
        if (L >= ntl * 4) return false;
        const int rt = L >> 2; u.pm = rt; u.pn = L & 3; u.x0 = __builtin_amdgcn_readfirstlane(tbl[1 + 3 * rt]); u.x1 = __builtin_amdgcn_readfirstlane(tbl[2 + 3 * rt]); u.x2 = __builtin_amdgcn_readfirstlane(tbl[3 + 3 * rt]); return true;
    }
};

struct AdRow {
    static constexpr bool GATHER = false;
    const char* abase; const char* bbase; int lda, ldb, acolpn;
    __device__ __forceinline__ const char* a_ptr(const Unit& u, int h, int kt) const { return abase + ((size_t)(u.pm * BM + h * HALF) * lda + u.pn * acolpn) * 2 + (size_t)kt * (BK * 2); }
    __device__ __forceinline__ void a_offs(const Unit&, const int (&)[2], const int (&)[2], unsigned (&)[2][2]) const {}
    __device__ __forceinline__ const char* b_ptr(const Unit& u, int h, int kt) const { return bbase + (size_t)(u.pn * BM + h * HALF) * ldb * 2 + (size_t)kt * (BK * 2); }
};
struct AdMoeUp {
    static constexpr bool GATHER = true;
    const char* abase; const int* tokrow; const char* wg; const char* wu; int lda, ldb;
    __device__ __forceinline__ const char* a_ptr(const Unit&, int, int kt) const { return abase + (size_t)kt * (BK * 2); }
    __device__ __forceinline__ void a_offs(const Unit& u, const int (&R)[2], const int (&C)[2], unsigned (&v)[2][2]) const {
#pragma unroll
        for (int h = 0; h < 2; ++h)
#pragma unroll
            for (int i = 0; i < 2; ++i) { const int rl = h * HALF + R[i]; const int tok = rl < u.x1 ? tokrow[u.x2 + rl] : 0; v[h][i] = (unsigned)(tok * 1024 + C[i]) * 2u; }
    }
    __device__ __forceinline__ const char* b_ptr(const Unit& u, int h, int kt) const {
        const int e = (u.pn >> 1) ? ((u.x0 >> 8) & 0xff) : (u.x0 & 0xff);
        return (h ? wu : wg) + (size_t)(e * 256 + (u.pn & 1) * HALF) * 1024 * 2 + (size_t)kt * (BK * 2);
    }
};
struct AdMoeDown {
    static constexpr bool GATHER = false;
    const char* abase; const char* wd; int lda, ldb;
    __device__ __forceinline__ const char* a_ptr(const Unit& u, int h, int kt) const { return abase + (size_t)(u.pm * BM + h * HALF) * 512 * 2 + (size_t)kt * (BK * 2); }
    __device__ __forceinline__ void a_offs(const Unit&, const int (&)[2], const int (&)[2], unsigned (&)[2][2]) const {}
    __device__ __forceinline__ const char* b_ptr(const Unit& u, int h, int kt) const {
        const int e = (kt >> 2) ? ((u.x0 >> 8) & 0xff) : (u.x0 & 0xff);
        return wd + (size_t)(e * 1024 + u.pn * BM + h * HALF) * 256 * 2 + (size_t)(kt & 3) * (BK * 2);
    }
};

__device__ __forceinline__ unsigned cvt_pk_bf16(float lo, float hi) { unsigned r; asm volatile("v_cvt_pk_bf16_f32 %0, %1, %2" : "=v"(r) : "v"(lo), "v"(hi)); return r; }

struct EpiBf16 {
    static constexpr bool PERM = true;
    bf16_t* O; int ldc; int split_cols; size_t split_stride; float scale0; unsigned* nq; unsigned* nk;
    __device__ __forceinline__ void operator()(const f32x4 (&acc)[2][2][4][2], const Unit& u, int wr, int wc, int fr, int fq) const {
        const int row0 = u.pm * BM + wr * 64 + fr; int colt = u.pn * BM; bf16_t* base = O; int t = 0;
        float sc = 1.f; if (split_cols) { t = colt / split_cols; base += (size_t)t * split_stride; colt -= t * split_cols; if (t == 0) sc = scale0; }
        const int col0 = colt + wc * 32 + 8 * fq;
#pragma unroll
        for (int ai = 0; ai < 2; ++ai)
#pragma unroll
            for (int m = 0; m < 4; ++m) { bf16_t* rowp = base + (size_t)(row0 + ai * HALF + m * 16) * ldc + col0;
#pragma unroll
                for (int bj = 0; bj < 2; ++bj) { f32x4 v0 = acc[ai][bj][m][0] * sc, v1 = acc[ai][bj][m][1] * sc;
                    u32x4 w; w.x = cvt_pk_bf16(v0[0], v0[1]); w.y = cvt_pk_bf16(v0[2], v0[3]); w.z = cvt_pk_bf16(v1[0], v1[1]); w.w = cvt_pk_bf16(v1[2], v1[3]);
                    *(u32x4*)(rowp + bj * HALF) = w; } }
        if (nq && t < 2) {
#pragma unroll
            for (int bj = 0; bj < 2; ++bj) { float mx = 0.f;
#pragma unroll
                for (int ai = 0; ai < 2; ++ai)
#pragma unroll
                    for (int m = 0; m < 4; ++m) { const f32x4 v0 = acc[ai][bj][m][0] * sc, v1 = acc[ai][bj][m][1] * sc;
                        float s = (v0[0] * v0[0] + v0[1] * v0[1]) + (v0[2] * v0[2] + v0[3] * v0[3]) + (v1[0] * v1[0] + v1[1] * v1[1]) + (v1[2] * v1[2] + v1[3] * v1[3]);
                        s += __shfl_xor(s, 16); s += __shfl_xor(s, 32); mx = fmaxf(mx, s); }
                mx = fmaxf(mx, __shfl_xor(mx, 1)); mx = fmaxf(mx, __shfl_xor(mx, 2)); mx = fmaxf(mx, __shfl_xor(mx, 4)); mx = fmaxf(mx, __shfl_xor(mx, 8));
                if (fr == 0 && fq == 0) { const int head = (colt >> 8) * 4 + 2 * bj + (wc >> 1), half = wc & 1;
                    unsigned* p = t == 0 ? nq + ((u.pm * 16 + head) * 2 + half) : nk + (((u.pm >> 5) * 16 + head) * 2 + half);
                    __hip_atomic_fetch_max(p, __float_as_uint(mx), __ATOMIC_RELAXED, __HIP_MEMORY_SCOPE_AGENT); } }
        }
    }
};
struct EpiResF32 {
    static constexpr bool PERM = false;
    const float* base; float* out; int ldc;
    __device__ __forceinline__ void operator()(const f32x4 (&acc)[2][2][4][2], const Unit& u, int wr, int wc, int fr, int fq) const {
        const size_t off0 = (size_t)(u.pm * BM + wr * 64 + fr) * ldc + u.pn * BM + wc * 32 + 4 * fq;
        f32x4 buf[3][4];
#define PG8_RES_LOAD(g) do { const size_t o_ = off0 + (size_t)(((g) >> 2) * HALF + ((g) & 3) * 16) * ldc; _Pragma("unroll") for (int q_ = 0; q_ < 4; ++q_) buf[(g) % 3][q_] = *(const f32x4*)(base + o_ + (q_ >> 1) * HALF + (q_ & 1) * 16); } while (0)
        PG8_RES_LOAD(0); PG8_RES_LOAD(1);
#pragma unroll
        for (int g = 0; g < 8; ++g) {
            if (g + 2 < 8) PG8_RES_LOAD(g + 2);
            const size_t o = off0 + (size_t)((g >> 2) * HALF + (g & 3) * 16) * ldc;
#pragma unroll
            for (int q = 0; q < 4; ++q) *(f32x4*)(out + o + (q >> 1) * HALF + (q & 1) * 16) = buf[g % 3][q] + acc[g >> 2][q >> 1][g & 3][q & 1];
            asm volatile("" ::: "memory");
        }
#undef PG8_RES_LOAD
    }
};
__device__ __forceinline__ float silu_mul(float g, float u) { return g * u * __builtin_amdgcn_rcpf(1.0f + __builtin_amdgcn_exp2f(-1.4426950408889634f * g)); }
struct EpiMoeH {
    static constexpr bool PERM = true;
    bf16_t* H; const float* gaterow;
    __device__ __forceinline__ void operator()(const f32x4 (&acc)[2][2][4][2], const Unit& u, int wr, int wc, int fr, int fq) const {
        const int half = u.pn >> 1, col0 = half * 256 + (u.pn & 1) * HALF + wc * 32 + 8 * fq;
#pragma unroll
        for (int ai = 0; ai < 2; ++ai)
#pragma unroll
            for (int m = 0; m < 4; ++m) { const int rl = ai * HALF + wr * 64 + m * 16 + fr, row = u.pm * BM + rl; const float gw = rl < u.x1 ? gaterow[(size_t)(u.x2 + rl) * 2 + half] : 0.f;
                const f32x4 g0 = acc[ai][0][m][0], g1 = acc[ai][0][m][1], u0 = acc[ai][1][m][0], u1 = acc[ai][1][m][1];
                u32x4 w; w.x = cvt_pk_bf16(silu_mul(g0[0], u0[0]) * gw, silu_mul(g0[1], u0[1]) * gw); w.y = cvt_pk_bf16(silu_mul(g0[2], u0[2]) * gw, silu_mul(g0[3], u0[3]) * gw);
                w.z = cvt_pk_bf16(silu_mul(g1[0], u1[0]) * gw, silu_mul(g1[1], u1[1]) * gw); w.w = cvt_pk_bf16(silu_mul(g1[2], u1[2]) * gw, silu_mul(g1[3], u1[3]) * gw);
                *(u32x4*)(H + (size_t)row * 512 + col0) = w; }
    }
};
struct EpiMoeOutBf16 {
    static constexpr bool PERM = true;
    bf16_t* Y; const int* tokrow; bf16_t* trash;
    __device__ __forceinline__ void operator()(const f32x4 (&acc)[2][2][4][2], const Unit& u, int wr, int wc, int fr, int fq) const {
        const int col0 = u.pn * BM + wc * 32 + 8 * fq, nvalid = u.x1;
#pragma unroll
        for (int ai = 0; ai < 2; ++ai)
#pragma unroll
            for (int m = 0; m < 4; ++m) { const int rl = ai * HALF + wr * 64 + m * 16 + fr; const int tok = rl < nvalid ? tokrow[u.x2 + rl] : 0;
                bf16_t* rowp = (rl < nvalid ? Y + (size_t)tok * 1024 : trash) + col0;
#pragma unroll
                for (int bj = 0; bj < 2; ++bj) { const f32x4 v0 = acc[ai][bj][m][0], v1 = acc[ai][bj][m][1];
                    u32x4 w; w.x = cvt_pk_bf16(v0[0], v0[1]); w.y = cvt_pk_bf16(v0[2], v0[3]); w.z = cvt_pk_bf16(v1[0], v1[1]); w.w = cvt_pk_bf16(v1[2], v1[3]);
                    *(u32x4*)(rowp + bj * HALF) = w; } }
    }
};

template <class Epi, class Sched, class AD, bool ALIGN_EPI>
__device__ __forceinline__ void gemm_phase(PG8_LAS unsigned char* lds, const int nt, const Sched& S, const Epi& E, const AD& ad) {
    int tid = threadIdx.x; asm volatile("" : "+v"(tid));
    const int wid = __builtin_amdgcn_readfirstlane(tid >> 6), lane = tid & 63, wr = wid >> 2, wc = wid & 3, fr = lane & 15, fq = lane >> 4;
    int Rs[2], Cs[2]; unsigned voffA[2], voffB[2];
#pragma unroll
    for (int i = 0; i < 2; ++i) { stage_rc(tid * 16 + i * 8192, Rs[i], Cs[i]); const int Rb = Epi::PERM ? ((Rs[i] & ~31) + perm32(Rs[i] & 31)) : Rs[i];
        voffA[i] = (unsigned)(Rs[i] * ad.lda + Cs[i]) * 2u; voffB[i] = (unsigned)(Rb * ad.ldb + Cs[i]) * 2u; }
    const unsigned ldsw = (unsigned)wid * 1024u;
    const int aoff = lds_byte(wr * 64 + fr, fq * 8), boff = lds_byte(wc * 32 + fr, fq * 8);
#define PG8_SA(b, h) (((b) * 2 + (h)) * HTB)
#define PG8_SB(b, h) ((4 + (b) * 2 + (h)) * HTB)
#define PG8_STAGE(bufoff, gbase, voff) do { _Pragma("unroll") for (int _i = 0; _i < 2; ++_i) \
        __builtin_amdgcn_global_load_lds((const unsigned*)((const char*)(gbase) + (voff)[_i]), (PG8_LAS unsigned*)(lds + (bufoff) + ldsw + _i * 8192), 16, 0, 0); } while (0)
#define PG8_STAGE_A(bufoff, U, h, kt, VG) do { if constexpr (AD::GATHER) PG8_STAGE(bufoff, ad.a_ptr(U, h, kt), (VG)[h]); else PG8_STAGE(bufoff, ad.a_ptr(U, h, kt), voffA); } while (0)
#define PG8_LDA(dst, b, h) do { _Pragma("unroll") for (int m = 0; m < 4; ++m) _Pragma("unroll") for (int k = 0; k < 2; ++k) dst[m][k] = *(const PG8_LAS bf16x8*)(lds + PG8_SA(b, h) + aoff + m * 2048 + k * 1024); } while (0)
#define PG8_LDB(dst, b, h) do { _Pragma("unroll") for (int n = 0; n < 2; ++n) _Pragma("unroll") for (int k = 0; k < 2; ++k) dst[n][k] = *(const PG8_LAS bf16x8*)(lds + PG8_SB(b, h) + boff + n * 2048 + k * 1024); } while (0)
#define PG8_MMA(ai, bj, At, Bt) do { __builtin_amdgcn_s_setprio(1); _Pragma("unroll") for (int m = 0; m < 4; ++m) _Pragma("unroll") for (int n = 0; n < 2; ++n) _Pragma("unroll") for (int k = 0; k < 2; ++k) \
        acc[ai][bj][m][n] = __builtin_amdgcn_mfma_f32_16x16x32_bf16(Bt[n][k], At[m][k], acc[ai][bj][m][n], 0, 0, 0); __builtin_amdgcn_s_setprio(0); } while (0)
#define PG8_WAIT_V(n) asm volatile("s_waitcnt vmcnt(" #n ")" ::: "memory")
#define PG8_WAIT_L(n) asm volatile("s_waitcnt lgkmcnt(" #n ")" ::: "memory")
#define PG8_BAR __builtin_amdgcn_s_barrier()
#define PG8_SCHED __builtin_amdgcn_sched_barrier(0)
    Unit cur, nxt; int ui = 0;
    if (!S.next(0, cur)) return;
    f32x4 acc[2][2][4][2];
#pragma unroll
    for (int a = 0; a < 2; ++a)
#pragma unroll
        for (int b = 0; b < 2; ++b)
#pragma unroll
            for (int m = 0; m < 4; ++m)
#pragma unroll
                for (int n = 0; n < 2; ++n) acc[a][b][m][n] = (f32x4){0.f, 0.f, 0.f, 0.f};
    bf16x8 At[4][2], B0[2][2], B1[2][2];
    unsigned vAc[2][2], vAn[2][2];
    ad.a_offs(cur, Rs, Cs, vAc);
    PG8_STAGE(PG8_SB(0, 0), ad.b_ptr(cur, 0, 0), voffB); PG8_STAGE(PG8_SB(0, 1), ad.b_ptr(cur, 1, 0), voffB); PG8_STAGE_A(PG8_SA(0, 0), cur, 0, 0, vAc); PG8_STAGE_A(PG8_SA(0, 1), cur, 1, 0, vAc);
    if (wr == 1) PG8_BAR;
    PG8_WAIT_V(2); PG8_BAR;
    PG8_STAGE(PG8_SB(1, 0), ad.b_ptr(cur, 0, 1), voffB); PG8_STAGE_A(PG8_SA(1, 0), cur, 0, 1, vAc); PG8_STAGE(PG8_SB(1, 1), ad.b_ptr(cur, 1, 1), voffB);
    PG8_WAIT_V(6); PG8_BAR;
    for (;;) {
        const bool has_next = S.next(ui + 1, nxt);
        if (!has_next) nxt = cur;
        if constexpr (AD::GATHER) {
            if (has_next) ad.a_offs(nxt, Rs, Cs, vAn);
            else {
#pragma unroll
                for (int h = 0; h < 2; ++h)
#pragma unroll
                    for (int i = 0; i < 2; ++i) vAn[h][i] = vAc[h][i]; } }
#pragma clang loop unroll(disable)
        for (int t = 0; t < nt; t += 2) {
            const bool last = (t == nt - 2);
            const Unit u2 = last ? nxt : cur; const int k2 = last ? 0 : t + 2, k3 = k2 + 1;
            unsigned v2[2][2];
            if constexpr (AD::GATHER) {
#pragma unroll
                for (int h = 0; h < 2; ++h)
#pragma unroll
                    for (int i = 0; i < 2; ++i) v2[h][i] = last ? vAn[h][i] : vAc[h][i]; }
            PG8_LDB(B0, 0, 0); PG8_LDB(B1, 0, 1); PG8_SCHED; PG8_LDA(At, 0, 0); PG8_STAGE_A(PG8_SA(1, 1), cur, 1, t + 1, vAc);
            PG8_WAIT_V(8); PG8_WAIT_L(0); PG8_BAR; PG8_MMA(0, 0, At, B0); PG8_MMA(0, 1, At, B1); PG8_BAR; PG8_SCHED;
            PG8_LDA(At, 0, 1); PG8_STAGE(PG8_SB(0, 0), ad.b_ptr(u2, 0, k2), voffB); PG8_STAGE(PG8_SB(0, 1), ad.b_ptr(u2, 1, k2), voffB); PG8_STAGE_A(PG8_SA(0, 0), u2, 0, k2, v2);
            PG8_WAIT_V(8); PG8_WAIT_L(0); PG8_BAR; PG8_MMA(1, 0, At, B0); PG8_MMA(1, 1, At, B1); PG8_BAR; PG8_SCHED;
            PG8_LDB(B0, 1, 0); PG8_LDB(B1, 1, 1); PG8_SCHED; PG8_LDA(At, 1, 0); PG8_STAGE_A(PG8_SA(0, 1), u2, 1, k2, v2);
            PG8_WAIT_V(8); PG8_WAIT_L(0); PG8_BAR; PG8_MMA(0, 0, At, B0); PG8_MMA(0, 1, At, B1); PG8_BAR; PG8_SCHED;
            PG8_LDA(At, 1, 1); PG8_STAGE(PG8_SB(1, 0), ad.b_ptr(u2, 0, k3), voffB); PG8_STAGE(PG8_SB(1, 1), ad.b_ptr(u2, 1, k3), voffB); PG8_STAGE_A(PG8_SA(1, 0), u2, 0, k3, v2);
            PG8_WAIT_V(8); PG8_WAIT_L(0); PG8_BAR; PG8_MMA(1, 0, At, B0); PG8_MMA(1, 1, At, B1); PG8_BAR; PG8_SCHED;
        }
        if constexpr (ALIGN_EPI) { if (wr == 0) PG8_BAR; }
        E(acc, cur, wr, wc, fr, fq);
        if (!has_next) break;
#pragma unroll
        for (int a = 0; a < 2; ++a)
#pragma unroll
            for (int b = 0; b < 2; ++b)
#pragma unroll
                for (int m = 0; m < 4; ++m)
#pragma unroll
                    for (int n = 0; n < 2; ++n) acc[a][b][m][n] = (f32x4){0.f, 0.f, 0.f, 0.f};
        cur = nxt; ++ui;
        if constexpr (AD::GATHER) {
#pragma unroll
            for (int h = 0; h < 2; ++h)
#pragma unroll
                for (int i = 0; i < 2; ++i) vAc[h][i] = vAn[h][i]; }
        if constexpr (ALIGN_EPI) { if (wr == 1) PG8_BAR; }
    }
    PG8_WAIT_V(0);
    if constexpr (!ALIGN_EPI) { if (wr == 0) PG8_BAR; }
    PG8_BAR;
#undef PG8_SA
#undef PG8_SB
#undef PG8_STAGE
#undef PG8_STAGE_A
#undef PG8_LDA
#undef PG8_LDB
#undef PG8_MMA
#undef PG8_WAIT_V
#undef PG8_WAIT_L
#undef PG8_BAR
#undef PG8_SCHED
}
}
namespace attn_body {
using bf16=__hip_bfloat16;
using bf16x8=__attribute__((ext_vector_type(8)))short;
using s16x4=__attribute__((ext_vector_type(4)))short;
using f32x16=__attribute__((ext_vector_type(16)))float;
using f32x2_t=__attribute__((ext_vector_type(2)))float;
using u32x4=__attribute__((ext_vector_type(4)))unsigned;
constexpr int BATCH=2,NHEAD=16,SEQ=8192,D=64,DM=NHEAD*D;
constexpr int NW=8,QBLK=32,QB=QBLK*NW,KVBLK=64,NQB=SEQ/QB;
constexpr int ATTN_PITCH=DM, ATTN_UNIT_ROWS=QB;
__device__ __forceinline__ int crow(int r,int hi){return (r&3)+8*(r>>2)+4*hi;}
#define SBAR() __builtin_amdgcn_sched_barrier(0)
__device__ __forceinline__ void cmask(f32x16&p0,f32x16&p1,int jb,int qrel,int hi){
  const float NEG=-INFINITY; int kb=64*jb+4*hi;
  #pragma unroll
  for(int r=0;r<16;++r){int kv=kb+(r&3)+8*(r>>2); if(kv>qrel)p0[r]=NEG; if(kv+32>qrel)p1[r]=NEG;}
}

constexpr int NSLOT=3, SLOTB=8192;
constexpr int LDS_K=0, LDS_V=NSLOT*SLOTB, LDS_WS=2*NSLOT*SLOTB, LDS_OST=LDS_WS+NW*64*4, LDS_BIAS=LDS_OST+NW*4096, LDS_TKT=LDS_BIAS+SEQ*4, LDS_BYTES=LDS_TKT+16;
constexpr float C2=0.125f*1.4426950408889634f;
__device__ __forceinline__ void glds16(const void*gsrc,unsigned lds_dst){unsigned keep;
  asm volatile("s_mov_b32 %0, m0\n\ts_mov_b32 m0, %2\n\ts_nop 0\n\tglobal_load_lds_dwordx4 %1, off\n\ts_mov_b32 m0, %0":"=&s"(keep):"v"(gsrc),"s"(lds_dst):"memory");}
__device__ __forceinline__ void glds16s(const void*sbase,unsigned voff,unsigned lds_dst){unsigned keep;
  asm volatile("s_mov_b32 %0, m0\n\ts_mov_b32 m0, %3\n\ts_nop 0\n\tglobal_load_lds_dwordx4 %1, %2\n\ts_mov_b32 m0, %0":"=&s"(keep):"v"(voff),"s"(sbase),"s"(lds_dst):"memory");}
__device__ __forceinline__ float max3f(float a,float b,float c){float r;asm("v_max3_f32 %0, %1, %2, %3":"=v"(r):"v"(a),"v"(b),"v"(c));return r;}
__device__ __forceinline__ float max2f(float a,float b){float r;asm("v_max_f32_e32 %0, %1, %2":"=v"(r):"v"(a),"v"(b));return r;}
__device__ __forceinline__ float fadd_s(float a,float b){float r;asm("v_add_f32_e32 %0, %1, %2":"=v"(r):"v"(a),"v"(b));return r;}
__device__ __forceinline__ float fsub_s(float a,float b){float r;asm("v_sub_f32_e32 %0, %1, %2":"=v"(r):"v"(a),"v"(b));return r;}
typedef float f32x2_t __attribute__((ext_vector_type(2))); typedef __bf16 bf16x2_t __attribute__((ext_vector_type(2)));
__device__ __forceinline__ unsigned cvtpk_s(float lo,float hi){f32x2_t v={lo,hi};bf16x2_t b=__builtin_convertvector(v,bf16x2_t);return __builtin_bit_cast(unsigned,b);}
#define WAIT_BAR(N) asm volatile("s_waitcnt vmcnt(" #N ") lgkmcnt(0)\n\ts_barrier":::"memory")

__device__ __forceinline__ void qkt(f32x16&p0,f32x16&p1,const char*Kslot,const bf16x8*qr,const f32x16&negm,int r32,int hi){
  const char*kb=Kslot+hi*1024+r32*16;
  #pragma unroll
  for(int d0=0;d0<4;++d0){
    const bf16x8 b0=*reinterpret_cast<const bf16x8*>(kb+d0*2048);
    const bf16x8 b1=*reinterpret_cast<const bf16x8*>(kb+d0*2048+512);
    if(d0==0){p0=__builtin_amdgcn_mfma_f32_32x32x16_bf16(b0,qr[0],negm,0,0,0);p1=__builtin_amdgcn_mfma_f32_32x32x16_bf16(b1,qr[0],negm,0,0,0);}
    else{p0=__builtin_amdgcn_mfma_f32_32x32x16_bf16(b0,qr[d0],p0,0,0,0);p1=__builtin_amdgcn_mfma_f32_32x32x16_bf16(b1,qr[d0],p1,0,0,0);}}
}
typedef __attribute__((address_space(3))) const char* lds_cptr;
typedef short v4i16_t __attribute__((ext_vector_type(4)));
__device__ __forceinline__ void kload8(bf16x8*kf,lds_cptr kp){
  kf[0]=*(const __attribute__((address_space(3))) bf16x8*)(kp);      kf[1]=*(const __attribute__((address_space(3))) bf16x8*)(kp+512);
  kf[2]=*(const __attribute__((address_space(3))) bf16x8*)(kp+2048); kf[3]=*(const __attribute__((address_space(3))) bf16x8*)(kp+2560);
  kf[4]=*(const __attribute__((address_space(3))) bf16x8*)(kp+4096); kf[5]=*(const __attribute__((address_space(3))) bf16x8*)(kp+4608);
  kf[6]=*(const __attribute__((address_space(3))) bf16x8*)(kp+6144); kf[7]=*(const __attribute__((address_space(3))) bf16x8*)(kp+6656);
}
__device__ __forceinline__ void kload2(bf16x8*kf,lds_cptr kp,int j){ kf[2*j]=*(const __attribute__((address_space(3))) bf16x8*)(kp+j*2048); kf[2*j+1]=*(const __attribute__((address_space(3))) bf16x8*)(kp+j*2048+512); }
__device__ __forceinline__ s16x4 vtr(lds_cptr p){ return __builtin_bit_cast(s16x4,__builtin_amdgcn_ds_read_tr16_b64_v4i16((__attribute__((address_space(3))) v4i16_t*)p)); }
__device__ __forceinline__ float rowmax(const f32x16&p0,const f32x16&p1){
  float a=max3f(p0[0],p0[1],p1[0]),b=max3f(p0[2],p0[3],p1[1]);a=max3f(a,p1[2],p1[3]);
  #pragma unroll
  for(int r=4;r<16;r+=4){a=max3f(a,p0[r],p0[r+1]);b=max3f(b,p0[r+2],p0[r+3]);a=max3f(a,p1[r],p1[r+1]);b=max3f(b,p1[r+2],p1[r+3]);}
  const float m=max2f(a,b);
  auto rr=__builtin_amdgcn_permlane32_swap(__float_as_uint(m),__float_as_uint(m),false,false);
  return max2f(__uint_as_float(rr[0]),__uint_as_float(rr[1]));
}
__device__ __forceinline__ void pv(f32x16*o,int vb,bf16x8 pa0,bf16x8 pa1,bf16x8 pa2,bf16x8 pa3){
  #pragma unroll
  for(int d0=0;d0<2;++d0){s16x4 lo[4],hi[4];
    #pragma unroll
    for(int ks=0;ks<4;++ks){
      asm volatile("ds_read_b64_tr_b16 %0,%1 offset:%c2":"=&v"(lo[ks]):"v"(vb),"i"(d0*4096+ks*1024):"memory");
      asm volatile("ds_read_b64_tr_b16 %0,%1 offset:%c2":"=&v"(hi[ks]):"v"(vb),"i"(d0*4096+ks*1024+512):"memory");}
    asm volatile("s_waitcnt lgkmcnt(0)":::"memory");SBAR();
    #define PK(k) (bf16x8){lo[k][0],lo[k][1],lo[k][2],lo[k][3],hi[k][0],hi[k][1],hi[k][2],hi[k][3]}
    o[d0]=__builtin_amdgcn_mfma_f32_32x32x16_bf16(pa0,PK(0),o[d0],0,0,0);
    o[d0]=__builtin_amdgcn_mfma_f32_32x32x16_bf16(pa1,PK(1),o[d0],0,0,0);
    o[d0]=__builtin_amdgcn_mfma_f32_32x32x16_bf16(pa2,PK(2),o[d0],0,0,0);
    o[d0]=__builtin_amdgcn_mfma_f32_32x32x16_bf16(pa3,PK(3),o[d0],0,0,0);
    #undef PK
  }
}

#ifndef ATTN_STORE16
#define ATTN_STORE16(p,v) (*(u32x4*)(p)=(v))
#endif
template<int THRL> __device__ __forceinline__ void attn_unit(int b,int h,int qb,const bf16*Q,const bf16*__restrict__ K,const bf16*__restrict__ V,bf16*O,const float*Fm,const unsigned*NQ,const unsigned*NK,unsigned*ctr,char*shm){
  int tid=threadIdx.x; asm volatile("":"+v"(tid));
  const int lane=tid&63,r32=lane&31,hi=lane>>5; const int wid=__builtin_amdgcn_readfirstlane(tid>>6);
  const long rowbase=(long)b*SEQ; const int q0=qb*QB;
  typedef __attribute__((address_space(3))) float lds_f32; typedef __attribute__((address_space(3))) const f32x2_t* lds_cf2;
  int t_start; const float*Fh=Fm+(long)(b*NHEAD+h)*SEQ; float fref;
  int tid2=tid; asm volatile("":"+v"(tid2));
  { fref=__hip_atomic_load(Fh+q0,__ATOMIC_RELAXED,__HIP_MEMORY_SCOPE_AGENT);
    const unsigned*nq=NQ+((b*NQB+qb)*NHEAD+h)*2; const unsigned*nk=NK+(b*NHEAD+h)*2;
    const float q2=__uint_as_float(__hip_atomic_load(nq,__ATOMIC_RELAXED,__HIP_MEMORY_SCOPE_AGENT))+__uint_as_float(__hip_atomic_load(nq+1,__ATOMIC_RELAXED,__HIP_MEMORY_SCOPE_AGENT));
    const float k2=__uint_as_float(__hip_atomic_load(nk,__ATOMIC_RELAXED,__HIP_MEMORY_SCOPE_AGENT))+__uint_as_float(__hip_atomic_load(nk+1,__ATOMIC_RELAXED,__HIP_MEMORY_SCOPE_AGENT));
    const float thr=43.3f+2.02f*sqrtf(q2*k2);
    const int NTf=(q0+QB)/KVBLK; int cnt=0;
    _Pragma("unroll") for(int jj=0;jj<2;++jj){ const int j=1+(tid2&63)+64*jj; bool ok=false; if(j<=NTf-4) ok=((fref-Fh[64*j-1])*1.4426950408889634f<=-thr); cnt+=__popcll(__ballot(ok)); }
    t_start=__builtin_amdgcn_readfirstlane(cnt&~1);
  }
  const lds_cf2 bias2=(lds_cf2)((__attribute__((address_space(3))) const char*)shm+LDS_BIAS)+2*hi+t_start*32;
  const bf16*Qw=Q+(rowbase+q0+wid*QBLK)*DM+h*D;
  const bf16*Kh=K+(rowbase+(long)t_start*KVBLK)*DM+h*D,*Vh=V+(rowbase+(long)t_start*KVBLK)*DM+h*D;
  const unsigned lds0=(unsigned)(uintptr_t)shm;
  float*wsf=(float*)(shm+LDS_WS)+wid*64;
  const bf16*ksrc=Kh+wid*8;
  const bf16*vsrc=Vh+(long)(16*(wid&3))*DM+(wid>>2)*32;
  const unsigned kvoff=(unsigned)lane*(DM*2), vvoff=(unsigned)((lane>>2)*DM+(lane&3)*8)*2u;
  const unsigned kdst=lds0+LDS_K+wid*1024, vdst=lds0+LDS_V+wid*1024;
  #define DMA_K(t,slot) glds16s(ksrc+(long)(t)*KVBLK*DM,kvoff,(unsigned)__builtin_amdgcn_readfirstlane(kdst+(slot)))
  #define DMA_V(t,slot) glds16s(vsrc+(long)(t)*KVBLK*DM,vvoff,(unsigned)__builtin_amdgcn_readfirstlane(vdst+(slot)))
  const char*Kbase=shm+LDS_K; bf16x8 kf[8];
  const lds_cptr shm3=(lds_cptr)shm; const lds_cptr kp0=shm3+LDS_K+hi*1024+r32*16; const lds_cptr vp0=shm3+LDS_V+((lane>>4)&1)*32+(lane&3)*8+(4*hi+((lane&15)>>2))*64;
  const int NT=(q0+QB)/KVBLK-t_start;
  DMA_K(0,0);DMA_V(0,0);DMA_K(1,SLOTB);
  bf16x8 qr[4];
  #pragma unroll
  for(int d0=0;d0<4;++d0)qr[d0]=*reinterpret_cast<const bf16x8*>(&Qw[(long)r32*DM+d0*16+hi*8]);
  { lds_f32*bl=(lds_f32*)((__attribute__((address_space(3))) char*)shm+LDS_BIAS);
    _Pragma("clang loop unroll(disable) vectorize(disable)")
    for(int s0=t_start*KVBLK+tid2;s0<q0+QB;s0+=4*NW*64){ float f_[4];
      _Pragma("unroll") for(int u_=0;u_<4;++u_){ const int s_=s0+u_*NW*64; f_[u_]=Fh[s_<q0+QB?s_:q0]; }
      _Pragma("unroll") for(int u_=0;u_<4;++u_){ const int s_=s0+u_*NW*64; if(s_<q0+QB)bl[s_]=(fref-f_[u_])*1.4426950408889634f; } } }
  float mhat=0.f,l_reg=0.f;f32x16 o[2];o[0]=f32x16{};o[1]=f32x16{};f32x16 negm=f32x16{};asm volatile("":"+v"(negm));
  const int qrel=wid*QBLK+r32;
  #define CMASK(P0,P1,t) do{int jb_=(t)-(NT-4); if(jb_>=0)cmask(P0,P1,jb_,qrel,hi);}while(0)
  #define BIASADD(P0,P1,t) do{ const lds_cf2 bp_=bias2+(t)*32; \
    _Pragma("unroll") for(int j_=0;j_<4;++j_){ \
      SBAR(); { const f32x2_t b_=bp_[4*j_];    P0[4*j_]+=b_[0];  P0[4*j_+1]+=b_[1]; } \
      SBAR(); { const f32x2_t b_=bp_[4*j_+1];  P0[4*j_+2]+=b_[0];P0[4*j_+3]+=b_[1]; } \
      SBAR(); { const f32x2_t b_=bp_[4*j_+16]; P1[4*j_]+=b_[0];  P1[4*j_+1]+=b_[1]; } \
      SBAR(); { const f32x2_t b_=bp_[4*j_+17]; P1[4*j_+2]+=b_[0];P1[4*j_+3]+=b_[1]; } } SBAR(); }while(0)
  bool resc=false;
  #define START(P0,P1) do{ const float rm=rowmax(P0,P1); resc=false; \
    { const float dl=rm; mhat=fadd_s(mhat,dl); \
      _Pragma("unroll") for(int r=0;r<16;++r){P0[r]=fsub_s(P0[r],dl);P1[r]=fsub_s(P1[r],dl);} \
      _Pragma("unroll") for(int r=0;r<16;++r)negm[r]=-mhat; asm volatile("":"+v"(negm)); } \
    _Pragma("unroll") for(int r=0;r<16;++r)P0[r]=__builtin_amdgcn_exp2f(P0[r]); }while(0)
  #define RESC() do{ if(resc){ asm volatile("s_waitcnt lgkmcnt(0)":::"memory"); \
      _Pragma("unroll") for(int d_=0;d_<2;++d_) _Pragma("unroll") for(int r=0;r<16;++r)o[d_][r]*=wsf[crow(r,hi)]; } }while(0)
  f32x16 pA0,pA1,pB0,pB1;
  int sl_prev=0,sl_cur=0,sl_next=SLOTB;
  #define ROT() do{sl_prev=sl_cur;sl_cur=sl_next;sl_next=(sl_next==(NSLOT-1)*SLOTB)?0:sl_next+SLOTB;}while(0)
  DMA_K(2,2*SLOTB);
  WAIT_BAR(3);
  qkt(pA0,pA1,Kbase,qr,negm,r32,hi);asm volatile("s_nop 15\n\ts_nop 7":"+v"(pA0),"+v"(pA1));BIASADD(pA0,pA1,0);CMASK(pA0,pA1,0);
  START(pA0,pA1);
  _Pragma("unroll") for(int r=0;r<16;++r)pA1[r]=__builtin_amdgcn_exp2f(pA1[r]);
  WAIT_BAR(0);
  DMA_K(3,0);DMA_V(1,SLOTB);
  ROT();
  kload8(kf,kp0+sl_cur);
  WAIT_BAR(2);
  s16x4 vlo[8],vhi[8]; u32x4 pw0,pw1,pw2,pw3;
  #define PKW(P,B) cvtpk_s(P[B],P[B+1])
  #define PAF(k) __builtin_bit_cast(bf16x8,pw##k)
  #define VFR(i) (bf16x8){vlo[i][0],vlo[i][1],vlo[i][2],vlo[i][3],vhi[i][0],vhi[i][1],vhi[i][2],vhi[i][3]}
  #define PIN(x) asm volatile("":"+v"(x))
  #define MX3(a,b,c) __builtin_fmaxf(__builtin_fmaxf((a),(b)),(c))
  #define GAPA(MF,A0,A1,A2,A3,W0,W1,PW) do{ MF; sacc+=A0; sacc+=A1; sacc+=A2; sacc+=A3; PIN(sacc); W0; W1; PIN(PW); SBAR(); }while(0)
  #define EX(v) __builtin_amdgcn_exp2f(v)
  #define GAPB(MF,X,B) do{ MF; X[B]=EX(X[B]); X[B+1]=EX(X[B+1]); X[B+2]=EX(X[B+2]); X[B+3]=EX(X[B+3]); PIN(X); SBAR(); }while(0)
  #define VRD(i) do{ vlo[i]=vtr(vp_+(((i)>>2)*4096+((i)&3)*1024)); vhi[i]=vtr(vp_+(((i)>>2)*4096+((i)&3)*1024+512)); }while(0)
  #define KRD(G,j) do{ if(G){ kload2(kf,kp0+sl_next,j); SBAR(); } }while(0)
  #define STEP(C0,C1,P0,P1,t,GK,GV,GL) do{ SBAR(); \
    const lds_cptr vp_=vp0+sl_prev; \
    VRD(0); SBAR(); float sacc=(P0[0]+P0[1]); \
    GAPA(C0=__builtin_amdgcn_mfma_f32_32x32x16_bf16(kf[0],qr[0],negm,0,0,0), P0[2],P0[3],P0[4],P0[5],     pw0[0]=PKW(P0,0), pw0[1]=PKW(P0,2), pw0); \
    VRD(4); SBAR(); GAPA(C1=__builtin_amdgcn_mfma_f32_32x32x16_bf16(kf[1],qr[0],negm,0,0,0), P0[6],P0[7],P0[8],P0[9],     pw0[2]=PKW(P0,4), pw0[3]=PKW(P0,6), pw0); \
    VRD(1); SBAR(); GAPA(C0=__builtin_amdgcn_mfma_f32_32x32x16_bf16(kf[2],qr[1],C0,0,0,0),   P0[10],P0[11],P0[12],P0[13], pw1[0]=PKW(P0,8), pw1[1]=PKW(P0,10), pw1); \
    VRD(5); SBAR(); GAPA(C1=__builtin_amdgcn_mfma_f32_32x32x16_bf16(kf[3],qr[1],C1,0,0,0),   P0[14],P0[15],P1[0],P1[1],   pw1[2]=PKW(P0,12),pw1[3]=PKW(P0,14), pw1); \
    VRD(2); SBAR(); GAPA(C0=__builtin_amdgcn_mfma_f32_32x32x16_bf16(kf[4],qr[2],C0,0,0,0),   P1[2],P1[3],P1[4],P1[5],     pw2[0]=PKW(P1,0), pw2[1]=PKW(P1,2), pw2); \
    VRD(6); SBAR(); GAPA(C1=__builtin_amdgcn_mfma_f32_32x32x16_bf16(kf[5],qr[2],C1,0,0,0),   P1[6],P1[7],P1[8],P1[9],     pw2[2]=PKW(P1,4), pw2[3]=PKW(P1,6), pw2); \
    VRD(3); SBAR(); GAPA(C0=__builtin_amdgcn_mfma_f32_32x32x16_bf16(kf[6],qr[3],C0,0,0,0),   P1[10],P1[11],P1[12],P1[13], pw3[0]=PKW(P1,8), pw3[1]=PKW(P1,10), pw3); \
    VRD(7); SBAR(); GAPA(C1=__builtin_amdgcn_mfma_f32_32x32x16_bf16(kf[7],qr[3],C1,0,0,0),   P1[14],P1[15],0.f,0.f,       pw3[2]=PKW(P1,12),pw3[3]=PKW(P1,14), pw3); \
    l_reg+=sacc; \
    if(GK){DMA_K((t)+3,sl_cur);} if(GV){DMA_V((t)+1,sl_next);} \
    BIASADD(C0,C1,t); CMASK(C0,C1,t); \
    { float a=MX3(C0[0],C0[1],C1[0]),b=MX3(C0[2],C0[3],C1[1]); a=MX3(a,C1[2],C1[3]); \
      _Pragma("unroll") for(int r=4;r<16;r+=4){a=MX3(a,C0[r],C0[r+1]);b=MX3(b,C0[r+2],C0[r+3]);a=MX3(a,C1[r],C1[r+1]);b=MX3(b,C1[r+2],C1[r+3]);} \
      float rm=__builtin_fmaxf(a,b); { auto rr=__builtin_amdgcn_permlane32_swap(__float_as_uint(rm),__float_as_uint(rm),false,false); rm=__builtin_fmaxf(__uint_as_float(rr[0]),__uint_as_float(rr[1])); } \
      resc=false; \
      if(__builtin_expect(__any(rm>(float)THRL),0)){ const float dl=__builtin_fmaxf(rm,0.f); mhat+=dl; \
        _Pragma("unroll") for(int r=0;r<16;++r){C0[r]-=dl;C1[r]-=dl;} \
        _Pragma("unroll") for(int r=0;r<16;++r)negm[r]=-mhat; asm volatile("":"+v"(negm)); \
        const float f=__builtin_amdgcn_exp2f(-dl); l_reg*=f; if(hi==0)wsf[r32]=f; resc=true; } } \
    SBAR(); \
    GAPB(o[0]=__builtin_amdgcn_mfma_f32_32x32x16_bf16(PAF(0),VFR(0),o[0],0,0,0), C0,0); \
    GAPB(o[1]=__builtin_amdgcn_mfma_f32_32x32x16_bf16(PAF(0),VFR(4),o[1],0,0,0), C0,4); \
    KRD(GL,0); GAPB(o[0]=__builtin_amdgcn_mfma_f32_32x32x16_bf16(PAF(1),VFR(1),o[0],0,0,0), C0,8); \
    KRD(GL,1); GAPB(o[1]=__builtin_amdgcn_mfma_f32_32x32x16_bf16(PAF(1),VFR(5),o[1],0,0,0), C0,12); \
    KRD(GL,2); GAPB(o[0]=__builtin_amdgcn_mfma_f32_32x32x16_bf16(PAF(2),VFR(2),o[0],0,0,0), C1,0); \
    KRD(GL,3); GAPB(o[1]=__builtin_amdgcn_mfma_f32_32x32x16_bf16(PAF(2),VFR(6),o[1],0,0,0), C1,4); \
    GAPB(o[0]=__builtin_amdgcn_mfma_f32_32x32x16_bf16(PAF(3),VFR(3),o[0],0,0,0), C1,8); \
    GAPB(o[1]=__builtin_amdgcn_mfma_f32_32x32x16_bf16(PAF(3),VFR(7),o[1],0,0,0), C1,12); \
    }while(0)
  int t=1;
  #undef CMASK
  #define CMASK(P0,P1,t) do{}while(0)
  for(;t+5<NT;t+=2){
    STEP(pB0,pB1,pA0,pA1,t,true,true,true);     WAIT_BAR(2); RESC(); ROT();
    STEP(pA0,pA1,pB0,pB1,t+1,true,true,true);   WAIT_BAR(2); RESC(); ROT();
  }
  #undef CMASK
  #define CMASK(P0,P1,t) do{int jb_=(t)-(NT-4); if(jb_>=0)cmask(P0,P1,jb_,qrel,hi);}while(0)
  #define ENDW(tt) do{ if((tt)+3<NT){WAIT_BAR(2);} else if((tt)+2<NT){WAIT_BAR(1);} else {WAIT_BAR(0);} }while(0)
  for(;t+1<NT;t+=2){
    STEP(pB0,pB1,pA0,pA1,t,(t+3<NT),(t+1<NT),(t+1<NT));       ENDW(t);   RESC(); ROT();
    STEP(pA0,pA1,pB0,pB1,t+1,(t+4<NT),(t+2<NT),(t+2<NT));     ENDW(t+1); RESC(); ROT();
  }
  STEP(pB0,pB1,pA0,pA1,NT-1,false,false,false); RESC();
  { float sacc=pB0[0]+pB0[1]; _Pragma("unroll") for(int r=2;r<16;++r)sacc+=pB0[r]; _Pragma("unroll") for(int r=0;r<16;++r)sacc+=pB1[r]; l_reg+=sacc;
    pw0=(u32x4){PKW(pB0,0),PKW(pB0,2),PKW(pB0,4),PKW(pB0,6)};pw1=(u32x4){PKW(pB0,8),PKW(pB0,10),PKW(pB0,12),PKW(pB0,14)};pw2=(u32x4){PKW(pB1,0),PKW(pB1,2),PKW(pB1,4),PKW(pB1,6)};pw3=(u32x4){PKW(pB1,8),PKW(pB1,10),PKW(pB1,12),PKW(pB1,14)};
    const int vb0=(int)(lds0+LDS_V)+((lane>>4)&1)*32+(lane&3)*8+(4*hi+((lane&15)>>2))*64;
    SBAR(); pv(o,vb0+sl_cur,PAF(0),PAF(1),PAF(2),PAF(3)); }
  #undef PKW
  #undef PAF
  #undef VFR
  #undef PIN
  #undef MX3
  #undef GAPA
  #undef GAPB
  #undef EX
  #undef VRD
  #undef KRD
  #undef STEP
  #undef ENDW
  unsigned tk_=0u; if(tid==0)tk_=__hip_atomic_fetch_add(ctr,1u,__ATOMIC_RELAXED,__HIP_MEMORY_SCOPE_AGENT);
  {auto rr=__builtin_amdgcn_permlane32_swap(__float_as_uint(l_reg),__float_as_uint(l_reg),false,false);l_reg=__uint_as_float(rr[0])+__uint_as_float(rr[1]);}
  if(hi==0)wsf[32+r32]=l_reg;asm volatile("s_waitcnt lgkmcnt(0)":::"memory");
  float rli[16];
  #pragma unroll
  for(int r=0;r<16;++r)rli[r]=__builtin_amdgcn_rcpf(wsf[32+crow(r,hi)]);
  bf16*Ow=O+(rowbase+q0+wid*QBLK)*DM+h*D;
  { bf16*stg=(bf16*)(shm+LDS_OST)+wid*2048;
    #pragma unroll
    for(int r=0;r<16;++r){const int orow=crow(r,hi);
      #pragma unroll
      for(int d0=0;d0<2;++d0)stg[orow*64+d0*32+r32]=__float2bfloat16(o[d0][r]*rli[r]);}
    asm volatile("s_waitcnt lgkmcnt(0)":::"memory");
    #pragma unroll
    for(int i=0;i<4;++i){const int row=i*8+(lane>>3),ch=lane&7; const u32x4 v=*(const u32x4*)(stg+row*64+ch*8); ATTN_STORE16(Ow+(long)row*DM+ch*8,v);} }
  if(tid==0)*(__attribute__((address_space(3))) unsigned*)((__attribute__((address_space(3))) char*)shm+LDS_TKT)=tk_;
  asm volatile("s_waitcnt lgkmcnt(0)\n\ts_barrier":::"memory");
  #undef DMA_K
  #undef BIASADD
  #undef DMA_V
  #undef CMASK
  #undef START
  #undef RESC
  #undef ROT
}
constexpr int ATTN_LDS_BYTES=LDS_BYTES;
struct AttnTensors { const bf16* Q; const bf16* K; const bf16* V; bf16* O; const float* F; const unsigned* NQ; const unsigned* NK; };
struct AttnUnit { int bh; int qb; };
struct StaticOrder {
  int vcu,G;
  __device__ __forceinline__ explicit StaticOrder(int grid,int vcu_):vcu(vcu_),G(grid){}
  __device__ __forceinline__ bool next(int i,AttnUnit&u)const{ const int quad=(i>>2)*G+vcu; if(quad>=BATCH*NHEAD*8)return false; const int s=quad&7,j=i&3; u.bh=quad>>3; u.qb=(j==0)?s:(j==1)?15-s:(j==2)?16+s:31-s; return true; }
  __device__ __forceinline__ void a_ready(const AttnUnit&)const{}
  __device__ __forceinline__ void done(const AttnUnit&)const{}
};
constexpr int NUNITS=BATCH*NHEAD*NQB;
template<int THRL=60> __device__ __forceinline__ void attn_phase(char*lds,const AttnTensors&T,unsigned*ctr){
  __attribute__((address_space(3))) unsigned*tkt=(__attribute__((address_space(3))) unsigned*)((__attribute__((address_space(3))) char*)lds+LDS_TKT);
  if(threadIdx.x==0)*tkt=__hip_atomic_fetch_add(ctr,1u,__ATOMIC_RELAXED,__HIP_MEMORY_SCOPE_AGENT);
  asm volatile("s_waitcnt vmcnt(0) lgkmcnt(0)\n\ts_barrier":::"memory");
  for(;;){ const unsigned n=(unsigned)__builtin_amdgcn_readfirstlane((int)*tkt); if(n>=(unsigned)NUNITS)break;
    const int bh=(int)(n&31u),qb=NQB-1-(int)(n>>5);
    attn_unit<THRL>(bh/NHEAD,bh%NHEAD,qb,T.Q,T.K,T.V,T.O,T.F,T.NQ,T.NK,ctr,lds); }
}
#undef SBAR
#undef WAIT_BAR
}
constexpr int NWAVES = 8;
#ifndef MK_PER_PHASE
#define MK_PER_PHASE 0
#endif
constexpr int NPHASE = 15;

constexpr int BATCH = 4, T = 8192, D = 1024, H = 16, HD = 64;
constexpr int M = BATCH * T;
constexpr int NQKV = 3 * D;
constexpr int MH = M / 2, BH = BATCH / 2;
constexpr int NEXP = 16, DEXP = 256, NBUCKET = 24, MAXTILES = 88, HROWS = MAXTILES * 256, BCAP = MH;
constexpr int NBLK = MH / 128;
constexpr float RMS_EPS = 1e-6f;

constexpr size_t MiB = 1u << 20, KiB = 1u << 10;
constexpr size_t WS_CTL = 0, CTL_ZERO_BYTES = 128 * KiB;
constexpr size_t WS_TOKINFO = 1 * MiB, WS_TOKGATE = WS_TOKINFO + 128 * KiB, WS_HIST = WS_TOKGATE + 256 * KiB, WS_TILETBL = WS_HIST + 32 * KiB, WS_TOKROW = WS_TILETBL + 4 * KiB,
                 WS_GATEROW = WS_TOKROW + 160 * KiB, WS_BLKSUM = WS_GATEROW + 320 * KiB, WS_RWG = WS_BLKSUM + 16 * KiB, WS_WFG = WS_RWG + 160 * KiB, WS_TRASH = WS_WFG + 64 * KiB, WS_SMALL_END = WS_TRASH + 4 * KiB;
static_assert(WS_SMALL_END <= 4 * MiB, "small tables");
constexpr size_t WS_LF = 4 * MiB, WS_FM = 6 * MiB;
constexpr size_t WS_WPOOL = 8 * MiB, WS_WQKV = 9 * MiB, WS_WO = 15 * MiB, WS_WG = 17 * MiB, WS_WU = 33 * MiB, WS_WD = 49 * MiB;
constexpr size_t WS_XN = 66 * MiB;
constexpr size_t WS_QO = 130 * MiB, WS_K = 194 * MiB, WS_V = 258 * MiB;
constexpr size_t WS_HMID = 322 * MiB, WS_Y0 = 370 * MiB, WS_DPOOL = 434 * MiB, WS_TOKROW2 = 498 * MiB, WS_GATEROW2 = 501 * MiB, WS_END = 508 * MiB;
static_assert(WS_HMID + (size_t)2 * HROWS * 512 * 2 <= WS_Y0 && WS_TOKROW2 + (size_t)2 * NBUCKET * BCAP * 4 <= WS_GATEROW2 && WS_GATEROW2 + (size_t)2 * NBUCKET * BCAP * 8 <= WS_END && WS_V - WS_K == WS_K - WS_QO, "d_ws map");
constexpr int CW_BAR = 4096;
constexpr int CW_NRM = 8192;
constexpr int CW_CNT = 12800;
constexpr int CW_CONV = 13120;
constexpr int CW_BARH = 16384;
constexpr int CW_ATQ = 12544;
static_assert(CW_NRM + 4096 + 128 <= CW_ATQ && (CW_BARH + 2 * 3456) * 4 <= (int)CTL_ZERO_BYTES, "CTL words inside the memset region");

constexpr int RING_OFF = 0, RING_BYTES = 131072;
constexpr int LDSCTL_OFF = RING_BYTES, MISC_OFF = LDSCTL_OFF + 320;
constexpr int TBL_OFF = RING_BYTES + 1024;
constexpr int LDS_BYTES = 147456;
static_assert(MISC_OFF + 128 <= TBL_OFF && TBL_OFF + (1 + 3 * MAXTILES) * 4 <= LDS_BYTES, "LDS map");

#define GAS __attribute__((address_space(1)))
#define LAS __attribute__((address_space(3)))
typedef unsigned short bf16;
typedef unsigned v4u __attribute__((ext_vector_type(4)));
typedef float f32x4 __attribute__((ext_vector_type(4)));
typedef float f32x2 __attribute__((ext_vector_type(2)));
typedef GAS unsigned gu32;
#define RLX_AGENT __ATOMIC_RELAXED, __HIP_MEMORY_SCOPE_AGENT
#define LDS_WAIT() asm volatile("s_waitcnt lgkmcnt(0)" ::: "memory")
__device__ __forceinline__ unsigned f2bf(float f) { unsigned u = __builtin_bit_cast(unsigned, f); return (u + 0x7fffu + ((u >> 16) & 1u)) >> 16; }
__device__ __forceinline__ unsigned pk2(float lo, float hi) { return f2bf(lo) | (f2bf(hi) << 16); }

#define XB_TMO      128
#define XB_XCNT(j)  (256  + 64 * (j))
#define XB_XSUB(j)  (1280 + 64 * (j))
#define XB_XGEN(j)  (2304 + 64 * (j))
#define XB_TOP      3328
#define XB_TOPGEN   3392
#define XCD_BAR_WORDS 3456
#define XB_SPIN_CAP (1u << 18)

__device__ __forceinline__ unsigned xb_ld(unsigned* p)              { return __hip_atomic_load(p, __ATOMIC_RELAXED, __HIP_MEMORY_SCOPE_AGENT); }
__device__ __forceinline__ unsigned xb_add(unsigned* p, unsigned v) { return __hip_atomic_fetch_add(p, v, __ATOMIC_RELAXED, __HIP_MEMORY_SCOPE_AGENT); }
__device__ __forceinline__ unsigned xb_xcc_id() { return (unsigned)__builtin_amdgcn_s_getreg((3 << 11) | 20) & 0xFu; }
#define XB_SPIN(cond, bar) do { unsigned _sp = 0; while (cond) { __builtin_amdgcn_s_sleep(1); \
    if ((++_sp & 255u) == 0u) { if (xb_ld(&(bar)[XB_TMO])) break; if (_sp > XB_SPIN_CAP) { atomicAdd(&(bar)[XB_TMO], 1u); break; } } } } while (0)

struct XcdBarrier {
    unsigned* bar; unsigned x; unsigned G;
    volatile LAS unsigned* st;
};

__device__ __forceinline__ XcdBarrier xcd_barrier_post(unsigned* bar, volatile LAS unsigned* st, unsigned G) {
    XcdBarrier b; b.bar = bar; b.x = xb_xcc_id(); b.st = st; b.G = G;
    if (threadIdx.x == 0) (void)xb_add(&bar[XB_XCNT(b.x)], 1u);
    return b;
}
__device__ __forceinline__ void xcd_barrier_complete(unsigned* bar, unsigned x, unsigned& nloc, unsigned& nx, const unsigned G) {
    unsigned sum, cnt, mine, sp = 0u;
    for (;;) {
        sum = 0u; cnt = 0u; mine = 0u;
#pragma unroll
        for (unsigned j = 0; j < 16; ++j) { const unsigned c = xb_ld(&bar[XB_XCNT(j)]); sum += c; cnt += (c > 0u) ? 1u : 0u; mine = (j == x) ? c : mine; }
        if (sum == G) break;
        __builtin_amdgcn_s_sleep(1);
        if ((++sp & 255u) == 0u) { if (xb_ld(&bar[XB_TMO])) break; if (sp > XB_SPIN_CAP) { atomicAdd(&bar[XB_TMO], 1u); break; } }
    }
    nloc = mine > 0u ? mine : 1u; nx = cnt > 0u ? cnt : 1u;
}

__device__ __forceinline__ void xcd_barrier(const XcdBarrier& b) {
    asm volatile("s_waitcnt vmcnt(0)" ::: "memory");
    __syncthreads();
    if (threadIdx.x == 0) {
        unsigned* bar = b.bar;
        __builtin_amdgcn_s_waitcnt(0);
        unsigned nloc = b.st[0], nx = b.st[1];
        if (nloc == 0u) { xcd_barrier_complete(bar, b.x, nloc, nx, b.G); b.st[0] = nloc; b.st[1] = nx; }
        const unsigned old = xb_add(&bar[XB_XSUB(b.x)], 1u);
        const unsigned gen = old / nloc;
        if (old + 1u == (gen + 1u) * nloc) {
            __builtin_amdgcn_fence(__ATOMIC_RELEASE, "agent");
            asm volatile("s_waitcnt vmcnt(0)" ::: "memory");
            const unsigned og = xb_add(&bar[XB_TOP], 1u);
            const unsigned tg = og / nx;
            if (og + 1u == (tg + 1u) * nx) xb_add(&bar[XB_TOPGEN], 1u);
            else XB_SPIN(xb_ld(&bar[XB_TOPGEN]) == tg, bar);
            __builtin_amdgcn_fence(__ATOMIC_ACQUIRE, "agent");
            xb_add(&bar[XB_XGEN(b.x)], 1u);
            asm volatile("s_waitcnt vmcnt(0)" ::: "memory");
        } else {
            XB_SPIN(xb_ld(&bar[XB_XGEN(b.x)]) == gen, bar);
            __builtin_amdgcn_fence(__ATOMIC_ACQUIRE, "agent");
            asm volatile("s_waitcnt vmcnt(0)" ::: "memory");
        }
    }
    __syncthreads();
}
template <int I> __device__ __forceinline__ const float* kin() {
    const __attribute__((address_space(4))) volatile unsigned long long* kp = (const __attribute__((address_space(4))) volatile unsigned long long*)__builtin_amdgcn_kernarg_segment_ptr();
    const unsigned long long v = kp[I];
    return (const float*)(GAS const float*)v;
}
enum InIdx { I_X = 0, I_MIXN, I_FFNN, I_POOLW, I_POOLS, I_KVN, I_WK, I_WV, I_WF, I_BF, I_WQ, I_WO, I_RG, I_RGB, I_RE, I_REB, I_WGATE, I_WUP, I_WDOWN, I_FINN };
struct Frame {
    LAS unsigned char* lds;
    volatile LAS unsigned* MISC;
    int tid, lane, wave;
    int vcu, G;
    int half;
    float* out;
    unsigned char* ws;
#define WSP(name, T, OFF) __device__ __forceinline__ T* name() const { return (T*)(ws + (OFF)); }
#define WSH(name, T, OFF, PERHALF) __device__ __forceinline__ T* name() const { return (T*)(ws + (OFF)) + (size_t)half * (PERHALF); }
    WSP(WPOOL, bf16, WS_WPOOL) WSP(WQKV, bf16, WS_WQKV) WSP(WO, bf16, WS_WO) WSP(WG, bf16, WS_WG) WSP(WU, bf16, WS_WU) WSP(WD, bf16, WS_WD)
    WSH(XN, bf16, WS_XN, (size_t)MH * D) WSH(QO, bf16, WS_QO, (size_t)MH * D) WSH(KB, bf16, WS_K, (size_t)MH * D) WSH(VB, bf16, WS_V, (size_t)MH * D) WSH(HMID, bf16, WS_HMID, (size_t)HROWS * 512)
    WSH(TOKROW, int, WS_TOKROW2, (size_t)NBUCKET * BCAP) WSH(GATEROW, float, WS_GATEROW2, (size_t)NBUCKET * BCAP * 2)
    WSH(BLKSUM, float, WS_BLKSUM, NBLK * 16) WSP(RWG, float, WS_RWG) WSP(WFG, float, WS_WFG) WSH(LF, float, WS_LF, (size_t)MH * 16) WSH(FM, float, WS_FM, (size_t)BH * H * T) WSP(TRASH, bf16, WS_TRASH)
    WSH(DPOOL, bf16, WS_DPOOL, (size_t)MH * D) WSH(Y0, bf16, WS_Y0, (size_t)MH * D) WSH(DATT, bf16, WS_V, (size_t)MH * D) WSH(Y1, bf16, WS_QO, (size_t)MH * D) WSH(H3B, bf16, WS_K, (size_t)MH * D)
    __device__ __forceinline__ const float* X() const { return kin<I_X>() + (size_t)half * MH * D; }
#undef WSH
#undef WSP
};

__device__ __forceinline__ float wave_sum(float v) {
#pragma unroll
    for (int o = 1; o < 64; o <<= 1) v += __shfl_xor(v, o);
    return v;
}
template <int N> __device__ __forceinline__ void halve(float (&v)[80], int mask, int lane) {
    const bool hi = (lane & mask) != 0;
#pragma unroll
    for (int k = 0; k < N / 2; ++k) { const float keep = hi ? v[2 * k + 1] : v[2 * k], send = hi ? v[2 * k] : v[2 * k + 1]; v[k] = keep + __shfl_xor(send, mask); }
}

struct ConvItem { const float* W; bf16* WT; const float* ks; const float* ns; int K, N, item; };
struct ConvLoads { float wv[32]; f32x4 ks0, ks1; float nsv; };
__device__ __forceinline__ void conv_issue(const ConvItem& c, int lane, ConvLoads& L) {
    const int nblk = c.N / 32, kb = c.item / nblk, nb = c.item % nblk, k0 = 64 * kb, n0 = 32 * nb;
    const float* wp = c.W + (size_t)(k0 + (lane >> 5)) * c.N + n0 + (lane & 31);
#pragma unroll
    for (int i = 0; i < 32; ++i) L.wv[i] = wp[(size_t)(2 * i) * c.N];
    L.nsv = c.ns ? c.ns[n0 + (lane & 31)] : 1.0f;
    const int ch = lane & 7;
    if (c.ks) { L.ks0 = *(const f32x4*)(c.ks + k0 + 8 * ch); L.ks1 = *(const f32x4*)(c.ks + k0 + 8 * ch + 4); } else { L.ks0 = (f32x4){1.f, 1.f, 1.f, 1.f}; L.ks1 = L.ks0; }
}
__device__ __forceinline__ void conv_finish(const ConvItem& c, int lane, const ConvLoads& L, LAS float* scr) {
    const int nblk = c.N / 32, kb = c.item / nblk, nb = c.item % nblk, k0 = 64 * kb, n0 = 32 * nb;
#pragma unroll
    for (int i = 0; i < 32; ++i) scr[(2 * i + (lane >> 5)) * 33 + (lane & 31)] = L.wv[i] * L.nsv;
    LDS_WAIT(); asm volatile("" ::: "memory");
    const int ch = lane & 7;
#pragma unroll
    for (int j = 0; j < 4; ++j) { const int n = (lane >> 3) + 8 * j; const LAS float* s = scr + (8 * ch) * 33 + n;
        v4u o; o.x = pg8::cvt_pk_bf16(s[0 * 33] * L.ks0.x, s[1 * 33] * L.ks0.y); o.y = pg8::cvt_pk_bf16(s[2 * 33] * L.ks0.z, s[3 * 33] * L.ks0.w);
        o.z = pg8::cvt_pk_bf16(s[4 * 33] * L.ks1.x, s[5 * 33] * L.ks1.y); o.w = pg8::cvt_pk_bf16(s[6 * 33] * L.ks1.z, s[7 * 33] * L.ks1.w);
        *(v4u*)(c.WT + (size_t)(n0 + n) * c.K + k0 + 8 * ch) = o; }
    LDS_WAIT(); asm volatile("" ::: "memory");
}
template <int W> __device__ __forceinline__ void pool_walk(const float* xb, int t0, int tbeg, const LAS float* invs, bf16* outp) {
    f32x4 ring[16], cur[16], nxt[16];
#pragma unroll
    for (int u = 0; u < 16; ++u) { ring[u] = (f32x4){0.f, 0.f, 0.f, 0.f}; const int t = t0 + tbeg - 16 + u; cur[u] = *(const f32x4*)(xb + (size_t)(t < 0 ? 0 : t) * D); }
    for (int base = -16; base < 64; base += 16) {
        if (base + 16 < 64) {
#pragma unroll
            for (int u = 0; u < 16; ++u) nxt[u] = *(const f32x4*)(xb + (size_t)(t0 + tbeg + base + 16 + u) * D); }
#pragma unroll
        for (int u = 0; u < 16; ++u) {
            const int tt = tbeg + base + u, t = t0 + tt;
            const f32x4 v = cur[u] * invs[tt + 16];
            ring[u] = v;
            if (base >= 0) {
                f32x4 s = v;
#pragma unroll
                for (int j = 1; j < W; ++j) s += ring[(u - j) & 15];
                const float rc = 1.0f / (float)((t + 1 < W) ? (t + 1) : W);
                const f32x4 d = s * rc - v;
                *(unsigned long long*)(outp + (size_t)t * D) = (unsigned long long)pg8::cvt_pk_bf16(d.x, d.y) | ((unsigned long long)pg8::cvt_pk_bf16(d.z, d.w) << 32);
            }
        }
#pragma unroll
        for (int u = 0; u < 16; ++u) cur[u] = nxt[u];
    }
}
__device__ __forceinline__ void p0_pool_diff(Frame& F) {
    LAS float* invs = (LAS float*)(F.lds + RING_OFF);
    for (int blk = F.vcu; blk < NBLK; blk += F.G) {
        const int b = blk >> 6, t0 = (blk & 63) * 128;
        const float* xb = F.X() + (size_t)b * T * D;
        for (int kb = 0; kb < 18; kb += 6) {
            f32x4 v[6][4];
#pragma unroll
            for (int q = 0; q < 6; ++q) { const int t = t0 - 16 + F.wave + 8 * (kb + q); const f32x4* xr = (const f32x4*)(xb + (size_t)(t < 0 ? 0 : t) * D) + F.lane;
#pragma unroll
                for (int j = 0; j < 4; ++j) v[q][j] = xr[64 * j]; }
#pragma unroll
            for (int q = 0; q < 6; ++q) { const int tt = -16 + F.wave + 8 * (kb + q); float s = 0.f;
#pragma unroll
                for (int j = 0; j < 4; ++j) s += (v[q][j].x * v[q][j].x + v[q][j].y * v[q][j].y) + (v[q][j].z * v[q][j].z + v[q][j].w * v[q][j].w);
                const float inv = (t0 + tt >= 0) ? 1.0f / sqrtf(wave_sum(s) * (1.0f / D) + RMS_EPS) : 0.f;
                if (F.lane == 0) invs[tt + 16] = inv; }
        }
        __syncthreads();
        const int tq = F.tid & 255, tbeg = (F.tid >> 8) * 64;
        const float* xt = xb + 4 * tq; bf16* op = F.XN() + (size_t)b * T * D + 4 * tq;
        const int grp = F.wave & 3;
        if (grp == 0) pool_walk<2>(xt, t0, tbeg, invs, op); else if (grp == 1) pool_walk<4>(xt, t0, tbeg, invs, op); else if (grp == 2) pool_walk<8>(xt, t0, tbeg, invs, op); else pool_walk<16>(xt, t0, tbeg, invs, op);
        __syncthreads();
    }
}
constexpr int CONV_EARLY = 4224, CONV_ALL = 14464;
__device__ __forceinline__ ConvItem conv_decode(Frame& F, int it) {
    ConvItem c; int r = it;
    if (r < 128) { const int g = r >> 5; c = ConvItem{kin<I_POOLW>() + g * 65536, F.WPOOL() + g * 65536, kin<I_MIXN>() + g * 256, kin<I_POOLS>() + g * 256, 256, 256, r & 31}; return c; } r -= 128;
    if (r < 4096) { const int up = r >> 11, mat = (r >> 7) & 15;
        c = ConvItem{(up ? kin<I_WUP>() : kin<I_WGATE>()) + (size_t)mat * 262144, (up ? F.WU() : F.WG()) + (size_t)mat * 262144, kin<I_FFNN>(), nullptr, D, DEXP, r & 127}; return c; } r -= 4096;
    if (r < 2048) { const int mat = r >> 7; c = ConvItem{kin<I_WDOWN>() + (size_t)mat * 262144, F.WD() + (size_t)mat * 262144, nullptr, nullptr, DEXP, D, r & 127}; return c; } r -= 2048;
    if (r < 2048) { const int mt = r >> 9;
        const float* W = mt == 0 ? kin<I_WQ>() : mt == 1 ? kin<I_WK>() : mt == 2 ? kin<I_WV>() : kin<I_WO>(); bf16* WT = mt < 3 ? F.WQKV() + (size_t)mt * D * D : F.WO();
        const float* ks = mt == 0 ? kin<I_MIXN>() + D : (mt < 3 ? kin<I_KVN>() : nullptr);
        c = ConvItem{W, WT, ks, nullptr, D, D, r & 511}; return c; } r -= 2048;
    if (r < 4096) { const int up = r >> 11, mat = 16 + ((r >> 7) & 15);
        c = ConvItem{(up ? kin<I_WUP>() : kin<I_WGATE>()) + (size_t)mat * 262144, (up ? F.WU() : F.WG()) + (size_t)mat * 262144, kin<I_FFNN>() + D, nullptr, D, DEXP, r & 127}; return c; } r -= 4096;
    { const int mat = 16 + (r >> 7); c = ConvItem{kin<I_WDOWN>() + (size_t)mat * 262144, F.WD() + (size_t)mat * 262144, nullptr, nullptr, DEXP, D, r & 127}; return c; }
}
__device__ __forceinline__ void p0_convert(Frame& F, int it0, int it1, int gw, int ngw) {
    LAS float* scr = (LAS float*)(F.lds + RING_OFF + 4096 + F.wave * 12288);
    int it = it0 + gw; if (it >= it1) return;
    ConvItem c = conv_decode(F, it); ConvLoads L; conv_issue(c, F.lane, L);
    for (;;) {
        const int itn = it + ngw; const bool more = itn < it1;
        ConvItem cn = c; ConvLoads Ln;
        if (more) { cn = conv_decode(F, itn); conv_issue(cn, F.lane, Ln); }
        conv_finish(c, F.lane, L, scr);
        if (!more) break;
        c = cn; L = Ln; it = itn;
    }
}
__device__ __forceinline__ void p0_small(Frame& F, int gt, int NT) {
    const float* rg = kin<I_RG>(); const float* re = kin<I_RE>(); const float* ffnn = kin<I_FFNN>(); const float* kvn = kin<I_KVN>(); const float* wf = kin<I_WF>();
    float* RWG = F.RWG(); float* WFG = F.WFG();
    for (int i = gt; i < 2 * 20 * D; i += NT) { const int l = i / (20 * D), rem = i % (20 * D), col = rem / D, c = rem % D;
        const float w = col < 4 ? rg[(size_t)(l * D + c) * 4 + col] : re[(size_t)(l * D + c) * 16 + (col - 4)]; RWG[i] = ffnn[l * D + c] * w; }
    for (int i = gt; i < 16 * D; i += NT) { const int h = i / D, c = i % D; WFG[i] = kvn[c] * wf[c * 16 + h]; }
}

struct RowSrc { const float* base; const bf16* d1; const bf16* d2; const bf16* d3; bf16* hwb; };
__device__ __forceinline__ f32x4 bf4_to_f32(unsigned long long w) { const unsigned lo = (unsigned)w, hi = (unsigned)(w >> 32);
    return (f32x4){__uint_as_float(lo << 16), __uint_as_float(lo & 0xffff0000u), __uint_as_float(hi << 16), __uint_as_float(hi & 0xffff0000u)}; }
__device__ __forceinline__ void row_load(const RowSrc& S, size_t row, int lane, f32x4 (&v)[4]) {
    if (S.base) { const f32x4* xr = (const f32x4*)(S.base + row * D) + lane;
#pragma unroll
        for (int j = 0; j < 4; ++j) v[j] = xr[64 * j]; }
    else {
#pragma unroll
        for (int j = 0; j < 4; ++j) v[j] = (f32x4){0.f, 0.f, 0.f, 0.f}; }
    if (S.d1) { const unsigned long long* dr = (const unsigned long long*)(S.d1 + row * D) + lane;
#pragma unroll
        for (int j = 0; j < 4; ++j) v[j] += bf4_to_f32(dr[64 * j]); }
    if (S.d2) { const unsigned long long* dr = (const unsigned long long*)(S.d2 + row * D) + lane;
#pragma unroll
        for (int j = 0; j < 4; ++j) v[j] += bf4_to_f32(dr[64 * j]); }
    if (S.d3) { const unsigned long long* dr = (const unsigned long long*)(S.d3 + row * D) + lane;
#pragma unroll
        for (int j = 0; j < 4; ++j) v[j] += bf4_to_f32(dr[64 * j]); }
    if (S.hwb) { unsigned long long* hr = (unsigned long long*)(S.hwb + row * D) + lane;
#pragma unroll
        for (int j = 0; j < 4; ++j) hr[64 * j] = (unsigned long long)pg8::cvt_pk_bf16(v[j].x, v[j].y) | ((unsigned long long)pg8::cvt_pk_bf16(v[j].z, v[j].w) << 32); }
}
__device__ __forceinline__ void rows4_load_norm(Frame& F, const RowSrc& S, int row0, f32x4 (&xv)[4][4], float (&inv)[4]) {
#pragma unroll
    for (int r = 0; r < 4; ++r) row_load(S, (size_t)(row0 + r), F.lane, xv[r]);
#pragma unroll
    for (int r = 0; r < 4; ++r) { float s = 0.f;
#pragma unroll
        for (int j = 0; j < 4; ++j) s += (xv[r][j].x * xv[r][j].x + xv[r][j].y * xv[r][j].y) + (xv[r][j].z * xv[r][j].z + xv[r][j].w * xv[r][j].w);
        inv[r] = 1.0f / sqrtf(wave_sum(s) * (1.0f / D) + RMS_EPS); }
#pragma unroll
    for (int r = 0; r < 4; ++r) { unsigned long long* o8 = (unsigned long long*)(F.XN() + (size_t)(row0 + r) * D) + F.lane;
#pragma unroll
        for (int j = 0; j < 4; ++j) o8[64 * j] = (unsigned long long)pg8::cvt_pk_bf16(xv[r][j].x * inv[r], xv[r][j].y * inv[r]) | ((unsigned long long)pg8::cvt_pk_bf16(xv[r][j].z * inv[r], xv[r][j].w * inv[r]) << 32); }
}
template <int NCOL> __device__ __forceinline__ void rows4_dots(const LAS float* Wl, int lane, const f32x4 (&xv)[4][4], float (&acc)[80]) {
#pragma unroll
    for (int j = 0; j < 4; ++j)
#pragma unroll
        for (int col = 0; col < NCOL; ++col) { const f32x4 w = ((const LAS f32x4*)(Wl + col * D))[lane + 64 * j];
#pragma unroll
            for (int r = 0; r < 4; ++r) { float a = acc[4 * col + r]; a = __builtin_fmaf(xv[r][j].x, w.x, a); a = __builtin_fmaf(xv[r][j].y, w.y, a); a = __builtin_fmaf(xv[r][j].z, w.z, a); a = __builtin_fmaf(xv[r][j].w, w.w, a); acc[4 * col + r] = a; }
            if ((col & 3) == 3) __builtin_amdgcn_sched_barrier(0); }
}
__device__ __forceinline__ void row_router_phase(Frame& F, int l, const RowSrc& RS, unsigned* cnt) {
    LAS float* Wl = (LAS float*)(F.lds + RING_OFF);
    LAS float* sc = (LAS float*)(F.lds + RING_OFF + 81920);
    LAS int* hl = (LAS int*)(F.lds + RING_OFF + 81920 + 4096);
    LAS int* tb = hl + 64;
    LAS float* tg = (LAS float*)(tb + 128);
    { const f32x4* rw = (const f32x4*)(F.RWG() + (size_t)l * 20 * D) + F.tid; f32x4 t[10];
#pragma unroll
      for (int i = 0; i < 10; ++i) t[i] = rw[i * NWAVES * 64];
#pragma unroll
      for (int i = 0; i < 10; ++i) ((LAS f32x4*)Wl)[F.tid + i * NWAVES * 64] = t[i]; }
    const float* gb = kin<I_RGB>() + l * 4; const float* eb = kin<I_REB>() + l * 16;
    for (int blk = F.vcu; blk < NBLK; blk += F.G) {
        if (F.tid < 32) hl[F.tid] = 0;
        __syncthreads();
        for (int pass = 0; pass < 4; ++pass) {
            asm volatile("" ::: "memory");
            const int row0 = blk * 128 + F.wave * 16 + pass * 4;
            f32x4 xv[4][4]; float inv[4];
            rows4_load_norm(F, RS, row0, xv, inv);
            LAS float* sw = sc + F.wave * 80;
            float acc[80];
#pragma unroll
            for (int i = 0; i < 16; ++i) acc[i] = 0.f;
            rows4_dots<4>(Wl, F.lane, xv, acc);
            halve<16>(acc, 1, F.lane); halve<8>(acc, 2, F.lane); halve<4>(acc, 4, F.lane); halve<2>(acc, 8, F.lane);
            acc[0] += __shfl_xor(acc[0], 16); acc[0] += __shfl_xor(acc[0], 32);
            { const int p = F.lane & 15, r = p & 3, c = p >> 2; const float iv = r == 0 ? inv[0] : r == 1 ? inv[1] : r == 2 ? inv[2] : inv[3];
              if (F.lane < 16) sw[r * 8 + c] = acc[0] * iv + gb[c]; }
            LDS_WAIT(); asm volatile("" ::: "memory");
            int gsel[4];
#pragma unroll
            for (int r = 0; r < 4; ++r) { const f32x4 g = *(const LAS f32x4*)(sw + r * 8); int gi = 0; float gm = g.x; if (g.y > gm) { gm = g.y; gi = 1; } if (g.z > gm) { gm = g.z; gi = 2; } if (g.w > gm) { gm = g.w; gi = 3; }
                gsel[r] = __builtin_amdgcn_readfirstlane(gi); }
#pragma unroll
            for (int i = 0; i < 16; ++i) acc[i] = 0.f;
#pragma unroll
            for (int j = 0; j < 4; ++j)
#pragma unroll
                for (int r = 0; r < 4; ++r) {
#pragma unroll
                    for (int c = 0; c < 4; ++c) { const f32x4 w = ((const LAS f32x4*)(Wl + (4 + 4 * gsel[r] + c) * D))[F.lane + 64 * j];
                        float a = acc[4 * c + r]; a = __builtin_fmaf(xv[r][j].x, w.x, a); a = __builtin_fmaf(xv[r][j].y, w.y, a); a = __builtin_fmaf(xv[r][j].z, w.z, a); a = __builtin_fmaf(xv[r][j].w, w.w, a); acc[4 * c + r] = a; }
                    __builtin_amdgcn_sched_barrier(0); }
            halve<16>(acc, 1, F.lane); halve<8>(acc, 2, F.lane); halve<4>(acc, 4, F.lane); halve<2>(acc, 8, F.lane);
            acc[0] += __shfl_xor(acc[0], 16); acc[0] += __shfl_xor(acc[0], 32);
            if (F.lane < 16) sw[(F.lane & 3) * 8 + 4 + (F.lane >> 2)] = acc[0];
            LDS_WAIT(); asm volatile("" ::: "memory");
            if (F.lane < 4) {
                const int r = F.lane; const LAS float* sr = sw + r * 8;
                const float iv = r == 0 ? inv[0] : r == 1 ? inv[1] : r == 2 ? inv[2] : inv[3];
                const float g0 = sr[0], g1 = sr[1], g2 = sr[2], g3 = sr[3];
                int gi = 0; float gm = g0; if (g1 > gm) { gm = g1; gi = 1; } if (g2 > gm) { gm = g2; gi = 2; } if (g3 > gm) { gm = g3; gi = 3; }
                const float gwt = 1.0f / (expf(g0 - gm) + expf(g1 - gm) + expf(g2 - gm) + expf(g3 - gm));
                const LAS float* se = sr + 4; const float* ebg = eb + gi * 4;
                const float e0 = se[0] * iv + ebg[0], e1 = se[1] * iv + ebg[1], e2 = se[2] * iv + ebg[2], e3 = se[3] * iv + ebg[3];
                int i1 = 0; float v1 = e0; if (e1 > v1) { v1 = e1; i1 = 1; } if (e2 > v1) { v1 = e2; i1 = 2; } if (e3 > v1) { v1 = e3; i1 = 3; }
                int i2 = -1; float v2 = -INFINITY;
                if (i1 != 0 && e0 > v2) { v2 = e0; i2 = 0; } if (i1 != 1 && e1 > v2) { v2 = e1; i2 = 1; } if (i1 != 2 && e2 > v2) { v2 = e2; i2 = 2; } if (i1 != 3 && e3 > v2) { v2 = e3; i2 = 3; }
                const float p1 = 1.0f / (1.0f + expf(v2 - v1)), p2 = 1.0f - p1;
                const int lo = i1 < i2 ? i1 : i2, hi = i1 < i2 ? i2 : i1;
                const float wlo = (i1 < i2 ? p1 : p2) * gwt, whi = (i1 < i2 ? p2 : p1) * gwt;
                const int pidx = lo == 0 ? hi - 1 : (lo == 1 ? hi + 1 : 5);
                const int bucket = gi * 6 + pidx, tok = row0 + r;
                const int rank = __hip_atomic_fetch_add(hl + bucket, 1, __ATOMIC_RELAXED, __HIP_MEMORY_SCOPE_WORKGROUP);
                const int ti = tok - blk * 128; tb[ti] = bucket | (rank << 8); tg[2 * ti] = wlo; tg[2 * ti + 1] = whi;
            }
        }
        __syncthreads();
        if (F.tid < NBUCKET) { const int n = hl[F.tid]; hl[32 + F.tid] = n ? (int)__hip_atomic_fetch_add(cnt + F.tid, (unsigned)n, RLX_AGENT) : 0; }
        __syncthreads();
        if (F.tid < 128) { const int v = tb[F.tid], b = v & 0xff, pos = b * BCAP + hl[32 + b] + (v >> 8);
            F.TOKROW()[pos] = blk * 128 + F.tid; *(f32x2*)(F.GATEROW() + 2 * (size_t)pos) = (f32x2){tg[2 * F.tid], tg[2 * F.tid + 1]}; }
        __syncthreads();
    }
}
__device__ __forceinline__ void row_forget_phase(Frame& F, const RowSrc& RS) {
    LAS float* Wl = (LAS float*)(F.lds + RING_OFF);
    LAS float* wsum = (LAS float*)(F.lds + RING_OFF + 81920);
    { const f32x4* rw = (const f32x4*)F.WFG() + F.tid; f32x4 t[8];
#pragma unroll
      for (int i = 0; i < 8; ++i) t[i] = rw[i * NWAVES * 64];
#pragma unroll
      for (int i = 0; i < 8; ++i) ((LAS f32x4*)Wl)[F.tid + i * NWAVES * 64] = t[i]; }
    __syncthreads();
    const int h = F.lane >> 2, r = F.lane & 3; const float bfh = kin<I_BF>()[h];
    for (int blk = F.vcu; blk < NBLK; blk += F.G) {
        float bsum = 0.f;
        for (int pass = 0; pass < 4; ++pass) {
            asm volatile("" ::: "memory");
            const int row0 = blk * 128 + F.wave * 16 + pass * 4;
            f32x4 xv[4][4]; float inv[4];
            rows4_load_norm(F, RS, row0, xv, inv);
            float acc[80];
#pragma unroll
            for (int i = 0; i < 80; ++i) acc[i] = 0.f;
            rows4_dots<16>(Wl, F.lane, xv, acc);
            halve<64>(acc, 1, F.lane); halve<32>(acc, 2, F.lane); halve<16>(acc, 4, F.lane); halve<8>(acc, 8, F.lane); halve<4>(acc, 16, F.lane); halve<2>(acc, 32, F.lane);
            const float iv = r == 0 ? inv[0] : r == 1 ? inv[1] : r == 2 ? inv[2] : inv[3];
            const float z = acc[0] * iv + bfh;
            const float lf = fminf(z, 0.f) - log1pf(expf(-fabsf(z)));
            F.LF()[(size_t)(row0 + r) * 16 + h] = lf; bsum += lf;
        }
        bsum += __shfl_xor(bsum, 1); bsum += __shfl_xor(bsum, 2);
        if (r == 0) wsum[F.wave * 16 + h] = bsum;
        __syncthreads();
        if (F.tid < 16) { float s = 0.f;
#pragma unroll
            for (int w = 0; w < NWAVES; ++w) s += wsum[w * 16 + F.tid];
            F.BLKSUM()[blk * 16 + F.tid] = s; }
        __syncthreads();
    }
}
__device__ __forceinline__ void final_norm_phase(Frame& F, const RowSrc& RS, float* dst) {
    const int gw = F.vcu * NWAVES + F.wave, NGW = F.G * NWAVES;
    f32x4 g[4];
#pragma unroll
    for (int j = 0; j < 4; ++j) g[j] = ((const f32x4*)kin<I_FINN>())[F.lane + 64 * j];
    for (int m0 = gw * 4; m0 < MH; m0 += NGW * 4) {
        f32x4 v[4][4]; float inv[4];
#pragma unroll
        for (int r = 0; r < 4; ++r) row_load(RS, (size_t)(m0 + r), F.lane, v[r]);
#pragma unroll
        for (int r = 0; r < 4; ++r) { float s = 0.f;
#pragma unroll
            for (int j = 0; j < 4; ++j) s += (v[r][j].x * v[r][j].x + v[r][j].y * v[r][j].y) + (v[r][j].z * v[r][j].z + v[r][j].w * v[r][j].w);
            inv[r] = 1.0f / sqrtf(wave_sum(s) * (1.0f / D) + RMS_EPS); }
#pragma unroll
        for (int r = 0; r < 4; ++r)
#pragma unroll
            for (int j = 0; j < 4; ++j) ((f32x4*)(dst + (size_t)(m0 + r) * D) + F.lane)[64 * j] = v[r][j] * inv[r] * g[j];
    }
}
__device__ __forceinline__ void build_tile_table(Frame& F, const unsigned* cnt) {
    LAS int* tbl = (LAS int*)(F.lds + TBL_OFF);
    LAS int* cn = (LAS int*)(F.lds + RING_OFF);
    if (F.tid < NBUCKET) cn[F.tid] = (int)__hip_atomic_load(cnt + F.tid, RLX_AGENT);
    __syncthreads();
    if (F.tid == 0) { int ntl = 0; for (int b = 0; b < NBUCKET; ++b) { cn[32 + b] = ntl; ntl += (cn[b] + 255) >> 8; } tbl[0] = ntl < MAXTILES ? ntl : MAXTILES; }
    __syncthreads();
    if (F.tid < NBUCKET) { const int b = F.tid, g = b / 6, p = b % 6, lo = p < 3 ? 0 : (p < 5 ? 1 : 2), hi = p < 3 ? p + 1 : (p < 5 ? p - 1 : 3), n = cn[b]; int t = cn[32 + b];
        for (int k = 0; k * 256 < n && t < MAXTILES; ++k, ++t) { tbl[1 + 3 * t] = (g * 4 + lo) | ((g * 4 + hi) << 8); tbl[2 + 3 * t] = (n - 256 * k) < 256 ? (n - 256 * k) : 256; tbl[3 + 3 * t] = b * BCAP + 256 * k; } }
    __syncthreads();
}
__device__ __forceinline__ void fscan_phase(Frame& F) {
    LAS float* bs = (LAS float*)(F.lds + RING_OFF);
    LAS float* sg = bs + 16;
    for (int blk = F.vcu; blk < NBLK; blk += F.G) {
        const int b = blk >> 6, first = b * 64, tid = F.tid;
        { LAS float* ps = sg + 128;
          for (int i = tid; i < 64 * 16; i += NWAVES * 64) { const int j = first + (i >> 4); ps[i] = j < blk ? F.BLKSUM()[j * 16 + (i & 15)] : 0.f; }
          __syncthreads();
          if (tid < 16) { float s = 0.f; for (int j = 0; j < 64; ++j) s += ps[j * 16 + tid]; bs[tid] = s; } }
        const int h = tid & 15, seg = tid >> 4;
        float v[16];
        if (tid < 128) { float s = 0.f;
#pragma unroll
            for (int k = 0; k < 16; ++k) { v[k] = F.LF()[(size_t)(blk * 128 + seg * 16 + k) * 16 + h]; s += v[k]; }
            sg[seg * 16 + h] = s; }
        __syncthreads();
        if (tid < 128) { float run = bs[h]; for (int s2 = 0; s2 < seg; ++s2) run += sg[s2 * 16 + h];
            float* fo = F.FM() + (size_t)(b * 16 + h) * T + (blk & 63) * 128 + seg * 16;
#pragma unroll
            for (int k = 0; k < 16; ++k) { run += v[k]; fo[k] = run; } }
        __syncthreads();
    }
}
struct Args { const float* in[20]; float* out; unsigned char* ws; };
__global__ void __launch_bounds__(NWAVES * 64, 2) yoco_fwd(Args args) {
    extern __shared__ __attribute__((aligned(16))) unsigned char lds[];
    Frame F;
    F.lds = (LAS unsigned char*)lds;
    F.MISC = (volatile LAS unsigned*)(F.lds + MISC_OFF);
    F.tid = threadIdx.x; F.lane = F.tid & 63; F.wave = __builtin_amdgcn_readfirstlane(F.tid >> 6);
    const int GA = gridDim.x, bx = blockIdx.x, li = bx >> 1;
    F.half = bx & 1; F.G = GA >> 1; F.vcu = (F.G % 4 == 0) ? (li % 4) * (F.G / 4) + li / 4 : li;
    unsigned char* ws = args.ws;
    F.ws = ws; F.out = args.out + (size_t)F.half * MH * D;
    gu32* const ctl = (gu32*)(ws + WS_CTL);
    { int t0 = threadIdx.x; asm volatile("" : "+v"(t0));
      for (int u = t0; u < (LDS_BYTES - LDSCTL_OFF) / 4; u += NWAVES * 64) ((LAS unsigned*)(F.lds + LDSCTL_OFF))[u] = 0u; }
    __syncthreads();
    const XcdBarrier barAll = xcd_barrier_post((unsigned*)(ctl + CW_BAR), F.MISC + 8, (unsigned)GA);
    const XcdBarrier bar = xcd_barrier_post((unsigned*)(ctl + CW_BARH) + F.half * XCD_BAR_WORDS, F.MISC + 12, (unsigned)F.G);
    unsigned* const cnt0 = (unsigned*)(ctl + CW_CNT + 64 * (2 * F.half)); unsigned* const cnt1 = cnt0 + 64;
    unsigned* const nq = (unsigned*)(ctl + CW_NRM) + F.half * 2048; unsigned* const nk = (unsigned*)(ctl + CW_NRM) + 4096 + F.half * 64;

#ifndef PH_MASK
#define PH_MASK 0x7fff
#endif
#define IN(k) ((PH_MASK >> (k)) & 1)
#define RETID() Frame Fq = F; { int t_ = threadIdx.x; asm volatile("" : "+v"(t_)); Fq.tid = t_; Fq.lane = t_ & 63; }
#define SEAM(k) do { xcd_barrier(bar); } while (0)
    PG8_LAS unsigned char* ring = F.lds + RING_OFF;

    if (IN(0)) { RETID();
        p0_convert(Fq, 0, CONV_EARLY, bx * NWAVES + Fq.wave, GA * NWAVES);
        p0_small(Fq, bx * (NWAVES * 64) + Fq.tid, GA * NWAVES * 64);
        xcd_barrier(barAll);
        if (Fq.half == 1) {
            p0_convert(Fq, CONV_EARLY, CONV_ALL, li * NWAVES + Fq.wave, Fq.G * NWAVES);
            asm volatile("s_waitcnt vmcnt(0)" ::: "memory"); __syncthreads();
            if (Fq.tid == 0) { __builtin_amdgcn_fence(__ATOMIC_RELEASE, "agent"); asm volatile("s_waitcnt vmcnt(0)" ::: "memory"); __hip_atomic_fetch_add((unsigned*)(ctl + CW_CONV), 1u, RLX_AGENT); }
        }
        p0_pool_diff(Fq);
#ifdef SKEW_TICKS
        if (Fq.half == 1) { const unsigned long long t0_ = __builtin_amdgcn_s_memrealtime(); while (__builtin_amdgcn_s_memrealtime() - t0_ < SKEW_TICKS) __builtin_amdgcn_s_sleep(10); }
#endif
    } SEAM(0);

    if (IN(1)) { RETID();
        pg8::StaticOrder S; S.init(MH, D, Fq.G, li, 4);
        pg8::AdRow ad{(const char*)Fq.XN(), (const char*)Fq.WPOOL(), D, 256, 256};
        pg8::EpiBf16 E{Fq.DPOOL(), D, 0, 0, 1.f, nullptr, nullptr};
        pg8::gemm_phase<pg8::EpiBf16, pg8::StaticOrder, pg8::AdRow, true>(ring, 4, S, E, ad);
    } SEAM(1);

    if (IN(2)) { RETID(); const RowSrc RS{Fq.X(), Fq.DPOOL(), nullptr, nullptr, nullptr}; row_router_phase(Fq, 0, RS, cnt0); } SEAM(2);
    if (IN(4)) { RETID();
        build_tile_table(Fq, cnt0);
        pg8::MoeOrder S{(const PG8_LAS int*)(Fq.lds + TBL_OFF), Fq.G, Fq.vcu};
        pg8::AdMoeUp ad{(const char*)Fq.XN(), Fq.TOKROW(), (const char*)Fq.WG(), (const char*)Fq.WU(), D, D};
        pg8::EpiMoeH E{Fq.HMID(), Fq.GATEROW()};
        pg8::gemm_phase<pg8::EpiMoeH, pg8::MoeOrder, pg8::AdMoeUp, true>(ring, 16, S, E, ad);
    } SEAM(4);
    if (F.half == 0) {
        if (F.tid == 0) { unsigned sp = 0; while (__hip_atomic_load((unsigned*)(ctl + CW_CONV), RLX_AGENT) < (unsigned)F.G) { __builtin_amdgcn_s_sleep(2); if (++sp > (1u << 22)) break; }
            __builtin_amdgcn_fence(__ATOMIC_ACQUIRE, "agent"); asm volatile("s_waitcnt vmcnt(0)" ::: "memory"); }
        __syncthreads();
    }
    if (IN(5)) { RETID();
        build_tile_table(Fq, cnt0);
        pg8::MoeOrder S{(const PG8_LAS int*)(Fq.lds + TBL_OFF), Fq.G, Fq.vcu};
        pg8::AdMoeDown ad{(const char*)Fq.HMID(), (const char*)Fq.WD(), 512, 256};
        pg8::EpiMoeOutBf16 E{Fq.Y0(), Fq.TOKROW(), Fq.TRASH()};
        pg8::gemm_phase<pg8::EpiMoeOutBf16, pg8::MoeOrder, pg8::AdMoeDown, true>(ring, 8, S, E, ad);
    } SEAM(5);

    if (IN(6)) { RETID(); const RowSrc RS{Fq.X(), Fq.DPOOL(), Fq.Y0(), nullptr, nullptr}; row_forget_phase(Fq, RS); } SEAM(6);
    if (IN(7)) { RETID();
        fscan_phase(Fq);
        pg8::StaticOrder S; S.init(MH, NQKV, Fq.G, li, 4);
        pg8::AdRow ad{(const char*)Fq.XN(), (const char*)Fq.WQKV(), D, D, 0};
        pg8::EpiBf16 E{Fq.QO(), D, D, (size_t)(WS_K - WS_QO) / 2, attn_body::C2, nq, nk};
        pg8::gemm_phase<pg8::EpiBf16, pg8::StaticOrder, pg8::AdRow, true>(ring, 16, S, E, ad);
    } SEAM(7);

    if (IN(8)) { RETID();
        static_assert(attn_body::ATTN_LDS_BYTES <= RING_BYTES && attn_body::ATTN_PITCH == D && attn_body::BATCH == BH, "attention body geometry vs frame");
        const attn_body::AttnTensors AT{(const attn_body::bf16*)Fq.QO(), (const attn_body::bf16*)Fq.KB(), (const attn_body::bf16*)Fq.VB(), (attn_body::bf16*)Fq.XN(), Fq.FM(), nq, nk};
        attn_body::attn_phase<>((char*)lds + RING_OFF, AT, (unsigned*)(ctl + CW_ATQ + 64 * Fq.half));
    } SEAM(8);

    if (IN(9)) { RETID();
        pg8::StaticOrder S; S.init(MH, D, Fq.G, li, 4);
        pg8::AdRow ad{(const char*)Fq.XN(), (const char*)Fq.WO(), D, D, 0};
        pg8::EpiBf16 E{Fq.DATT(), D, 0, 0, 1.f, nullptr, nullptr};
        pg8::gemm_phase<pg8::EpiBf16, pg8::StaticOrder, pg8::AdRow, true>(ring, 16, S, E, ad);
    } SEAM(9);

    if (IN(10)) { RETID(); const RowSrc RS{Fq.X(), Fq.DPOOL(), Fq.Y0(), Fq.DATT(), Fq.H3B()}; row_router_phase(Fq, 1, RS, cnt1); } SEAM(10);
    if (IN(12)) { RETID();
        build_tile_table(Fq, cnt1);
        pg8::MoeOrder S{(const PG8_LAS int*)(Fq.lds + TBL_OFF), Fq.G, Fq.vcu};
        pg8::AdMoeUp ad{(const char*)Fq.XN(), Fq.TOKROW(), (const char*)(Fq.WG() + (size_t)NEXP * DEXP * D), (const char*)(Fq.WU() + (size_t)NEXP * DEXP * D), D, D};
        pg8::EpiMoeH E{Fq.HMID(), Fq.GATEROW()};
        pg8::gemm_phase<pg8::EpiMoeH, pg8::MoeOrder, pg8::AdMoeUp, true>(ring, 16, S, E, ad);
    } SEAM(12);
    if (IN(13)) { RETID();
        build_tile_table(Fq, cnt1);
        pg8::MoeOrder S{(const PG8_LAS int*)(Fq.lds + TBL_OFF), Fq.G, Fq.vcu};
        pg8::AdMoeDown ad{(const char*)Fq.HMID(), (const char*)(Fq.WD() + (size_t)NEXP * DEXP * D), 512, 256};
        pg8::EpiMoeOutBf16 E{Fq.Y1(), Fq.TOKROW(), Fq.TRASH()};
        pg8::gemm_phase<pg8::EpiMoeOutBf16, pg8::MoeOrder, pg8::AdMoeDown, true>(ring, 8, S, E, ad);
    } SEAM(13);

    if (IN(14)) { RETID(); const RowSrc RS{nullptr, Fq.H3B(), Fq.Y1(), nullptr, nullptr}; final_norm_phase(Fq, RS, Fq.out); }
#undef IN
#undef SEAM
}

extern "C" void kernel_launch(void* const* d_in, const int* in_sizes, int n_in, void* d_out, int out_size, void* d_ws, size_t ws_size, hipStream_t stream) {
    static int grid = 0;
    if (grid == 0) {
        if (n_in != 20 || in_sizes[0] != M * D || out_size != M * D || ws_size < WS_END) { fprintf(stderr, "kernel_launch: unexpected shapes (n_in %d, in0 %d, out %d, ws %zu); nothing launched\n", n_in, n_in > 0 ? in_sizes[0] : -1, out_size, ws_size); grid = -1; return; }
        int dev = 0, cus = 0, per_cu = 0;
        if (hipGetDevice(&dev) != hipSuccess || hipDeviceGetAttribute(&cus, hipDeviceAttributeMultiprocessorCount, dev) != hipSuccess) { fprintf(stderr, "kernel_launch: hipGetDevice / hipDeviceGetAttribute failed\n"); grid = -1; return; }
        if (hipFuncSetAttribute((const void*)yoco_fwd, hipFuncAttributeMaxDynamicSharedMemorySize, LDS_BYTES) != hipSuccess) { fprintf(stderr, "kernel_launch: hipFuncSetAttribute failed\n"); grid = -1; return; }
        if (hipOccupancyMaxActiveBlocksPerMultiprocessor(&per_cu, (const void*)yoco_fwd, NWAVES * 64, LDS_BYTES) != hipSuccess || per_cu < 1)
            fprintf(stderr, "kernel_launch: note: occupancy query reports %d workgroups per CU\n", per_cu);
        (void)hipGetLastError();
        grid = cus & ~1;
    }
    if (grid < 0) return;
    if (hipMemsetAsync((char*)d_ws + WS_CTL, 0, CTL_ZERO_BYTES, stream) != hipSuccess) { fprintf(stderr, "kernel_launch: hipMemsetAsync failed\n"); return; }
    Args a{};
    for (int i = 0; i < 20; ++i) a.in[i] = (const float*)d_in[i];
    a.out = (float*)d_out; a.ws = (unsigned char*)d_ws;
    hipLaunchKernelGGL(yoco_fwd, dim3(grid), dim3(NWAVES * 64), LDS_BYTES, stream, a);
    const hipError_t le = hipPeekAtLastError();
    if (le != hipSuccess) fprintf(stderr, "kernel_launch: launch failed: %s\n", hipGetErrorName(le));
}
```

```cpp
#include <hip/hip_runtime.h>
#include <hip/hip_bf16.h>
#include <cstdio>
#include <cstdint>
#include <cmath>
namespace pg8 {
#define PG8_LAS __attribute__((address_space(3)))
typedef unsigned short bf16_t;
typedef short bf16x8 __attribute__((ext_vector_type(8)));
typedef float f32x4 __attribute__((ext_vector_type(4)));
typedef unsigned u32x4 __attribute__((ext_vector_type(4)));
constexpr int BM = 256, BK = 64, HALF = 128, HTB = HALF * BK * 2  , STAGE_BYTES = 8 * HTB, NXCD = 8, WGM = 8;

__host__ __device__ __forceinline__ int lds_byte(int r, int c) { const int st = (r >> 4) * 2 + (c >> 5), rr = r & 15, cc = c & 31, ob = rr * 64 + cc * 2; return st * 1024 + (ob ^ (((ob >> 9) & 1) << 5)); }
__host__ __device__ __forceinline__ void stage_rc(int b, int& R, int& C) { const int st = b / 1024, sb = b % 1024, swz = sb ^ (((sb >> 9) & 1) << 5); R = (st >> 1) * 16 + swz / 64; C = (st & 1) * 32 + (swz % 64) / 2; }
__host__ __device__ __forceinline__ int perm32(int rho) { const int n = rho >> 4, i = rho & 15; return 8 * (i >> 2) + 4 * n + (i & 3); }

struct Unit { int pm, pn, x0, x1, x2; };

struct StaticOrder {
    int nM, nN, nwg, G, c, nx;
    __device__ __forceinline__ void init(int M, int N, int G_, int c_, int nx_) { nM = M / BM; nN = N / BM; nwg = nM * nN; G = G_; c = c_; nx = nx_; }
    __device__ __forceinline__ bool next(int i, Unit& u) const {
        const long L = (long)i * G + c; if (L >= nwg) return false;
        int wgid = (int)L; { const int q = nwg / nx, r = nwg % nx, xcd = wgid % nx, off = wgid / nx; wgid = (xcd < r ? xcd * (q + 1) : r * (q + 1) + (xcd - r) * q) + off; }
        const int nig = WGM * nN, gid = wgid / nig, fm = gid * WGM, gsz = (nM - fm) < WGM ? (nM - fm) : WGM;
        u.pm = fm + ((wgid % nig) % gsz); u.pn = (wgid % nig) / gsz; u.x0 = 0; u.x1 = 0; u.x2 = 0; return true;
    }
};
struct MoeOrder {
    const PG8_LAS int* tbl; int G, c;
    __device__ __forceinline__ bool next(int i, Unit& u) const {
        const int L = i * G + c; const int ntl = __builtin_amdgcn_readfirstlane(tbl[0]);
        if (L >= ntl * 4) return false;
        const int rt = L >> 2; u.pm = rt; u.pn = L & 3; u.x0 = __builtin_amdgcn_readfirstlane(tbl[1 + 3 * rt]); u.x1 = __builtin_amdgcn_readfirstlane(tbl[2 + 3 * rt]); u.x2 = __builtin_amdgcn_readfirstlane(tbl[3 + 3 * rt]); return true;
    }
};

struct AdRow {
    static constexpr bool GATHER = false;
    const char* abase; const char* bbase; int lda, ldb, acolpn;
    __device__ __forceinline__ const char* a_ptr(const Unit& u, int h, int kt) const { return abase + ((size_t)(u.pm * BM + h * HALF) * lda + u.pn * acolpn) * 2 + (size_t)kt * (BK * 2); }
    __device__ __forceinline__ void a_offs(const Unit&, const int (&)[2], const int (&)[2], unsigned (&)[2][2]) const {}
    __device__ __forceinline__ const char* b_ptr(const Unit& u, int h, int kt) const { return bbase + (size_t)(u.pn * BM + h * HALF) * ldb * 2 + (size_t)kt * (BK * 2); }
};
struct AdMoeUp {
    static constexpr bool GATHER = true;
    const char* abase; const int* tokrow; const char* wg; const char* wu; int lda, ldb;
    __device__ __forceinline__ const char* a_ptr(const Unit&, int, int kt) const { return abase + (size_t)kt * (BK * 2); }
    __device__ __forceinline__ void a_offs(const Unit& u, const int (&R)[2], const int (&C)[2], unsigned (&v)[2][2]) const {
#pragma unroll
        for (int h = 0; h < 2; ++h)
#pragma unroll
            for (int i = 0; i < 2; ++i) { const int rl = h * HALF + R[i]; const int tok = rl < u.x1 ? tokrow[u.x2 + rl] : 0; v[h][i] = (unsigned)(tok * 1024 + C[i]) * 2u; }
    }
    __device__ __forceinline__ const char* b_ptr(const Unit& u, int h, int kt) const {
        const int e = (u.pn >> 1) ? ((u.x0 >> 8) & 0xff) : (u.x0 & 0xff);
        return (h ? wu : wg) + (size_t)(e * 256 + (u.pn & 1) * HALF) * 1024 * 2 + (size_t)kt * (BK * 2);
    }
};
struct AdMoeDown {
    static constexpr bool GATHER = false;
    const char* abase; const char* wd; int lda, ldb;
    __device__ __forceinline__ const char* a_ptr(const Unit& u, int h, int kt) const { return abase + (size_t)(u.pm * BM + h * HALF) * 512 * 2 + (size_t)kt * (BK * 2); }
    __device__ __forceinline__ void a_offs(const Unit&, const int (&)[2], const int (&)[2], unsigned (&)[2][2]) const {}
    __device__ __forceinline__ const char* b_ptr(const Unit& u, int h, int kt) const {
        const int e = (kt >> 2) ? ((u.x0 >> 8) & 0xff) : (u.x0 & 0xff);
        return wd + (size_t)(e * 1024 + u.pn * BM + h * HALF) * 256 * 2 + (size_t)(kt & 3) * (BK * 2);
    }
};

__device__ __forceinline__ unsigned cvt_pk_bf16(float lo, float hi) { unsigned r; asm volatile("v_cvt_pk_bf16_f32 %0, %1, %2" : "=v"(r) : "v"(lo), "v"(hi)); return r; }

struct EpiBf16 {
    static constexpr bool PERM = true;
    bf16_t* O; int ldc; int split_cols; size_t split_stride; float scale0; unsigned* nq; unsigned* nk;
    __device__ __forceinline__ void operator()(const f32x4 (&acc)[2][2][4][2], const Unit& u, int wr, int wc, int fr, int fq) const {
        const int row0 = u.pm * BM + wr * 64 + fr; int colt = u.pn * BM; bf16_t* base = O; int t = 0;
        float sc = 1.f; if (split_cols) { t = colt / split_cols; base += (size_t)t * split_stride; colt -= t * split_cols; if (t == 0) sc = scale0; }
        const int col0 = colt + wc * 32 + 8 * fq;
#pragma unroll
        for (int ai = 0; ai < 2; ++ai)
#pragma unroll
            for (int m = 0; m < 4; ++m) { bf16_t* rowp = base + (size_t)(row0 + ai * HALF + m * 16) * ldc + col0;
#pragma unroll
                for (int bj = 0; bj < 2; ++bj) { f32x4 v0 = acc[ai][bj][m][0] * sc, v1 = acc[ai][bj][m][1] * sc;
                    u32x4 w; w.x = cvt_pk_bf16(v0[0], v0[1]); w.y = cvt_pk_bf16(v0[2], v0[3]); w.z = cvt_pk_bf16(v1[0], v1[1]); w.w = cvt_pk_bf16(v1[2], v1[3]);
                    *(u32x4*)(rowp + bj * HALF) = w; } }
        if (nq && t < 2) {
#pragma unroll
            for (int bj = 0; bj < 2; ++bj) { float mx = 0.f;
#pragma unroll
                for (int ai = 0; ai < 2; ++ai)
#pragma unroll
                    for (int m = 0; m < 4; ++m) { const f32x4 v0 = acc[ai][bj][m][0] * sc, v1 = acc[ai][bj][m][1] * sc;
                        float s = (v0[0] * v0[0] + v0[1] * v0[1]) + (v0[2] * v0[2] + v0[3] * v0[3]) + (v1[0] * v1[0] + v1[1] * v1[1]) + (v1[2] * v1[2] + v1[3] * v1[3]);
                        s += __shfl_xor(s, 16); s += __shfl_xor(s, 32); mx = fmaxf(mx, s); }
                mx = fmaxf(mx, __shfl_xor(mx, 1)); mx = fmaxf(mx, __shfl_xor(mx, 2)); mx = fmaxf(mx, __shfl_xor(mx, 4)); mx = fmaxf(mx, __shfl_xor(mx, 8));
                if (fr == 0 && fq == 0) { const int head = (colt >> 8) * 4 + 2 * bj + (wc >> 1), half = wc & 1;
                    unsigned* p = t == 0 ? nq + ((u.pm * 16 + head) * 2 + half) : nk + (((u.pm >> 5) * 16 + head) * 2 + half);
                    __hip_atomic_fetch_max(p, __float_as_uint(mx), __ATOMIC_RELAXED, __HIP_MEMORY_SCOPE_AGENT); } }
        }
    }
};
struct EpiResF32 {
    static constexpr bool PERM = false;
    const float* base; float* out; int ldc;
    __device__ __forceinline__ void operator()(const f32x4 (&acc)[2][2][4][2], const Unit& u, int wr, int wc, int fr, int fq) const {
        const size_t off0 = (size_t)(u.pm * BM + wr * 64 + fr) * ldc + u.pn * BM + wc * 32 + 4 * fq;
        f32x4 buf[3][4];
#define PG8_RES_LOAD(g) do { const size_t o_ = off0 + (size_t)(((g) >> 2) * HALF + ((g) & 3) * 16) * ldc; _Pragma("unroll") for (int q_ = 0; q_ < 4; ++q_) buf[(g) % 3][q_] = *(const f32x4*)(base + o_ + (q_ >> 1) * HALF + (q_ & 1) * 16); } while (0)
        PG8_RES_LOAD(0); PG8_RES_LOAD(1);
#pragma unroll
        for (int g = 0; g < 8; ++g) {
            if (g + 2 < 8) PG8_RES_LOAD(g + 2);
            const size_t o = off0 + (size_t)((g >> 2) * HALF + (g & 3) * 16) * ldc;
#pragma unroll
            for (int q = 0; q < 4; ++q) *(f32x4*)(out + o + (q >> 1) * HALF + (q & 1) * 16) = buf[g % 3][q] + acc[g >> 2][q >> 1][g & 3][q & 1];
            asm volatile("" ::: "memory");
        }
#undef PG8_RES_LOAD
    }
};
__device__ __forceinline__ float silu_mul(float g, float u) { return g * u * __builtin_amdgcn_rcpf(1.0f + __builtin_amdgcn_exp2f(-1.4426950408889634f * g)); }
struct EpiMoeH {
    static constexpr bool PERM = true;
    bf16_t* H; const float* gaterow;
    __device__ __forceinline__ void operator()(const f32x4 (&acc)[2][2][4][2], const Unit& u, int wr, int wc, int fr, int fq) const {
        const int half = u.pn >> 1, col0 = half * 256 + (u.pn & 1) * HALF + wc * 32 + 8 * fq;
#pragma unroll
        for (int ai = 0; ai < 2; ++ai)
#pragma unroll
            for (int m = 0; m < 4; ++m) { const int rl = ai * HALF + wr * 64 + m * 16 + fr, row = u.pm * BM + rl; const float gw = rl < u.x1 ? gaterow[(size_t)(u.x2 + rl) * 2 + half] : 0.f;
                const f32x4 g0 = acc[ai][0][m][0], g1 = acc[ai][0][m][1], u0 = acc[ai][1][m][0], u1 = acc[ai][1][m][1];
                u32x4 w; w.x = cvt_pk_bf16(silu_mul(g0[0], u0[0]) * gw, silu_mul(g0[1], u0[1]) * gw); w.y = cvt_pk_bf16(silu_mul(g0[2], u0[2]) * gw, silu_mul(g0[3], u0[3]) * gw);
                w.z = cvt_pk_bf16(silu_mul(g1[0], u1[0]) * gw, silu_mul(g1[1], u1[1]) * gw); w.w = cvt_pk_bf16(silu_mul(g1[2], u1[2]) * gw, silu_mul(g1[3], u1[3]) * gw);
                *(u32x4*)(H + (size_t)row * 512 + col0) = w; }
    }
};
struct EpiMoeOutBf16 {
    static constexpr bool PERM = true;
    bf16_t* Y; const int* tokrow; bf16_t* trash;
    __device__ __forceinline__ void operator()(const f32x4 (&acc)[2][2][4][2], const Unit& u, int wr, int wc, int fr, int fq) const {
        const int col0 = u.pn * BM + wc * 32 + 8 * fq, nvalid = u.x1;
#pragma unroll
        for (int ai = 0; ai < 2; ++ai)
#pragma unroll
            for (int m = 0; m < 4; ++m) { const int rl = ai * HALF + wr * 64 + m * 16 + fr; const int tok = rl < nvalid ? tokrow[u.x2 + rl] : 0;
                bf16_t* rowp = (rl < nvalid ? Y + (size_t)tok * 1024 : trash) + col0;
#pragma unroll
                for (int bj = 0; bj < 2; ++bj) { const f32x4 v0 = acc[ai][bj][m][0], v1 = acc[ai][bj][m][1];
                    u32x4 w; w.x = cvt_pk_bf16(v0[0], v0[1]); w.y = cvt_pk_bf16(v0[2], v0[3]); w.z = cvt_pk_bf16(v1[0], v1[1]); w.w = cvt_pk_bf16(v1[2], v1[3]);
                    *(u32x4*)(rowp + bj * HALF) = w; } }
    }
};

template <class Epi, class Sched, class AD, bool ALIGN_EPI>
__device__ __forceinline__ void gemm_phase(PG8_LAS unsigned char* lds, const int nt, const Sched& S, const Epi& E, const AD& ad) {
    int tid = threadIdx.x; asm volatile("" : "+v"(tid));
    const int wid = __builtin_amdgcn_readfirstlane(tid >> 6), lane = tid & 63, wr = wid >> 2, wc = wid & 3, fr = lane & 15, fq = lane >> 4;
    int Rs[2], Cs[2]; unsigned voffA[2], voffB[2];
#pragma unroll
    for (int i = 0; i < 2; ++i) { stage_rc(tid * 16 + i * 8192, Rs[i], Cs[i]); const int Rb = Epi::PERM ? ((Rs[i] & ~31) + perm32(Rs[i] & 31)) : Rs[i];
        voffA[i] = (unsigned)(Rs[i] * ad.lda + Cs[i]) * 2u; voffB[i] = (unsigned)(Rb * ad.ldb + Cs[i]) * 2u; }
    const unsigned ldsw = (unsigned)wid * 1024u;
    const int aoff = lds_byte(wr * 64 + fr, fq * 8), boff = lds_byte(wc * 32 + fr, fq * 8);
#define PG8_SA(b, h) (((b) * 2 + (h)) * HTB)
#define PG8_SB(b, h) ((4 + (b) * 2 + (h)) * HTB)
#define PG8_STAGE(bufoff, gbase, voff) do { _Pragma("unroll") for (int _i = 0; _i < 2; ++_i) \
        __builtin_amdgcn_global_load_lds((const unsigned*)((const char*)(gbase) + (voff)[_i]), (PG8_LAS unsigned*)(lds + (bufoff) + ldsw + _i * 8192), 16, 0, 0); } while (0)
#define PG8_STAGE_A(bufoff, U, h, kt, VG) do { if constexpr (AD::GATHER) PG8_STAGE(bufoff, ad.a_ptr(U, h, kt), (VG)[h]); else PG8_STAGE(bufoff, ad.a_ptr(U, h, kt), voffA); } while (0)
#define PG8_LDA(dst, b, h) do { _Pragma("unroll") for (int m = 0; m < 4; ++m) _Pragma("unroll") for (int k = 0; k < 2; ++k) dst[m][k] = *(const PG8_LAS bf16x8*)(lds + PG8_SA(b, h) + aoff + m * 2048 + k * 1024); } while (0)
#define PG8_LDB(dst, b, h) do { _Pragma("unroll") for (int n = 0; n < 2; ++n) _Pragma("unroll") for (int k = 0; k < 2; ++k) dst[n][k] = *(const PG8_LAS bf16x8*)(lds + PG8_SB(b, h) + boff + n * 2048 + k * 1024); } while (0)
#define PG8_MMA(ai, bj, At, Bt) do { __builtin_amdgcn_s_setprio(1); _Pragma("unroll") for (int m = 0; m < 4; ++m) _Pragma("unroll") for (int n = 0; n < 2; ++n) _Pragma("unroll") for (int k = 0; k < 2; ++k) \
        acc[ai][bj][m][n] = __builtin_amdgcn_mfma_f32_16x16x32_bf16(Bt[n][k], At[m][k], acc[ai][bj][m][n], 0, 0, 0); __builtin_amdgcn_s_setprio(0); } while (0)
#define PG8_WAIT_V(n) asm volatile("s_waitcnt vmcnt(" #n ")" ::: "memory")
#define PG8_WAIT_L(n) asm volatile("s_waitcnt lgkmcnt(" #n ")" ::: "memory")
#define PG8_BAR __builtin_amdgcn_s_barrier()
#define PG8_SCHED __builtin_amdgcn_sched_barrier(0)
    Unit cur, nxt; int ui = 0;
    if (!S.next(0, cur)) return;
    f32x4 acc[2][2][4][2];
#pragma unroll
    for (int a = 0; a < 2; ++a)
#pragma unroll
        for (int b = 0; b < 2; ++b)
#pragma unroll
            for (int m = 0; m < 4; ++m)
#pragma unroll
                for (int n = 0; n < 2; ++n) acc[a][b][m][n] = (f32x4){0.f, 0.f, 0.f, 0.f};
    bf16x8 At[4][2], B0[2][2], B1[2][2];
    unsigned vAc[2][2], vAn[2][2];
    ad.a_offs(cur, Rs, Cs, vAc);
    PG8_STAGE(PG8_SB(0, 0), ad.b_ptr(cur, 0, 0), voffB); PG8_STAGE(PG8_SB(0, 1), ad.b_ptr(cur, 1, 0), voffB); PG8_STAGE_A(PG8_SA(0, 0), cur, 0, 0, vAc); PG8_STAGE_A(PG8_SA(0, 1), cur, 1, 0, vAc);
    if (wr == 1) PG8_BAR;
    PG8_WAIT_V(2); PG8_BAR;
    PG8_STAGE(PG8_SB(1, 0), ad.b_ptr(cur, 0, 1), voffB); PG8_STAGE_A(PG8_SA(1, 0), cur, 0, 1, vAc); PG8_STAGE(PG8_SB(1, 1), ad.b_ptr(cur, 1, 1), voffB);
    PG8_WAIT_V(6); PG8_BAR;
    for (;;) {
        const bool has_next = S.next(ui + 1, nxt);
        if (!has_next) nxt = cur;
        if constexpr (AD::GATHER) {
            if (has_next) ad.a_offs(nxt, Rs, Cs, vAn);
            else {
#pragma unroll
                for (int h = 0; h < 2; ++h)
#pragma unroll
                    for (int i = 0; i < 2; ++i) vAn[h][i] = vAc[h][i]; } }
#pragma clang loop unroll(disable)
        for (int t = 0; t < nt; t += 2) {
            const bool last = (t == nt - 2);
            const Unit u2 = last ? nxt : cur; const int k2 = last ? 0 : t + 2, k3 = k2 + 1;
            unsigned v2[2][2];
            if constexpr (AD::GATHER) {
#pragma unroll
                for (int h = 0; h < 2; ++h)
#pragma unroll
                    for (int i = 0; i < 2; ++i) v2[h][i] = last ? vAn[h][i] : vAc[h][i]; }
            PG8_LDB(B0, 0, 0); PG8_LDB(B1, 0, 1); PG8_SCHED; PG8_LDA(At, 0, 0); PG8_STAGE_A(PG8_SA(1, 1), cur, 1, t + 1, vAc);
            PG8_WAIT_V(8); PG8_WAIT_L(0); PG8_BAR; PG8_MMA(0, 0, At, B0); PG8_MMA(0, 1, At, B1); PG8_BAR; PG8_SCHED;
            PG8_LDA(At, 0, 1); PG8_STAGE(PG8_SB(0, 0), ad.b_ptr(u2, 0, k2), voffB); PG8_STAGE(PG8_SB(0, 1), ad.b_ptr(u2, 1, k2), voffB); PG8_STAGE_A(PG8_SA(0, 0), u2, 0, k2, v2);
            PG8_WAIT_V(8); PG8_WAIT_L(0); PG8_BAR; PG8_MMA(1, 0, At, B0); PG8_MMA(1, 1, At, B1); PG8_BAR; PG8_SCHED;
            PG8_LDB(B0, 1, 0); PG8_LDB(B1, 1, 1); PG8_SCHED; PG8_LDA(At, 1, 0); PG8_STAGE_A(PG8_SA(0, 1), u2, 1, k2, v2);
            PG8_WAIT_V(8); PG8_WAIT_L(0); PG8_BAR; PG8_MMA(0, 0, At, B0); PG8_MMA(0, 1, At, B1); PG8_BAR; PG8_SCHED;
            PG8_LDA(At, 1, 1); PG8_STAGE(PG8_SB(1, 0), ad.b_ptr(u2, 0, k3), voffB); PG8_STAGE(PG8_SB(1, 1), ad.b_ptr(u2, 1, k3), voffB); PG8_STAGE_A(PG8_SA(1, 0), u2, 0, k3, v2);
            PG8_WAIT_V(8); PG8_WAIT_L(0); PG8_BAR; PG8_MMA(1, 0, At, B0); PG8_MMA(1, 1, At, B1); PG8_BAR; PG8_SCHED;
        }
        if constexpr (ALIGN_EPI) { if (wr == 0) PG8_BAR; }
        E(acc, cur, wr, wc, fr, fq);
        if (!has_next) break;
#pragma unroll
        for (int a = 0; a < 2; ++a)
#pragma unroll
            for (int b = 0; b < 2; ++b)
#pragma unroll
                for (int m = 0; m < 4; ++m)
#pragma unroll
                    for (int n = 0; n < 2; ++n) acc[a][b][m][n] = (f32x4){0.f, 0.f, 0.f, 0.f};
        cur = nxt; ++ui;
        if constexpr (AD::GATHER) {
#pragma unroll
            for (int h = 0; h < 2; ++h)
#pragma unroll
                for (int i = 0; i < 2; ++i) vAc[h][i] = vAn[h][i]; }
        if constexpr (ALIGN_EPI) { if (wr == 1) PG8_BAR; }
    }
    PG8_WAIT_V(0);
    if constexpr (!ALIGN_EPI) { if (wr == 0) PG8_BAR; }
    PG8_BAR;
#undef PG8_SA
#undef PG8_SB
#undef PG8_STAGE
#undef PG8_STAGE_A
#undef PG8_LDA
#undef PG8_LDB
#undef PG8_MMA
#undef PG8_WAIT_V
#undef PG8_WAIT_L
#undef PG8_BAR
#undef PG8_SCHED
}
}
namespace attn_body {
using bf16=__hip_bfloat16;
using bf16x8=__attribute__((ext_vector_type(8)))short;
using s16x4=__attribute__((ext_vector_type(4)))short;
using f32x16=__attribute__((ext_vector_type(16)))float;
using f32x2_t=__attribute__((ext_vector_type(2)))float;
using u32x4=__attribute__((ext_vector_type(4)))unsigned;
constexpr int BATCH=2,NHEAD=16,SEQ=8192,D=64,DM=NHEAD*D;
constexpr int NW=8,QBLK=32,QB=QBLK*NW,KVBLK=64,NQB=SEQ/QB;
constexpr int ATTN_PITCH=DM, ATTN_UNIT_ROWS=QB;
__device__ __forceinline__ int crow(int r,int hi){return (r&3)+8*(r>>2)+4*hi;}
#define SBAR() __builtin_amdgcn_sched_barrier(0)
__device__ __forceinline__ void cmask(f32x16&p0,f32x16&p1,int jb,int qrel,int hi){
  const float NEG=-INFINITY; int kb=64*jb+4*hi;
  #pragma unroll
  for(int r=0;r<16;++r){int kv=kb+(r&3)+8*(r>>2); if(kv>qrel)p0[r]=NEG; if(kv+32>qrel)p1[r]=NEG;}
}

constexpr int NSLOT=3, SLOTB=8192;
constexpr int LDS_K=0, LDS_V=NSLOT*SLOTB, LDS_WS=2*NSLOT*SLOTB, LDS_OST=LDS_WS+NW*64*4, LDS_BIAS=LDS_OST+NW*4096, LDS_TKT=LDS_BIAS+SEQ*4, LDS_BYTES=LDS_TKT+16;
constexpr float C2=0.125f*1.4426950408889634f;
__device__ __forceinline__ void glds16(const void*gsrc,unsigned lds_dst){unsigned keep;
  asm volatile("s_mov_b32 %0, m0\n\ts_mov_b32 m0, %2\n\ts_nop 0\n\tglobal_load_lds_dwordx4 %1, off\n\ts_mov_b32 m0, %0":"=&s"(keep):"v"(gsrc),"s"(lds_dst):"memory");}
__device__ __forceinline__ void glds16s(const void*sbase,unsigned voff,unsigned lds_dst){unsigned keep;
  asm volatile("s_mov_b32 %0, m0\n\ts_mov_b32 m0, %3\n\ts_nop 0\n\tglobal_load_lds_dwordx4 %1, %2\n\ts_mov_b32 m0, %0":"=&s"(keep):"v"(voff),"s"(sbase),"s"(lds_dst):"memory");}
__device__ __forceinline__ float max3f(float a,float b,float c){float r;asm("v_max3_f32 %0, %1, %2, %3":"=v"(r):"v"(a),"v"(b),"v"(c));return r;}
__device__ __forceinline__ float max2f(float a,float b){float r;asm("v_max_f32_e32 %0, %1, %2":"=v"(r):"v"(a),"v"(b));return r;}
__device__ __forceinline__ float fadd_s(float a,float b){float r;asm("v_add_f32_e32 %0, %1, %2":"=v"(r):"v"(a),"v"(b));return r;}
__device__ __forceinline__ float fsub_s(float a,float b){float r;asm("v_sub_f32_e32 %0, %1, %2":"=v"(r):"v"(a),"v"(b));return r;}
typedef float f32x2_t __attribute__((ext_vector_type(2))); typedef __bf16 bf16x2_t __attribute__((ext_vector_type(2)));
__device__ __forceinline__ unsigned cvtpk_s(float lo,float hi){f32x2_t v={lo,hi};bf16x2_t b=__builtin_convertvector(v,bf16x2_t);return __builtin_bit_cast(unsigned,b);}
#define WAIT_BAR(N) asm volatile("s_waitcnt vmcnt(" #N ") lgkmcnt(0)\n\ts_barrier":::"memory")

__device__ __forceinline__ void qkt(f32x16&p0,f32x16&p1,const char*Kslot,const bf16x8*qr,const f32x16&negm,int r32,int hi){
  const char*kb=Kslot+hi*1024+r32*16;
  #pragma unroll
  for(int d0=0;d0<4;++d0){
    const bf16x8 b0=*reinterpret_cast<const bf16x8*>(kb+d0*2048);
    const bf16x8 b1=*reinterpret_cast<const bf16x8*>(kb+d0*2048+512);
    if(d0==0){p0=__builtin_amdgcn_mfma_f32_32x32x16_bf16(b0,qr[0],negm,0,0,0);p1=__builtin_amdgcn_mfma_f32_32x32x16_bf16(b1,qr[0],negm,0,0,0);}
    else{p0=__builtin_amdgcn_mfma_f32_32x32x16_bf16(b0,qr[d0],p0,0,0,0);p1=__builtin_amdgcn_mfma_f32_32x32x16_bf16(b1,qr[d0],p1,0,0,0);}}
}
typedef __attribute__((address_space(3))) const char* lds_cptr;
typedef short v4i16_t __attribute__((ext_vector_type(4)));
__device__ __forceinline__ void kload8(bf16x8*kf,lds_cptr kp){
  kf[0]=*(const __attribute__((address_space(3))) bf16x8*)(kp);      kf[1]=*(const __attribute__((address_space(3))) bf16x8*)(kp+512);
  kf[2]=*(const __attribute__((address_space(3))) bf16x8*)(kp+2048); kf[3]=*(const __attribute__((address_space(3))) bf16x8*)(kp+2560);
  kf[4]=*(const __attribute__((address_space(3))) bf16x8*)(kp+4096); kf[5]=*(const __attribute__((address_space(3))) bf16x8*)(kp+4608);
  kf[6]=*(const __attribute__((address_space(3))) bf16x8*)(kp+6144); kf[7]=*(const __attribute__((address_space(3))) bf16x8*)(kp+6656);
}
__device__ __forceinline__ void kload2(bf16x8*kf,lds_cptr kp,int j){ kf[2*j]=*(const __attribute__((address_space(3))) bf16x8*)(kp+j*2048); kf[2*j+1]=*(const __attribute__((address_space(3))) bf16x8*)(kp+j*2048+512); }
__device__ __forceinline__ s16x4 vtr(lds_cptr p){ return __builtin_bit_cast(s16x4,__builtin_amdgcn_ds_read_tr16_b64_v4i16((__attribute__((address_space(3))) v4i16_t*)p)); }
__device__ __forceinline__ float rowmax(const f32x16&p0,const f32x16&p1){
  float a=max3f(p0[0],p0[1],p1[0]),b=max3f(p0[2],p0[3],p1[1]);a=max3f(a,p1[2],p1[3]);
  #pragma unroll
  for(int r=4;r<16;r+=4){a=max3f(a,p0[r],p0[r+1]);b=max3f(b,p0[r+2],p0[r+3]);a=max3f(a,p1[r],p1[r+1]);b=max3f(b,p1[r+2],p1[r+3]);}
  const float m=max2f(a,b);
  auto rr=__builtin_amdgcn_permlane32_swap(__float_as_uint(m),__float_as_uint(m),false,false);
  return max2f(__uint_as_float(rr[0]),__uint_as_float(rr[1]));
}
__device__ __forceinline__ void pv(f32x16*o,int vb,bf16x8 pa0,bf16x8 pa1,bf16x8 pa2,bf16x8 pa3){
  #pragma unroll
  for(int d0=0;d0<2;++d0){s16x4 lo[4],hi[4];
    #pragma unroll
    for(int ks=0;ks<4;++ks){
      asm volatile("ds_read_b64_tr_b16 %0,%1 offset:%c2":"=&v"(lo[ks]):"v"(vb),"i"(d0*4096+ks*1024):"memory");
      asm volatile("ds_read_b64_tr_b16 %0,%1 offset:%c2":"=&v"(hi[ks]):"v"(vb),"i"(d0*4096+ks*1024+512):"memory");}
    asm volatile("s_waitcnt lgkmcnt(0)":::"memory");SBAR();
    #define PK(k) (bf16x8){lo[k][0],lo[k][1],lo[k][2],lo[k][3],hi[k][0],hi[k][1],hi[k][2],hi[k][3]}
    o[d0]=__builtin_amdgcn_mfma_f32_32x32x16_bf16(pa0,PK(0),o[d0],0,0,0);
    o[d0]=__builtin_amdgcn_mfma_f32_32x32x16_bf16(pa1,PK(1),o[d0],0,0,0);
    o[d0]=__builtin_amdgcn_mfma_f32_32x32x16_bf16(pa2,PK(2),o[d0],0,0,0);
    o[d0]=__builtin_amdgcn_mfma_f32_32x32x16_bf16(pa3,PK(3),o[d0],0,0,0);
    #undef PK
  }
}

#ifndef ATTN_STORE16
#define ATTN_STORE16(p,v) (*(u32x4*)(p)=(v))
#endif
template<int THRL> __device__ __forceinline__ void attn_unit(int b,int h,int qb,const bf16*Q,const bf16*__restrict__ K,const bf16*__restrict__ V,bf16*O,const float*Fm,const unsigned*NQ,const unsigned*NK,unsigned*ctr,char*shm){
  int tid=threadIdx.x; asm volatile("":"+v"(tid));
  const int lane=tid&63,r32=lane&31,hi=lane>>5; const int wid=__builtin_amdgcn_readfirstlane(tid>>6);
  const long rowbase=(long)b*SEQ; const int q0=qb*QB;
  typedef __attribute__((address_space(3))) float lds_f32; typedef __attribute__((address_space(3))) const f32x2_t* lds_cf2;
  int t_start; const float*Fh=Fm+(long)(b*NHEAD+h)*SEQ; float fref;
  int tid2=tid; asm volatile("":"+v"(tid2));
  { fref=__hip_atomic_load(Fh+q0,__ATOMIC_RELAXED,__HIP_MEMORY_SCOPE_AGENT);
    const unsigned*nq=NQ+((b*NQB+qb)*NHEAD+h)*2; const unsigned*nk=NK+(b*NHEAD+h)*2;
    const float q2=__uint_as_float(__hip_atomic_load(nq,__ATOMIC_RELAXED,__HIP_MEMORY_SCOPE_AGENT))+__uint_as_float(__hip_atomic_load(nq+1,__ATOMIC_RELAXED,__HIP_MEMORY_SCOPE_AGENT));
    const float k2=__uint_as_float(__hip_atomic_load(nk,__ATOMIC_RELAXED,__HIP_MEMORY_SCOPE_AGENT))+__uint_as_float(__hip_atomic_load(nk+1,__ATOMIC_RELAXED,__HIP_MEMORY_SCOPE_AGENT));
    const float thr=43.3f+2.02f*sqrtf(q2*k2);
    const int NTf=(q0+QB)/KVBLK; int cnt=0;
    _Pragma("unroll") for(int jj=0;jj<2;++jj){ const int j=1+(tid2&63)+64*jj; bool ok=false; if(j<=NTf-4) ok=((fref-Fh[64*j-1])*1.4426950408889634f<=-thr); cnt+=__popcll(__ballot(ok)); }
    t_start=__builtin_amdgcn_readfirstlane(cnt&~1);
  }
  const lds_cf2 bias2=(lds_cf2)((__attribute__((address_space(3))) const char*)shm+LDS_BIAS)+2*hi+t_start*32;
  const bf16*Qw=Q+(rowbase+q0+wid*QBLK)*DM+h*D;
  const bf16*Kh=K+(rowbase+(long)t_start*KVBLK)*DM+h*D,*Vh=V+(rowbase+(long)t_start*KVBLK)*DM+h*D;
  const unsigned lds0=(unsigned)(uintptr_t)shm;
  float*wsf=(float*)(shm+LDS_WS)+wid*64;
  const bf16*ksrc=Kh+wid*8;
  const bf16*vsrc=Vh+(long)(16*(wid&3))*DM+(wid>>2)*32;
  const unsigned kvoff=(unsigned)lane*(DM*2), vvoff=(unsigned)((lane>>2)*DM+(lane&3)*8)*2u;
  const unsigned kdst=lds0+LDS_K+wid*1024, vdst=lds0+LDS_V+wid*1024;
  #define DMA_K(t,slot) glds16s(ksrc+(long)(t)*KVBLK*DM,kvoff,(unsigned)__builtin_amdgcn_readfirstlane(kdst+(slot)))
  #define DMA_V(t,slot) glds16s(vsrc+(long)(t)*KVBLK*DM,vvoff,(unsigned)__builtin_amdgcn_readfirstlane(vdst+(slot)))
  const char*Kbase=shm+LDS_K; bf16x8 kf[8];
  const lds_cptr shm3=(lds_cptr)shm; const lds_cptr kp0=shm3+LDS_K+hi*1024+r32*16; const lds_cptr vp0=shm3+LDS_V+((lane>>4)&1)*32+(lane&3)*8+(4*hi+((lane&15)>>2))*64;
  const int NT=(q0+QB)/KVBLK-t_start;
  DMA_K(0,0);DMA_V(0,0);DMA_K(1,SLOTB);
  bf16x8 qr[4];
  #pragma unroll
  for(int d0=0;d0<4;++d0)qr[d0]=*reinterpret_cast<const bf16x8*>(&Qw[(long)r32*DM+d0*16+hi*8]);
  { lds_f32*bl=(lds_f32*)((__attribute__((address_space(3))) char*)shm+LDS_BIAS);
    _Pragma("clang loop unroll(disable) vectorize(disable)")
    for(int s0=t_start*KVBLK+tid2;s0<q0+QB;s0+=4*NW*64){ float f_[4];
      _Pragma("unroll") for(int u_=0;u_<4;++u_){ const int s_=s0+u_*NW*64; f_[u_]=Fh[s_<q0+QB?s_:q0]; }
      _Pragma("unroll") for(int u_=0;u_<4;++u_){ const int s_=s0+u_*NW*64; if(s_<q0+QB)bl[s_]=(fref-f_[u_])*1.4426950408889634f; } } }
  float mhat=0.f,l_reg=0.f;f32x16 o[2];o[0]=f32x16{};o[1]=f32x16{};f32x16 negm=f32x16{};asm volatile("":"+v"(negm));
  const int qrel=wid*QBLK+r32;
  #define CMASK(P0,P1,t) do{int jb_=(t)-(NT-4); if(jb_>=0)cmask(P0,P1,jb_,qrel,hi);}while(0)
  #define BIASADD(P0,P1,t) do{ const lds_cf2 bp_=bias2+(t)*32; \
    _Pragma("unroll") for(int j_=0;j_<4;++j_){ SBAR(); \
      const f32x2_t b0_=bp_[4*j_], b1_=bp_[4*j_+1], b2_=bp_[4*j_+16], b3_=bp_[4*j_+17];     \
      P0[4*j_]+=b0_[0]; P0[4*j_+1]+=b0_[1]; P0[4*j_+2]+=b1_[0]; P0[4*j_+3]+=b1_[1]; \
      P1[4*j_]+=b2_[0]; P1[4*j_+1]+=b2_[1]; P1[4*j_+2]+=b3_[0]; P1[4*j_+3]+=b3_[1]; } SBAR(); }while(0)
  bool resc=false;
  #define START(P0,P1) do{ const float rm=rowmax(P0,P1); resc=false; \
    { const float dl=rm; mhat=fadd_s(mhat,dl); \
      _Pragma("unroll") for(int r=0;r<16;++r){P0[r]=fsub_s(P0[r],dl);P1[r]=fsub_s(P1[r],dl);} \
      _Pragma("unroll") for(int r=0;r<16;++r)negm[r]=-mhat; asm volatile("":"+v"(negm)); } \
    _Pragma("unroll") for(int r=0;r<16;++r)P0[r]=__builtin_amdgcn_exp2f(P0[r]); }while(0)
  #define RESC() do{ if(resc){ asm volatile("s_waitcnt lgkmcnt(0)":::"memory"); \
      _Pragma("unroll") for(int d_=0;d_<2;++d_) _Pragma("unroll") for(int r=0;r<16;++r)o[d_][r]*=wsf[crow(r,hi)]; } }while(0)
  f32x16 pA0,pA1,pB0,pB1;
  int sl_prev=0,sl_cur=0,sl_next=SLOTB;
  #define ROT() do{sl_prev=sl_cur;sl_cur=sl_next;sl_next=(sl_next==(NSLOT-1)*SLOTB)?0:sl_next+SLOTB;}while(0)
  DMA_K(2,2*SLOTB);
  WAIT_BAR(3);
  qkt(pA0,pA1,Kbase,qr,negm,r32,hi);asm volatile("s_nop 15\n\ts_nop 7":"+v"(pA0),"+v"(pA1));BIASADD(pA0,pA1,0);CMASK(pA0,pA1,0);
  START(pA0,pA1);
  _Pragma("unroll") for(int r=0;r<16;++r)pA1[r]=__builtin_amdgcn_exp2f(pA1[r]);
  WAIT_BAR(0);
  DMA_K(3,0);DMA_V(1,SLOTB);
  ROT();
  kload8(kf,kp0+sl_cur);
  WAIT_BAR(2);
  s16x4 vlo[8],vhi[8]; u32x4 pw0,pw1,pw2,pw3;
  #define PKW(P,B) cvtpk_s(P[B],P[B+1])
  #define PAF(k) __builtin_bit_cast(bf16x8,pw##k)
  #define VFR(i) (bf16x8){vlo[i][0],vlo[i][1],vlo[i][2],vlo[i][3],vhi[i][0],vhi[i][1],vhi[i][2],vhi[i][3]}
  #define PIN(x) asm volatile("":"+v"(x))
  #define MX3(a,b,c) __builtin_fmaxf(__builtin_fmaxf((a),(b)),(c))
  #define GAPA(MF,A0,A1,A2,A3,W0,W1,PW) do{ MF; sacc+=A0; sacc+=A1; sacc+=A2; sacc+=A3; PIN(sacc); W0; W1; PIN(PW); SBAR(); }while(0)
  #define EX(v) __builtin_amdgcn_exp2f(v)
  #define GAPB(MF,X,B) do{ MF; X[B]=EX(X[B]); X[B+1]=EX(X[B+1]); X[B+2]=EX(X[B+2]); X[B+3]=EX(X[B+3]); PIN(X); SBAR(); }while(0)
  #define VRD(i) do{ vlo[i]=vtr(vp_+(((i)>>2)*4096+((i)&3)*1024)); vhi[i]=vtr(vp_+(((i)>>2)*4096+((i)&3)*1024+512)); }while(0)
  #define KRD(G,j) do{ if(G){ kload2(kf,kp0+sl_next,j); SBAR(); } }while(0)
  #define STEP(C0,C1,P0,P1,t,GK,GV,GL) do{ SBAR(); \
    const lds_cptr vp_=vp0+sl_prev; \
    VRD(0); SBAR(); float sacc=(P0[0]+P0[1]); \
    GAPA(C0=__builtin_amdgcn_mfma_f32_32x32x16_bf16(kf[0],qr[0],negm,0,0,0), P0[2],P0[3],P0[4],P0[5],     pw0[0]=PKW(P0,0), pw0[1]=PKW(P0,2), pw0); \
    VRD(4); SBAR(); GAPA(C1=__builtin_amdgcn_mfma_f32_32x32x16_bf16(kf[1],qr[0],negm,0,0,0), P0[6],P0[7],P0[8],P0[9],     pw0[2]=PKW(P0,4), pw0[3]=PKW(P0,6), pw0); \
    VRD(1); SBAR(); GAPA(C0=__builtin_amdgcn_mfma_f32_32x32x16_bf16(kf[2],qr[1],C0,0,0,0),   P0[10],P0[11],P0[12],P0[13], pw1[0]=PKW(P0,8), pw1[1]=PKW(P0,10), pw1); \
    VRD(5); SBAR(); GAPA(C1=__builtin_amdgcn_mfma_f32_32x32x16_bf16(kf[3],qr[1],C1,0,0,0),   P0[14],P0[15],P1[0],P1[1],   pw1[2]=PKW(P0,12),pw1[3]=PKW(P0,14), pw1); \
    VRD(2); SBAR(); GAPA(C0=__builtin_amdgcn_mfma_f32_32x32x16_bf16(kf[4],qr[2],C0,0,0,0),   P1[2],P1[3],P1[4],P1[5],     pw2[0]=PKW(P1,0), pw2[1]=PKW(P1,2), pw2); \
    VRD(6); SBAR(); GAPA(C1=__builtin_amdgcn_mfma_f32_32x32x16_bf16(kf[5],qr[2],C1,0,0,0),   P1[6],P1[7],P1[8],P1[9],     pw2[2]=PKW(P1,4), pw2[3]=PKW(P1,6), pw2); \
    VRD(3); SBAR(); GAPA(C0=__builtin_amdgcn_mfma_f32_32x32x16_bf16(kf[6],qr[3],C0,0,0,0),   P1[10],P1[11],P1[12],P1[13], pw3[0]=PKW(P1,8), pw3[1]=PKW(P1,10), pw3); \
    VRD(7); SBAR(); GAPA(C1=__builtin_amdgcn_mfma_f32_32x32x16_bf16(kf[7],qr[3],C1,0,0,0),   P1[14],P1[15],0.f,0.f,       pw3[2]=PKW(P1,12),pw3[3]=PKW(P1,14), pw3); \
    l_reg+=sacc; \
    if(GK){DMA_K((t)+3,sl_cur);} if(GV){DMA_V((t)+1,sl_next);} \
    BIASADD(C0,C1,t); CMASK(C0,C1,t); \
    { float a=MX3(C0[0],C0[1],C1[0]),b=MX3(C0[2],C0[3],C1[1]); a=MX3(a,C1[2],C1[3]); \
      _Pragma("unroll") for(int r=4;r<16;r+=4){a=MX3(a,C0[r],C0[r+1]);b=MX3(b,C0[r+2],C0[r+3]);a=MX3(a,C1[r],C1[r+1]);b=MX3(b,C1[r+2],C1[r+3]);} \
      float rm=__builtin_fmaxf(a,b); { auto rr=__builtin_amdgcn_permlane32_swap(__float_as_uint(rm),__float_as_uint(rm),false,false); rm=__builtin_fmaxf(__uint_as_float(rr[0]),__uint_as_float(rr[1])); } \
      resc=false; \
      if(__builtin_expect(__any(rm>(float)THRL),0)){ const float dl=__builtin_fmaxf(rm,0.f); mhat+=dl; \
        _Pragma("unroll") for(int r=0;r<16;++r){C0[r]-=dl;C1[r]-=dl;} \
        _Pragma("unroll") for(int r=0;r<16;++r)negm[r]=-mhat; asm volatile("":"+v"(negm)); \
        const float f=__builtin_amdgcn_exp2f(-dl); l_reg*=f; if(hi==0)wsf[r32]=f; resc=true; } } \
    SBAR(); \
    GAPB(o[0]=__builtin_amdgcn_mfma_f32_32x32x16_bf16(PAF(0),VFR(0),o[0],0,0,0), C0,0); \
    GAPB(o[1]=__builtin_amdgcn_mfma_f32_32x32x16_bf16(PAF(0),VFR(4),o[1],0,0,0), C0,4); \
    KRD(GL,0); GAPB(o[0]=__builtin_amdgcn_mfma_f32_32x32x16_bf16(PAF(1),VFR(1),o[0],0,0,0), C0,8); \
    KRD(GL,1); GAPB(o[1]=__builtin_amdgcn_mfma_f32_32x32x16_bf16(PAF(1),VFR(5),o[1],0,0,0), C0,12); \
    KRD(GL,2); GAPB(o[0]=__builtin_amdgcn_mfma_f32_32x32x16_bf16(PAF(2),VFR(2),o[0],0,0,0), C1,0); \
    KRD(GL,3); GAPB(o[1]=__builtin_amdgcn_mfma_f32_32x32x16_bf16(PAF(2),VFR(6),o[1],0,0,0), C1,4); \
    GAPB(o[0]=__builtin_amdgcn_mfma_f32_32x32x16_bf16(PAF(3),VFR(3),o[0],0,0,0), C1,8); \
    GAPB(o[1]=__builtin_amdgcn_mfma_f32_32x32x16_bf16(PAF(3),VFR(7),o[1],0,0,0), C1,12); \
    }while(0)
  int t=1;
  #undef CMASK
  #define CMASK(P0,P1,t) do{}while(0)
  for(;t+5<NT;t+=2){
    STEP(pB0,pB1,pA0,pA1,t,true,true,true);     WAIT_BAR(2); RESC(); ROT();
    STEP(pA0,pA1,pB0,pB1,t+1,true,true,true);   WAIT_BAR(2); RESC(); ROT();
  }
  #undef CMASK
  #define CMASK(P0,P1,t) do{int jb_=(t)-(NT-4); if(jb_>=0)cmask(P0,P1,jb_,qrel,hi);}while(0)
  #define ENDW(tt) do{ if((tt)+3<NT){WAIT_BAR(2);} else if((tt)+2<NT){WAIT_BAR(1);} else {WAIT_BAR(0);} }while(0)
  for(;t+1<NT;t+=2){
    STEP(pB0,pB1,pA0,pA1,t,(t+3<NT),(t+1<NT),(t+1<NT));       ENDW(t);   RESC(); ROT();
    STEP(pA0,pA1,pB0,pB1,t+1,(t+4<NT),(t+2<NT),(t+2<NT));     ENDW(t+1); RESC(); ROT();
  }
  STEP(pB0,pB1,pA0,pA1,NT-1,false,false,false); RESC();
  { float sacc=pB0[0]+pB0[1]; _Pragma("unroll") for(int r=2;r<16;++r)sacc+=pB0[r]; _Pragma("unroll") for(int r=0;r<16;++r)sacc+=pB1[r]; l_reg+=sacc;
    pw0=(u32x4){PKW(pB0,0),PKW(pB0,2),PKW(pB0,4),PKW(pB0,6)};pw1=(u32x4){PKW(pB0,8),PKW(pB0,10),PKW(pB0,12),PKW(pB0,14)};pw2=(u32x4){PKW(pB1,0),PKW(pB1,2),PKW(pB1,4),PKW(pB1,6)};pw3=(u32x4){PKW(pB1,8),PKW(pB1,10),PKW(pB1,12),PKW(pB1,14)};
    const int vb0=(int)(lds0+LDS_V)+((lane>>4)&1)*32+(lane&3)*8+(4*hi+((lane&15)>>2))*64;
    SBAR(); pv(o,vb0+sl_cur,PAF(0),PAF(1),PAF(2),PAF(3)); }
  #undef PKW
  #undef PAF
  #undef VFR
  #undef PIN
  #undef MX3
  #undef GAPA
  #undef GAPB
  #undef EX
  #undef VRD
  #undef KRD
  #undef STEP
  #undef ENDW
  unsigned tk_=0u; if(tid==0)tk_=__hip_atomic_fetch_add(ctr,1u,__ATOMIC_RELAXED,__HIP_MEMORY_SCOPE_AGENT);
  {auto rr=__builtin_amdgcn_permlane32_swap(__float_as_uint(l_reg),__float_as_uint(l_reg),false,false);l_reg=__uint_as_float(rr[0])+__uint_as_float(rr[1]);}
  if(hi==0)wsf[32+r32]=l_reg;asm volatile("s_waitcnt lgkmcnt(0)":::"memory");
  float rli[16];
  #pragma unroll
  for(int r=0;r<16;++r)rli[r]=__builtin_amdgcn_rcpf(wsf[32+crow(r,hi)]);
  bf16*Ow=O+(rowbase+q0+wid*QBLK)*DM+h*D;
  { bf16*stg=(bf16*)(shm+LDS_OST)+wid*2048;
    #pragma unroll
    for(int r=0;r<16;++r){const int orow=crow(r,hi);
      #pragma unroll
      for(int d0=0;d0<2;++d0)stg[orow*64+d0*32+r32]=__float2bfloat16(o[d0][r]*rli[r]);}
    asm volatile("s_waitcnt lgkmcnt(0)":::"memory");
    #pragma unroll
    for(int i=0;i<4;++i){const int row=i*8+(lane>>3),ch=lane&7; const u32x4 v=*(const u32x4*)(stg+row*64+ch*8); ATTN_STORE16(Ow+(long)row*DM+ch*8,v);} }
  if(tid==0)*(__attribute__((address_space(3))) unsigned*)((__attribute__((address_space(3))) char*)shm+LDS_TKT)=tk_;
  asm volatile("s_waitcnt lgkmcnt(0)\n\ts_barrier":::"memory");
  #undef DMA_K
  #undef BIASADD
  #undef DMA_V
  #undef CMASK
  #undef START
  #undef RESC
  #undef ROT
}
constexpr int ATTN_LDS_BYTES=LDS_BYTES;
struct AttnTensors { const bf16* Q; const bf16* K; const bf16* V; bf16* O; const float* F; const unsigned* NQ; const unsigned* NK; };
struct AttnUnit { int bh; int qb; };
struct StaticOrder {
  int vcu,G;
  __device__ __forceinline__ explicit StaticOrder(int grid,int vcu_):vcu(vcu_),G(grid){}
  __device__ __forceinline__ bool next(int i,AttnUnit&u)const{ const int quad=(i>>2)*G+vcu; if(quad>=BATCH*NHEAD*8)return false; const int s=quad&7,j=i&3; u.bh=quad>>3; u.qb=(j==0)?s:(j==1)?15-s:(j==2)?16+s:31-s; return true; }
  __device__ __forceinline__ void a_ready(const AttnUnit&)const{}
  __device__ __forceinline__ void done(const AttnUnit&)const{}
};
constexpr int NUNITS=BATCH*NHEAD*NQB;
template<int THRL=60> __device__ __forceinline__ void attn_phase(char*lds,const AttnTensors&T,unsigned*ctr){
  __attribute__((address_space(3))) unsigned*tkt=(__attribute__((address_space(3))) unsigned*)((__attribute__((address_space(3))) char*)lds+LDS_TKT);
  if(threadIdx.x==0)*tkt=__hip_atomic_fetch_add(ctr,1u,__ATOMIC_RELAXED,__HIP_MEMORY_SCOPE_AGENT);
  asm volatile("s_waitcnt vmcnt(0) lgkmcnt(0)\n\ts_barrier":::"memory");
  for(;;){ const unsigned n=(unsigned)__builtin_amdgcn_readfirstlane((int)*tkt); if(n>=(unsigned)NUNITS)break;
    const int bh=(int)(n&31u),qb=NQB-1-(int)(n>>5);
    attn_unit<THRL>(bh/NHEAD,bh%NHEAD,qb,T.Q,T.K,T.V,T.O,T.F,T.NQ,T.NK,ctr,lds); }
}
#undef SBAR
#undef WAIT_BAR
}
constexpr int NWAVES = 8;
#ifndef MK_PER_PHASE
#define MK_PER_PHASE 0
#endif
constexpr int NPHASE = 15;

constexpr int BATCH = 4, T = 8192, D = 1024, H = 16, HD = 64;
constexpr int M = BATCH * T;
constexpr int NQKV = 3 * D;
constexpr int MH = M / 2, BH = BATCH / 2;
constexpr int NEXP = 16, DEXP = 256, NBUCKET = 24, MAXTILES = 88, HROWS = MAXTILES * 256, BCAP = MH;
constexpr int NBLK = MH / 128;
constexpr float RMS_EPS = 1e-6f;

constexpr size_t MiB = 1u << 20, KiB = 1u << 10;
constexpr size_t WS_CTL = 0, CTL_ZERO_BYTES = 128 * KiB;
constexpr size_t WS_TOKINFO = 1 * MiB, WS_TOKGATE = WS_TOKINFO + 128 * KiB, WS_HIST = WS_TOKGATE + 256 * KiB, WS_TILETBL = WS_HIST + 32 * KiB, WS_TOKROW = WS_TILETBL + 4 * KiB,
                 WS_GATEROW = WS_TOKROW + 160 * KiB, WS_BLKSUM = WS_GATEROW + 320 * KiB, WS_RWG = WS_BLKSUM + 16 * KiB, WS_WFG = WS_RWG + 160 * KiB, WS_TRASH = WS_WFG + 64 * KiB, WS_SMALL_END = WS_TRASH + 4 * KiB;
static_assert(WS_SMALL_END <= 4 * MiB, "small tables");
constexpr size_t WS_LF = 4 * MiB, WS_FM = 6 * MiB;
constexpr size_t WS_WPOOL = 8 * MiB, WS_WQKV = 9 * MiB, WS_WO = 15 * MiB, WS_WG = 17 * MiB, WS_WU = 33 * MiB, WS_WD = 49 * MiB;
constexpr size_t WS_XN = 66 * MiB;
constexpr size_t WS_QO = 130 * MiB, WS_K = 194 * MiB, WS_V = 258 * MiB;
constexpr size_t WS_HMID = 322 * MiB, WS_Y0 = 370 * MiB, WS_DPOOL = 434 * MiB, WS_TOKROW2 = 498 * MiB, WS_GATEROW2 = 501 * MiB, WS_END = 508 * MiB;
static_assert(WS_HMID + (size_t)2 * HROWS * 512 * 2 <= WS_Y0 && WS_TOKROW2 + (size_t)2 * NBUCKET * BCAP * 4 <= WS_GATEROW2 && WS_GATEROW2 + (size_t)2 * NBUCKET * BCAP * 8 <= WS_END && WS_V - WS_K == WS_K - WS_QO, "d_ws map");
constexpr int CW_BAR = 4096;
constexpr int CW_NRM = 8192;
constexpr int CW_CNT = 12800;
constexpr int CW_CONV = 13120;
constexpr int CW_BARH = 16384;
constexpr int CW_ATQ = 12544;
static_assert(CW_NRM + 4096 + 128 <= CW_ATQ && (CW_BARH + 2 * 3456) * 4 <= (int)CTL_ZERO_BYTES, "CTL words inside the memset region");

constexpr int RING_OFF = 0, RING_BYTES = 131072;
constexpr int LDSCTL_OFF = RING_BYTES, MISC_OFF = LDSCTL_OFF + 320;
constexpr int TBL_OFF = RING_BYTES + 1024;
constexpr int LDS_BYTES = 147456;
static_assert(MISC_OFF + 128 <= TBL_OFF && TBL_OFF + (1 + 3 * MAXTILES) * 4 <= LDS_BYTES, "LDS map");

#define GAS __attribute__((address_space(1)))
#define LAS __attribute__((address_space(3)))
typedef unsigned short bf16;
typedef unsigned v4u __attribute__((ext_vector_type(4)));
typedef float f32x4 __attribute__((ext_vector_type(4)));
typedef float f32x2 __attribute__((ext_vector_type(2)));
typedef GAS unsigned gu32;
#define RLX_AGENT __ATOMIC_RELAXED, __HIP_MEMORY_SCOPE_AGENT
#define LDS_WAIT() asm volatile("s_waitcnt lgkmcnt(0)" ::: "memory")
__device__ __forceinline__ unsigned f2bf(float f) { unsigned u = __builtin_bit_cast(unsigned, f); return (u + 0x7fffu + ((u >> 16) & 1u)) >> 16; }
__device__ __forceinline__ unsigned pk2(float lo, float hi) { return f2bf(lo) | (f2bf(hi) << 16); }

#define XB_TMO      128
#define XB_XCNT(j)  (256  + 64 * (j))
#define XB_XSUB(j)  (1280 + 64 * (j))
#define XB_XGEN(j)  (2304 + 64 * (j))
#define XB_TOP      3328
#define XB_TOPGEN   3392
#define XCD_BAR_WORDS 3456
#define XB_SPIN_CAP (1u << 18)

__device__ __forceinline__ unsigned xb_ld(unsigned* p)              { return __hip_atomic_load(p, __ATOMIC_RELAXED, __HIP_MEMORY_SCOPE_AGENT); }
__device__ __forceinline__ unsigned xb_add(unsigned* p, unsigned v) { return __hip_atomic_fetch_add(p, v, __ATOMIC_RELAXED, __HIP_MEMORY_SCOPE_AGENT); }
__device__ __forceinline__ unsigned xb_xcc_id() { return (unsigned)__builtin_amdgcn_s_getreg((3 << 11) | 20) & 0xFu; }
#define XB_SPIN(cond, bar) do { unsigned _sp = 0; while (cond) { __builtin_amdgcn_s_sleep(1); \
    if ((++_sp & 255u) == 0u) { if (xb_ld(&(bar)[XB_TMO])) break; if (_sp > XB_SPIN_CAP) { atomicAdd(&(bar)[XB_TMO], 1u); break; } } } } while (0)

struct XcdBarrier {
    unsigned* bar; unsigned x; unsigned G;
    volatile LAS unsigned* st;
};

__device__ __forceinline__ XcdBarrier xcd_barrier_post(unsigned* bar, volatile LAS unsigned* st, unsigned G) {
    XcdBarrier b; b.bar = bar; b.x = xb_xcc_id(); b.st = st; b.G = G;
    if (threadIdx.x == 0) (void)xb_add(&bar[XB_XCNT(b.x)], 1u);
    return b;
}
__device__ __forceinline__ void xcd_barrier_complete(unsigned* bar, unsigned x, unsigned& nloc, unsigned& nx, const unsigned G) {
    unsigned sum, cnt, mine, sp = 0u;
    for (;;) {
        sum = 0u; cnt = 0u; mine = 0u;
#pragma unroll
        for (unsigned j = 0; j < 16; ++j) { const unsigned c = xb_ld(&bar[XB_XCNT(j)]); sum += c; cnt += (c > 0u) ? 1u : 0u; mine = (j == x) ? c : mine; }
        if (sum == G) break;
        __builtin_amdgcn_s_sleep(1);
        if ((++sp & 255u) == 0u) { if (xb_ld(&bar[XB_TMO])) break; if (sp > XB_SPIN_CAP) { atomicAdd(&bar[XB_TMO], 1u); break; } }
    }
    nloc = mine > 0u ? mine : 1u; nx = cnt > 0u ? cnt : 1u;
}

__device__ __forceinline__ void xcd_barrier(const XcdBarrier& b) {
    asm volatile("s_waitcnt vmcnt(0)" ::: "memory");
    __syncthreads();
    if (threadIdx.x == 0) {
        unsigned* bar = b.bar;
        __builtin_amdgcn_s_waitcnt(0);
        unsigned nloc = b.st[0], nx = b.st[1];
        if (nloc == 0u) { xcd_barrier_complete(bar, b.x, nloc, nx, b.G); b.st[0] = nloc; b.st[1] = nx; }
        const unsigned old = xb_add(&bar[XB_XSUB(b.x)], 1u);
        const unsigned gen = old / nloc;
        if (old + 1u == (gen + 1u) * nloc) {
            __builtin_amdgcn_fence(__ATOMIC_RELEASE, "agent");
            asm volatile("s_waitcnt vmcnt(0)" ::: "memory");
            const unsigned og = xb_add(&bar[XB_TOP], 1u);
            const unsigned tg = og / nx;
            if (og + 1u == (tg + 1u) * nx) xb_add(&bar[XB_TOPGEN], 1u);
            else XB_SPIN(xb_ld(&bar[XB_TOPGEN]) == tg, bar);
            __builtin_amdgcn_fence(__ATOMIC_ACQUIRE, "agent");
            xb_add(&bar[XB_XGEN(b.x)], 1u);
            asm volatile("s_waitcnt vmcnt(0)" ::: "memory");
        } else {
            XB_SPIN(xb_ld(&bar[XB_XGEN(b.x)]) == gen, bar);
            __builtin_amdgcn_fence(__ATOMIC_ACQUIRE, "agent");
            asm volatile("s_waitcnt vmcnt(0)" ::: "memory");
        }
    }
    __syncthreads();
}
template <int I> __device__ __forceinline__ const float* kin() {
    const __attribute__((address_space(4))) volatile unsigned long long* kp = (const __attribute__((address_space(4))) volatile unsigned long long*)__builtin_amdgcn_kernarg_segment_ptr();
    const unsigned long long v = kp[I];
    return (const float*)(GAS const float*)v;
}
enum InIdx { I_X = 0, I_MIXN, I_FFNN, I_POOLW, I_POOLS, I_KVN, I_WK, I_WV, I_WF, I_BF, I_WQ, I_WO, I_RG, I_RGB, I_RE, I_REB, I_WGATE, I_WUP, I_WDOWN, I_FINN };
struct Frame {
    LAS unsigned char* lds;
    volatile LAS unsigned* MISC;
    int tid, lane, wave;
    int vcu, G;
    int half;
    float* out;
    unsigned char* ws;
#define WSP(name, T, OFF) __device__ __forceinline__ T* name() const { return (T*)(ws + (OFF)); }
#define WSH(name, T, OFF, PERHALF) __device__ __forceinline__ T* name() const { return (T*)(ws + (OFF)) + (size_t)half * (PERHALF); }
    WSP(WPOOL, bf16, WS_WPOOL) WSP(WQKV, bf16, WS_WQKV) WSP(WO, bf16, WS_WO) WSP(WG, bf16, WS_WG) WSP(WU, bf16, WS_WU) WSP(WD, bf16, WS_WD)
    WSH(XN, bf16, WS_XN, (size_t)MH * D) WSH(QO, bf16, WS_QO, (size_t)MH * D) WSH(KB, bf16, WS_K, (size_t)MH * D) WSH(VB, bf16, WS_V, (size_t)MH * D) WSH(HMID, bf16, WS_HMID, (size_t)HROWS * 512)
    WSH(TOKROW, int, WS_TOKROW2, (size_t)NBUCKET * BCAP) WSH(GATEROW, float, WS_GATEROW2, (size_t)NBUCKET * BCAP * 2)
    WSH(BLKSUM, float, WS_BLKSUM, NBLK * 16) WSP(RWG, float, WS_RWG) WSP(WFG, float, WS_WFG) WSH(LF, float, WS_LF, (size_t)MH * 16) WSH(FM, float, WS_FM, (size_t)BH * H * T) WSP(TRASH, bf16, WS_TRASH)
    WSH(DPOOL, bf16, WS_DPOOL, (size_t)MH * D) WSH(Y0, bf16, WS_Y0, (size_t)MH * D) WSH(DATT, bf16, WS_V, (size_t)MH * D) WSH(Y1, bf16, WS_QO, (size_t)MH * D) WSH(H3B, bf16, WS_K, (size_t)MH * D)
    __device__ __forceinline__ const float* X() const { return kin<I_X>() + (size_t)half * MH * D; }
#undef WSH
#undef WSP
};

__device__ __forceinline__ float wave_sum(float v) {
#pragma unroll
    for (int o = 1; o < 64; o <<= 1) v += __shfl_xor(v, o);
    return v;
}
template <int N> __device__ __forceinline__ void halve(float (&v)[80], int mask, int lane) {
    const bool hi = (lane & mask) != 0;
#pragma unroll
    for (int k = 0; k < N / 2; ++k) { const float keep = hi ? v[2 * k + 1] : v[2 * k], send = hi ? v[2 * k] : v[2 * k + 1]; v[k] = keep + __shfl_xor(send, mask); }
}

struct ConvItem { const float* W; bf16* WT; const float* ks; const float* ns; int K, N, item; };
struct ConvLoads { float wv[32]; f32x4 ks0, ks1; float nsv; };
__device__ __forceinline__ void conv_issue(const ConvItem& c, int lane, ConvLoads& L) {
    const int nblk = c.N / 32, kb = c.item / nblk, nb = c.item % nblk, k0 = 64 * kb, n0 = 32 * nb;
    const float* wp = c.W + (size_t)(k0 + (lane >> 5)) * c.N + n0 + (lane & 31);
#pragma unroll
    for (int i = 0; i < 32; ++i) L.wv[i] = wp[(size_t)(2 * i) * c.N];
    L.nsv = c.ns ? c.ns[n0 + (lane & 31)] : 1.0f;
    const int ch = lane & 7;
    if (c.ks) { L.ks0 = *(const f32x4*)(c.ks + k0 + 8 * ch); L.ks1 = *(const f32x4*)(c.ks + k0 + 8 * ch + 4); } else { L.ks0 = (f32x4){1.f, 1.f, 1.f, 1.f}; L.ks1 = L.ks0; }
}
__device__ __forceinline__ void conv_finish(const ConvItem& c, int lane, const ConvLoads& L, LAS float* scr) {
    const int nblk = c.N / 32, kb = c.item / nblk, nb = c.item % nblk, k0 = 64 * kb, n0 = 32 * nb;
#pragma unroll
    for (int i = 0; i < 32; ++i) scr[(2 * i + (lane >> 5)) * 33 + (lane & 31)] = L.wv[i] * L.nsv;
    LDS_WAIT(); asm volatile("" ::: "memory");
    const int ch = lane & 7;
#pragma unroll
    for (int j = 0; j < 4; ++j) { const int n = (lane >> 3) + 8 * j; const LAS float* s = scr + (8 * ch) * 33 + n;
        v4u o; o.x = pg8::cvt_pk_bf16(s[0 * 33] * L.ks0.x, s[1 * 33] * L.ks0.y); o.y = pg8::cvt_pk_bf16(s[2 * 33] * L.ks0.z, s[3 * 33] * L.ks0.w);
        o.z = pg8::cvt_pk_bf16(s[4 * 33] * L.ks1.x, s[5 * 33] * L.ks1.y); o.w = pg8::cvt_pk_bf16(s[6 * 33] * L.ks1.z, s[7 * 33] * L.ks1.w);
        *(v4u*)(c.WT + (size_t)(n0 + n) * c.K + k0 + 8 * ch) = o; }
    LDS_WAIT(); asm volatile("" ::: "memory");
}
template <int W> __device__ __forceinline__ void pool_walk(const float* xb, int t0, int tbeg, const LAS float* invs, bf16* outp) {
    f32x4 ring[16], cur[16], nxt[16];
#pragma unroll
    for (int u = 0; u < 16; ++u) { ring[u] = (f32x4){0.f, 0.f, 0.f, 0.f}; const int t = t0 + tbeg - 16 + u; cur[u] = *(const f32x4*)(xb + (size_t)(t < 0 ? 0 : t) * D); }
    for (int base = -16; base < 64; base += 16) {
        if (base + 16 < 64) {
#pragma unroll
            for (int u = 0; u < 16; ++u) nxt[u] = *(const f32x4*)(xb + (size_t)(t0 + tbeg + base + 16 + u) * D); }
#pragma unroll
        for (int u = 0; u < 16; ++u) {
            const int tt = tbeg + base + u, t = t0 + tt;
            const f32x4 v = cur[u] * invs[tt + 16];
            ring[u] = v;
            if (base >= 0) {
                f32x4 s = v;
#pragma unroll
                for (int j = 1; j < W; ++j) s += ring[(u - j) & 15];
                const float rc = 1.0f / (float)((t + 1 < W) ? (t + 1) : W);
                const f32x4 d = s * rc - v;
                *(unsigned long long*)(outp + (size_t)t * D) = (unsigned long long)pg8::cvt_pk_bf16(d.x, d.y) | ((unsigned long long)pg8::cvt_pk_bf16(d.z, d.w) << 32);
            }
        }
#pragma unroll
        for (int u = 0; u < 16; ++u) cur[u] = nxt[u];
    }
}
__device__ __forceinline__ void p0_pool_diff(Frame& F) {
    LAS float* invs = (LAS float*)(F.lds + RING_OFF);
    for (int blk = F.vcu; blk < NBLK; blk += F.G) {
        const int b = blk >> 6, t0 = (blk & 63) * 128;
        const float* xb = F.X() + (size_t)b * T * D;
        for (int kb = 0; kb < 18; kb += 6) {
            f32x4 v[6][4];
#pragma unroll
            for (int q = 0; q < 6; ++q) { const int t = t0 - 16 + F.wave + 8 * (kb + q); const f32x4* xr = (const f32x4*)(xb + (size_t)(t < 0 ? 0 : t) * D) + F.lane;
#pragma unroll
                for (int j = 0; j < 4; ++j) v[q][j] = xr[64 * j]; }
#pragma unroll
            for (int q = 0; q < 6; ++q) { const int tt = -16 + F.wave + 8 * (kb + q); float s = 0.f;
#pragma unroll
                for (int j = 0; j < 4; ++j) s += (v[q][j].x * v[q][j].x + v[q][j].y * v[q][j].y) + (v[q][j].z * v[q][j].z + v[q][j].w * v[q][j].w);
                const float inv = (t0 + tt >= 0) ? 1.0f / sqrtf(wave_sum(s) * (1.0f / D) + RMS_EPS) : 0.f;
                if (F.lane == 0) invs[tt + 16] = inv; }
        }
        __syncthreads();
        const int tq = F.tid & 255, tbeg = (F.tid >> 8) * 64;
        const float* xt = xb + 4 * tq; bf16* op = F.XN() + (size_t)b * T * D + 4 * tq;
        const int grp = F.wave & 3;
        if (grp == 0) pool_walk<2>(xt, t0, tbeg, invs, op); else if (grp == 1) pool_walk<4>(xt, t0, tbeg, invs, op); else if (grp == 2) pool_walk<8>(xt, t0, tbeg, invs, op); else pool_walk<16>(xt, t0, tbeg, invs, op);
        __syncthreads();
    }
}
constexpr int CONV_EARLY = 4224, CONV_ALL = 14464;
__device__ __forceinline__ ConvItem conv_decode(Frame& F, int it) {
    ConvItem c; int r = it;
    if (r < 128) { const int g = r >> 5; c = ConvItem{kin<I_POOLW>() + g * 65536, F.WPOOL() + g * 65536, kin<I_MIXN>() + g * 256, kin<I_POOLS>() + g * 256, 256, 256, r & 31}; return c; } r -= 128;
    if (r < 4096) { const int up = r >> 11, mat = (r >> 7) & 15;
        c = ConvItem{(up ? kin<I_WUP>() : kin<I_WGATE>()) + (size_t)mat * 262144, (up ? F.WU() : F.WG()) + (size_t)mat * 262144, kin<I_FFNN>(), nullptr, D, DEXP, r & 127}; return c; } r -= 4096;
    if (r < 2048) { const int mat = r >> 7; c = ConvItem{kin<I_WDOWN>() + (size_t)mat * 262144, F.WD() + (size_t)mat * 262144, nullptr, nullptr, DEXP, D, r & 127}; return c; } r -= 2048;
    if (r < 2048) { const int mt = r >> 9;
        const float* W = mt == 0 ? kin<I_WQ>() : mt == 1 ? kin<I_WK>() : mt == 2 ? kin<I_WV>() : kin<I_WO>(); bf16* WT = mt < 3 ? F.WQKV() + (size_t)mt * D * D : F.WO();
        const float* ks = mt == 0 ? kin<I_MIXN>() + D : (mt < 3 ? kin<I_KVN>() : nullptr);
        c = ConvItem{W, WT, ks, nullptr, D, D, r & 511}; return c; } r -= 2048;
    if (r < 4096) { const int up = r >> 11, mat = 16 + ((r >> 7) & 15);
        c = ConvItem{(up ? kin<I_WUP>() : kin<I_WGATE>()) + (size_t)mat * 262144, (up ? F.WU() : F.WG()) + (size_t)mat * 262144, kin<I_FFNN>() + D, nullptr, D, DEXP, r & 127}; return c; } r -= 4096;
    { const int mat = 16 + (r >> 7); c = ConvItem{kin<I_WDOWN>() + (size_t)mat * 262144, F.WD() + (size_t)mat * 262144, nullptr, nullptr, DEXP, D, r & 127}; return c; }
}
__device__ __forceinline__ void p0_convert(Frame& F, int it0, int it1, int gw, int ngw) {
    LAS float* scr = (LAS float*)(F.lds + RING_OFF + 4096 + F.wave * 12288);
    int it = it0 + gw; if (it >= it1) return;
    ConvItem c = conv_decode(F, it); ConvLoads L; conv_issue(c, F.lane, L);
    for (;;) {
        const int itn = it + ngw; const bool more = itn < it1;
        ConvItem cn = c; ConvLoads Ln;
        if (more) { cn = conv_decode(F, itn); conv_issue(cn, F.lane, Ln); }
        conv_finish(c, F.lane, L, scr);
        if (!more) break;
        c = cn; L = Ln; it = itn;
    }
}
__device__ __forceinline__ void p0_small(Frame& F, int gt, int NT) {
    const float* rg = kin<I_RG>(); const float* re = kin<I_RE>(); const float* ffnn = kin<I_FFNN>(); const float* kvn = kin<I_KVN>(); const float* wf = kin<I_WF>();
    float* RWG = F.RWG(); float* WFG = F.WFG();
    for (int i = gt; i < 2 * 20 * D; i += NT) { const int l = i / (20 * D), rem = i % (20 * D), col = rem / D, c = rem % D;
        const float w = col < 4 ? rg[(size_t)(l * D + c) * 4 + col] : re[(size_t)(l * D + c) * 16 + (col - 4)]; RWG[i] = ffnn[l * D + c] * w; }
    for (int i = gt; i < 16 * D; i += NT) { const int h = i / D, c = i % D; WFG[i] = kvn[c] * wf[c * 16 + h]; }
}

struct RowSrc { const float* base; const bf16* d1; const bf16* d2; const bf16* d3; bf16* hwb; };
__device__ __forceinline__ f32x4 bf4_to_f32(unsigned long long w) { const unsigned lo = (unsigned)w, hi = (unsigned)(w >> 32);
    return (f32x4){__uint_as_float(lo << 16), __uint_as_float(lo & 0xffff0000u), __uint_as_float(hi << 16), __uint_as_float(hi & 0xffff0000u)}; }
__device__ __forceinline__ void row_load(const RowSrc& S, size_t row, int lane, f32x4 (&v)[4]) {
    if (S.base) { const f32x4* xr = (const f32x4*)(S.base + row * D) + lane;
#pragma unroll
        for (int j = 0; j < 4; ++j) v[j] = xr[64 * j]; }
    else {
#pragma unroll
        for (int j = 0; j < 4; ++j) v[j] = (f32x4){0.f, 0.f, 0.f, 0.f}; }
    if (S.d1) { const unsigned long long* dr = (const unsigned long long*)(S.d1 + row * D) + lane;
#pragma unroll
        for (int j = 0; j < 4; ++j) v[j] += bf4_to_f32(dr[64 * j]); }
    if (S.d2) { const unsigned long long* dr = (const unsigned long long*)(S.d2 + row * D) + lane;
#pragma unroll
        for (int j = 0; j < 4; ++j) v[j] += bf4_to_f32(dr[64 * j]); }
    if (S.d3) { const unsigned long long* dr = (const unsigned long long*)(S.d3 + row * D) + lane;
#pragma unroll
        for (int j = 0; j < 4; ++j) v[j] += bf4_to_f32(dr[64 * j]); }
    if (S.hwb) { unsigned long long* hr = (unsigned long long*)(S.hwb + row * D) + lane;
#pragma unroll
        for (int j = 0; j < 4; ++j) hr[64 * j] = (unsigned long long)pg8::cvt_pk_bf16(v[j].x, v[j].y) | ((unsigned long long)pg8::cvt_pk_bf16(v[j].z, v[j].w) << 32); }
}
__device__ __forceinline__ void rows4_load_norm(Frame& F, const RowSrc& S, int row0, f32x4 (&xv)[4][4], float (&inv)[4]) {
#pragma unroll
    for (int r = 0; r < 4; ++r) row_load(S, (size_t)(row0 + r), F.lane, xv[r]);
#pragma unroll
    for (int r = 0; r < 4; ++r) { float s = 0.f;
#pragma unroll
        for (int j = 0; j < 4; ++j) s += (xv[r][j].x * xv[r][j].x + xv[r][j].y * xv[r][j].y) + (xv[r][j].z * xv[r][j].z + xv[r][j].w * xv[r][j].w);
        inv[r] = 1.0f / sqrtf(wave_sum(s) * (1.0f / D) + RMS_EPS); }
#pragma unroll
    for (int r = 0; r < 4; ++r) { unsigned long long* o8 = (unsigned long long*)(F.XN() + (size_t)(row0 + r) * D) + F.lane;
#pragma unroll
        for (int j = 0; j < 4; ++j) o8[64 * j] = (unsigned long long)pg8::cvt_pk_bf16(xv[r][j].x * inv[r], xv[r][j].y * inv[r]) | ((unsigned long long)pg8::cvt_pk_bf16(xv[r][j].z * inv[r], xv[r][j].w * inv[r]) << 32); }
}
template <int NCOL> __device__ __forceinline__ void rows4_dots(const LAS float* Wl, int lane, const f32x4 (&xv)[4][4], float (&acc)[80]) {
#pragma unroll
    for (int j = 0; j < 4; ++j)
#pragma unroll
        for (int col = 0; col < NCOL; ++col) { const f32x4 w = ((const LAS f32x4*)(Wl + col * D))[lane + 64 * j];
#pragma unroll
            for (int r = 0; r < 4; ++r) { float a = acc[4 * col + r]; a = __builtin_fmaf(xv[r][j].x, w.x, a); a = __builtin_fmaf(xv[r][j].y, w.y, a); a = __builtin_fmaf(xv[r][j].z, w.z, a); a = __builtin_fmaf(xv[r][j].w, w.w, a); acc[4 * col + r] = a; }
            if ((col & 3) == 3) __builtin_amdgcn_sched_barrier(0); }
}
__device__ __forceinline__ void row_router_phase(Frame& F, int l, const RowSrc& RS, unsigned* cnt) {
    LAS float* Wl = (LAS float*)(F.lds + RING_OFF);
    LAS float* sc = (LAS float*)(F.lds + RING_OFF + 81920);
    LAS int* hl = (LAS int*)(F.lds + RING_OFF + 81920 + 4096);
    LAS int* tb = hl + 64;
    LAS float* tg = (LAS float*)(tb + 128);
    { const f32x4* rw = (const f32x4*)(F.RWG() + (size_t)l * 20 * D) + F.tid; f32x4 t[10];
#pragma unroll
      for (int i = 0; i < 10; ++i) t[i] = rw[i * NWAVES * 64];
#pragma unroll
      for (int i = 0; i < 10; ++i) ((LAS f32x4*)Wl)[F.tid + i * NWAVES * 64] = t[i]; }
    const float* gb = kin<I_RGB>() + l * 4; const float* eb = kin<I_REB>() + l * 16;
    for (int blk = F.vcu; blk < NBLK; blk += F.G) {
        if (F.tid < 32) hl[F.tid] = 0;
        __syncthreads();
        for (int pass = 0; pass < 4; ++pass) {
            asm volatile("" ::: "memory");
            const int row0 = blk * 128 + F.wave * 16 + pass * 4;
            f32x4 xv[4][4]; float inv[4];
            rows4_load_norm(F, RS, row0, xv, inv);
            LAS float* sw = sc + F.wave * 80;
            float acc[80];
#pragma unroll
            for (int i = 0; i < 16; ++i) acc[i] = 0.f;
            rows4_dots<4>(Wl, F.lane, xv, acc);
            halve<16>(acc, 1, F.lane); halve<8>(acc, 2, F.lane); halve<4>(acc, 4, F.lane); halve<2>(acc, 8, F.lane);
            acc[0] += __shfl_xor(acc[0], 16); acc[0] += __shfl_xor(acc[0], 32);
            { const int p = F.lane & 15, r = p & 3, c = p >> 2; const float iv = r == 0 ? inv[0] : r == 1 ? inv[1] : r == 2 ? inv[2] : inv[3];
              if (F.lane < 16) sw[r * 8 + c] = acc[0] * iv + gb[c]; }
            LDS_WAIT(); asm volatile("" ::: "memory");
            int gsel[4];
#pragma unroll
            for (int r = 0; r < 4; ++r) { const f32x4 g = *(const LAS f32x4*)(sw + r * 8); int gi = 0; float gm = g.x; if (g.y > gm) { gm = g.y; gi = 1; } if (g.z > gm) { gm = g.z; gi = 2; } if (g.w > gm) { gm = g.w; gi = 3; }
                gsel[r] = __builtin_amdgcn_readfirstlane(gi); }
#pragma unroll
            for (int i = 0; i < 16; ++i) acc[i] = 0.f;
#pragma unroll
            for (int j = 0; j < 4; ++j)
#pragma unroll
                for (int r = 0; r < 4; ++r) {
#pragma unroll
                    for (int c = 0; c < 4; ++c) { const f32x4 w = ((const LAS f32x4*)(Wl + (4 + 4 * gsel[r] + c) * D))[F.lane + 64 * j];
                        float a = acc[4 * c + r]; a = __builtin_fmaf(xv[r][j].x, w.x, a); a = __builtin_fmaf(xv[r][j].y, w.y, a); a = __builtin_fmaf(xv[r][j].z, w.z, a); a = __builtin_fmaf(xv[r][j].w, w.w, a); acc[4 * c + r] = a; }
                    __builtin_amdgcn_sched_barrier(0); }
            halve<16>(acc, 1, F.lane); halve<8>(acc, 2, F.lane); halve<4>(acc, 4, F.lane); halve<2>(acc, 8, F.lane);
            acc[0] += __shfl_xor(acc[0], 16); acc[0] += __shfl_xor(acc[0], 32);
            if (F.lane < 16) sw[(F.lane & 3) * 8 + 4 + (F.lane >> 2)] = acc[0];
            LDS_WAIT(); asm volatile("" ::: "memory");
            if (F.lane < 4) {
                const int r = F.lane; const LAS float* sr = sw + r * 8;
                const float iv = r == 0 ? inv[0] : r == 1 ? inv[1] : r == 2 ? inv[2] : inv[3];
                const float g0 = sr[0], g1 = sr[1], g2 = sr[2], g3 = sr[3];
                int gi = 0; float gm = g0; if (g1 > gm) { gm = g1; gi = 1; } if (g2 > gm) { gm = g2; gi = 2; } if (g3 > gm) { gm = g3; gi = 3; }
                const float gwt = 1.0f / (expf(g0 - gm) + expf(g1 - gm) + expf(g2 - gm) + expf(g3 - gm));
                const LAS float* se = sr + 4; const float* ebg = eb + gi * 4;
                const float e0 = se[0] * iv + ebg[0], e1 = se[1] * iv + ebg[1], e2 = se[2] * iv + ebg[2], e3 = se[3] * iv + ebg[3];
                int i1 = 0; float v1 = e0; if (e1 > v1) { v1 = e1; i1 = 1; } if (e2 > v1) { v1 = e2; i1 = 2; } if (e3 > v1) { v1 = e3; i1 = 3; }
                int i2 = -1; float v2 = -INFINITY;
                if (i1 != 0 && e0 > v2) { v2 = e0; i2 = 0; } if (i1 != 1 && e1 > v2) { v2 = e1; i2 = 1; } if (i1 != 2 && e2 > v2) { v2 = e2; i2 = 2; } if (i1 != 3 && e3 > v2) { v2 = e3; i2 = 3; }
                const float p1 = 1.0f / (1.0f + expf(v2 - v1)), p2 = 1.0f - p1;
                const int lo = i1 < i2 ? i1 : i2, hi = i1 < i2 ? i2 : i1;
                const float wlo = (i1 < i2 ? p1 : p2) * gwt, whi = (i1 < i2 ? p2 : p1) * gwt;
                const int pidx = lo == 0 ? hi - 1 : (lo == 1 ? hi + 1 : 5);
                const int bucket = gi * 6 + pidx, tok = row0 + r;
                const int rank = __hip_atomic_fetch_add(hl + bucket, 1, __ATOMIC_RELAXED, __HIP_MEMORY_SCOPE_WORKGROUP);
                const int ti = tok - blk * 128; tb[ti] = bucket | (rank << 8); tg[2 * ti] = wlo; tg[2 * ti + 1] = whi;
            }
        }
        __syncthreads();
        if (F.tid < NBUCKET) { const int n = hl[F.tid]; hl[32 + F.tid] = n ? (int)__hip_atomic_fetch_add(cnt + F.tid, (unsigned)n, RLX_AGENT) : 0; }
        __syncthreads();
        if (F.tid < 128) { const int v = tb[F.tid], b = v & 0xff, pos = b * BCAP + hl[32 + b] + (v >> 8);
            F.TOKROW()[pos] = blk * 128 + F.tid; *(f32x2*)(F.GATEROW() + 2 * (size_t)pos) = (f32x2){tg[2 * F.tid], tg[2 * F.tid + 1]}; }
        __syncthreads();
    }
}
__device__ __forceinline__ void row_forget_phase(Frame& F, const RowSrc& RS) {
    LAS float* Wl = (LAS float*)(F.lds + RING_OFF);
    LAS float* wsum = (LAS float*)(F.lds + RING_OFF + 81920);
    { const f32x4* rw = (const f32x4*)F.WFG() + F.tid; f32x4 t[8];
#pragma unroll
      for (int i = 0; i < 8; ++i) t[i] = rw[i * NWAVES * 64];
#pragma unroll
      for (int i = 0; i < 8; ++i) ((LAS f32x4*)Wl)[F.tid + i * NWAVES * 64] = t[i]; }
    __syncthreads();
    const int h = F.lane >> 2, r = F.lane & 3; const float bfh = kin<I_BF>()[h];
    for (int blk = F.vcu; blk < NBLK; blk += F.G) {
        float bsum = 0.f;
        for (int pass = 0; pass < 4; ++pass) {
            asm volatile("" ::: "memory");
            const int row0 = blk * 128 + F.wave * 16 + pass * 4;
            f32x4 xv[4][4]; float inv[4];
            rows4_load_norm(F, RS, row0, xv, inv);
            float acc[80];
#pragma unroll
            for (int i = 0; i < 80; ++i) acc[i] = 0.f;
            rows4_dots<16>(Wl, F.lane, xv, acc);
            halve<64>(acc, 1, F.lane); halve<32>(acc, 2, F.lane); halve<16>(acc, 4, F.lane); halve<8>(acc, 8, F.lane); halve<4>(acc, 16, F.lane); halve<2>(acc, 32, F.lane);
            const float iv = r == 0 ? inv[0] : r == 1 ? inv[1] : r == 2 ? inv[2] : inv[3];
            const float z = acc[0] * iv + bfh;
            const float lf = fminf(z, 0.f) - log1pf(expf(-fabsf(z)));
            F.LF()[(size_t)(row0 + r) * 16 + h] = lf; bsum += lf;
        }
        bsum += __shfl_xor(bsum, 1); bsum += __shfl_xor(bsum, 2);
        if (r == 0) wsum[F.wave * 16 + h] = bsum;
        __syncthreads();
        if (F.tid < 16) { float s = 0.f;
#pragma unroll
            for (int w = 0; w < NWAVES; ++w) s += wsum[w * 16 + F.tid];
            F.BLKSUM()[blk * 16 + F.tid] = s; }
        __syncthreads();
    }
}
__device__ __forceinline__ void final_norm_phase(Frame& F, const RowSrc& RS, float* dst) {
    const int gw = F.vcu * NWAVES + F.wave, NGW = F.G * NWAVES;
    f32x4 g[4];
#pragma unroll
    for (int j = 0; j < 4; ++j) g[j] = ((const f32x4*)kin<I_FINN>())[F.lane + 64 * j];
    for (int m0 = gw * 4; m0 < MH; m0 += NGW * 4) {
        f32x4 v[4][4]; float inv[4];
#pragma unroll
        for (int r = 0; r < 4; ++r) row_load(RS, (size_t)(m0 + r), F.lane, v[r]);
#pragma unroll
        for (int r = 0; r < 4; ++r) { float s = 0.f;
#pragma unroll
            for (int j = 0; j < 4; ++j) s += (v[r][j].x * v[r][j].x + v[r][j].y * v[r][j].y) + (v[r][j].z * v[r][j].z + v[r][j].w * v[r][j].w);
            inv[r] = 1.0f / sqrtf(wave_sum(s) * (1.0f / D) + RMS_EPS); }
#pragma unroll
        for (int r = 0; r < 4; ++r)
#pragma unroll
            for (int j = 0; j < 4; ++j) ((f32x4*)(dst + (size_t)(m0 + r) * D) + F.lane)[64 * j] = v[r][j] * inv[r] * g[j];
    }
}
__device__ __forceinline__ void build_tile_table(Frame& F, const unsigned* cnt) {
    LAS int* tbl = (LAS int*)(F.lds + TBL_OFF);
    LAS int* cn = (LAS int*)(F.lds + RING_OFF);
    if (F.tid < NBUCKET) cn[F.tid] = (int)__hip_atomic_load(cnt + F.tid, RLX_AGENT);
    __syncthreads();
    if (F.tid == 0) { int ntl = 0; for (int b = 0; b < NBUCKET; ++b) { cn[32 + b] = ntl; ntl += (cn[b] + 255) >> 8; } tbl[0] = ntl < MAXTILES ? ntl : MAXTILES; }
    __syncthreads();
    if (F.tid < NBUCKET) { const int b = F.tid, g = b / 6, p = b % 6, lo = p < 3 ? 0 : (p < 5 ? 1 : 2), hi = p < 3 ? p + 1 : (p < 5 ? p - 1 : 3), n = cn[b]; int t = cn[32 + b];
        for (int k = 0; k * 256 < n && t < MAXTILES; ++k, ++t) { tbl[1 + 3 * t] = (g * 4 + lo) | ((g * 4 + hi) << 8); tbl[2 + 3 * t] = (n - 256 * k) < 256 ? (n - 256 * k) : 256; tbl[3 + 3 * t] = b * BCAP + 256 * k; } }
    __syncthreads();
}
__device__ __forceinline__ void fscan_phase(Frame& F) {
    LAS float* bs = (LAS float*)(F.lds + RING_OFF);
    LAS float* sg = bs + 16;
    for (int blk = F.vcu; blk < NBLK; blk += F.G) {
        const int b = blk >> 6, first = b * 64, tid = F.tid;
        { LAS float* ps = sg + 128;
          for (int i = tid; i < 64 * 16; i += NWAVES * 64) { const int j = first + (i >> 4); ps[i] = j < blk ? F.BLKSUM()[j * 16 + (i & 15)] : 0.f; }
          __syncthreads();
          if (tid < 16) { float s = 0.f; for (int j = 0; j < 64; ++j) s += ps[j * 16 + tid]; bs[tid] = s; } }
        const int h = tid & 15, seg = tid >> 4;
        float v[16];
        if (tid < 128) { float s = 0.f;
#pragma unroll
            for (int k = 0; k < 16; ++k) { v[k] = F.LF()[(size_t)(blk * 128 + seg * 16 + k) * 16 + h]; s += v[k]; }
            sg[seg * 16 + h] = s; }
        __syncthreads();
        if (tid < 128) { float run = bs[h]; for (int s2 = 0; s2 < seg; ++s2) run += sg[s2 * 16 + h];
            float* fo = F.FM() + (size_t)(b * 16 + h) * T + (blk & 63) * 128 + seg * 16;
#pragma unroll
            for (int k = 0; k < 16; ++k) { run += v[k]; fo[k] = run; } }
        __syncthreads();
    }
}
struct Args { const float* in[20]; float* out; unsigned char* ws; };
__global__ void __launch_bounds__(NWAVES * 64, 2) yoco_fwd(Args args) {
    extern __shared__ __attribute__((aligned(16))) unsigned char lds[];
    Frame F;
    F.lds = (LAS unsigned char*)lds;
    F.MISC = (volatile LAS unsigned*)(F.lds + MISC_OFF);
    F.tid = threadIdx.x; F.lane = F.tid & 63; F.wave = __builtin_amdgcn_readfirstlane(F.tid >> 6);
    const int GA = gridDim.x, bx = blockIdx.x, li = bx >> 1;
    F.half = bx & 1; F.G = GA >> 1; F.vcu = (F.G % 4 == 0) ? (li % 4) * (F.G / 4) + li / 4 : li;
    unsigned char* ws = args.ws;
    F.ws = ws; F.out = args.out + (size_t)F.half * MH * D;
    gu32* const ctl = (gu32*)(ws + WS_CTL);
    { int t0 = threadIdx.x; asm volatile("" : "+v"(t0));
      for (int u = t0; u < (LDS_BYTES - LDSCTL_OFF) / 4; u += NWAVES * 64) ((LAS unsigned*)(F.lds + LDSCTL_OFF))[u] = 0u; }
    __syncthreads();
    const XcdBarrier barAll = xcd_barrier_post((unsigned*)(ctl + CW_BAR), F.MISC + 8, (unsigned)GA);
    const XcdBarrier bar = xcd_barrier_post((unsigned*)(ctl + CW_BARH) + F.half * XCD_BAR_WORDS, F.MISC + 12, (unsigned)F.G);
    unsigned* const cnt0 = (unsigned*)(ctl + CW_CNT + 64 * (2 * F.half)); unsigned* const cnt1 = cnt0 + 64;
    unsigned* const nq = (unsigned*)(ctl + CW_NRM) + F.half * 2048; unsigned* const nk = (unsigned*)(ctl + CW_NRM) + 4096 + F.half * 64;

#ifndef PH_MASK
#define PH_MASK 0x7fff
#endif
#define IN(k) ((PH_MASK >> (k)) & 1)
#define RETID() Frame Fq = F; { int t_ = threadIdx.x; asm volatile("" : "+v"(t_)); Fq.tid = t_; Fq.lane = t_ & 63; }
#define SEAM(k) do { xcd_barrier(bar); } while (0)
    PG8_LAS unsigned char* ring = F.lds + RING_OFF;

    if (IN(0)) { RETID();
        p0_convert(Fq, 0, CONV_EARLY, bx * NWAVES + Fq.wave, GA * NWAVES);
        p0_small(Fq, bx * (NWAVES * 64) + Fq.tid, GA * NWAVES * 64);
        xcd_barrier(barAll);
        if (Fq.half == 1) {
            p0_convert(Fq, CONV_EARLY, CONV_ALL, li * NWAVES + Fq.wave, Fq.G * NWAVES);
            asm volatile("s_waitcnt vmcnt(0)" ::: "memory"); __syncthreads();
            if (Fq.tid == 0) { __builtin_amdgcn_fence(__ATOMIC_RELEASE, "agent"); asm volatile("s_waitcnt vmcnt(0)" ::: "memory"); __hip_atomic_fetch_add((unsigned*)(ctl + CW_CONV), 1u, RLX_AGENT); }
        }
        p0_pool_diff(Fq);
#ifdef SKEW_TICKS
        if (Fq.half == 1) { const unsigned long long t0_ = __builtin_amdgcn_s_memrealtime(); while (__builtin_amdgcn_s_memrealtime() - t0_ < SKEW_TICKS) __builtin_amdgcn_s_sleep(10); }
#endif
    } SEAM(0);

    if (IN(1)) { RETID();
        pg8::StaticOrder S; S.init(MH, D, Fq.G, li, 4);
        pg8::AdRow ad{(const char*)Fq.XN(), (const char*)Fq.WPOOL(), D, 256, 256};
        pg8::EpiBf16 E{Fq.DPOOL(), D, 0, 0, 1.f, nullptr, nullptr};
        pg8::gemm_phase<pg8::EpiBf16, pg8::StaticOrder, pg8::AdRow, true>(ring, 4, S, E, ad);
    } SEAM(1);

    if (IN(2)) { RETID(); const RowSrc RS{Fq.X(), Fq.DPOOL(), nullptr, nullptr, nullptr}; row_router_phase(Fq, 0, RS, cnt0); } SEAM(2);
    if (IN(4)) { RETID();
        build_tile_table(Fq, cnt0);
        pg8::MoeOrder S{(const PG8_LAS int*)(Fq.lds + TBL_OFF), Fq.G, Fq.vcu};
        pg8::AdMoeUp ad{(const char*)Fq.XN(), Fq.TOKROW(), (const char*)Fq.WG(), (const char*)Fq.WU(), D, D};
        pg8::EpiMoeH E{Fq.HMID(), Fq.GATEROW()};
        pg8::gemm_phase<pg8::EpiMoeH, pg8::MoeOrder, pg8::AdMoeUp, true>(ring, 16, S, E, ad);
    } SEAM(4);
    if (F.half == 0) {
        if (F.tid == 0) { unsigned sp = 0; while (__hip_atomic_load((unsigned*)(ctl + CW_CONV), RLX_AGENT) < (unsigned)F.G) { __builtin_amdgcn_s_sleep(2); if (++sp > (1u << 22)) break; }
            __builtin_amdgcn_fence(__ATOMIC_ACQUIRE, "agent"); asm volatile("s_waitcnt vmcnt(0)" ::: "memory"); }
        __syncthreads();
    }
    if (IN(5)) { RETID();
        build_tile_table(Fq, cnt0);
        pg8::MoeOrder S{(const PG8_LAS int*)(Fq.lds + TBL_OFF), Fq.G, Fq.vcu};
        pg8::AdMoeDown ad{(const char*)Fq.HMID(), (const char*)Fq.WD(), 512, 256};
        pg8::EpiMoeOutBf16 E{Fq.Y0(), Fq.TOKROW(), Fq.TRASH()};
        pg8::gemm_phase<pg8::EpiMoeOutBf16, pg8::MoeOrder, pg8::AdMoeDown, true>(ring, 8, S, E, ad);
    } SEAM(5);

    if (IN(6)) { RETID(); const RowSrc RS{Fq.X(), Fq.DPOOL(), Fq.Y0(), nullptr, nullptr}; row_forget_phase(Fq, RS); } SEAM(6);
    if (IN(7)) { RETID();
        fscan_phase(Fq);
        pg8::StaticOrder S; S.init(MH, NQKV, Fq.G, li, 4);
        pg8::AdRow ad{(const char*)Fq.XN(), (const char*)Fq.WQKV(), D, D, 0};
        pg8::EpiBf16 E{Fq.QO(), D, D, (size_t)(WS_K - WS_QO) / 2, attn_body::C2, nq, nk};
        pg8::gemm_phase<pg8::EpiBf16, pg8::StaticOrder, pg8::AdRow, true>(ring, 16, S, E, ad);
    } SEAM(7);

    if (IN(8)) { RETID();
        static_assert(attn_body::ATTN_LDS_BYTES <= RING_BYTES && attn_body::ATTN_PITCH == D && attn_body::BATCH == BH, "attention body geometry vs frame");
        const attn_body::AttnTensors AT{(const attn_body::bf16*)Fq.QO(), (const attn_body::bf16*)Fq.KB(), (const attn_body::bf16*)Fq.VB(), (attn_body::bf16*)Fq.XN(), Fq.FM(), nq, nk};
        attn_body::attn_phase<>((char*)lds + RING_OFF, AT, (unsigned*)(ctl + CW_ATQ + 64 * Fq.half));
    } SEAM(8);

    if (IN(9)) { RETID();
        pg8::StaticOrder S; S.init(MH, D, Fq.G, li, 4);
        pg8::AdRow ad{(const char*)Fq.XN(), (const char*)Fq.WO(), D, D, 0};
        pg8::EpiBf16 E{Fq.DATT(), D, 0, 0, 1.f, nullptr, nullptr};
        pg8::gemm_phase<pg8::EpiBf16, pg8::StaticOrder, pg8::AdRow, true>(ring, 16, S, E, ad);
    } SEAM(9);

    if (IN(10)) { RETID(); const RowSrc RS{Fq.X(), Fq.DPOOL(), Fq.Y0(), Fq.DATT(), Fq.H3B()}; row_router_phase(Fq, 1, RS, cnt1); } SEAM(10);
    if (IN(12)) { RETID();
        build_tile_table(Fq, cnt1);
        pg8::MoeOrder S{(const PG8_LAS int*)(Fq.lds + TBL_OFF), Fq.G, Fq.vcu};
        pg8::AdMoeUp ad{(const char*)Fq.XN(), Fq.TOKROW(), (const char*)(Fq.WG() + (size_t)NEXP * DEXP * D), (const char*)(Fq.WU() + (size_t)NEXP * DEXP * D), D, D};
        pg8::EpiMoeH E{Fq.HMID(), Fq.GATEROW()};
        pg8::gemm_phase<pg8::EpiMoeH, pg8::MoeOrder, pg8::AdMoeUp, true>(ring, 16, S, E, ad);
    } SEAM(12);
    if (IN(13)) { RETID();
        build_tile_table(Fq, cnt1);
        pg8::MoeOrder S{(const PG8_LAS int*)(Fq.lds + TBL_OFF), Fq.G, Fq.vcu};
        pg8::AdMoeDown ad{(const char*)Fq.HMID(), (const char*)(Fq.WD() + (size_t)NEXP * DEXP * D), 512, 256};
        pg8::EpiMoeOutBf16 E{Fq.Y1(), Fq.TOKROW(), Fq.TRASH()};
        pg8::gemm_phase<pg8::EpiMoeOutBf16, pg8::MoeOrder, pg8::AdMoeDown, true>(ring, 8, S, E, ad);
    } SEAM(13);

    if (IN(14)) { RETID(); const RowSrc RS{nullptr, Fq.H3B(), Fq.Y1(), nullptr, nullptr}; final_norm_phase(Fq, RS, Fq.out); }
#undef IN
#undef SEAM
}

extern "C" void kernel_launch(void* const* d_in, const int* in_sizes, int n_in, void* d_out, int out_size, void* d_ws, size_t ws_size, hipStream_t stream) {
    static int grid = 0;
    if (grid == 0) {
        if (n_in != 20 || in_sizes[0] != M * D || out_size != M * D || ws_size < WS_END) { fprintf(stderr, "kernel_launch: unexpected shapes (n_in %d, in0 %d, out %d, ws %zu); nothing launched\n", n_in, n_in > 0 ? in_sizes[0] : -1, out_size, ws_size); grid = -1; return; }
        int dev = 0, cus = 0, per_cu = 0;
        if (hipGetDevice(&dev) != hipSuccess || hipDeviceGetAttribute(&cus, hipDeviceAttributeMultiprocessorCount, dev) != hipSuccess) { fprintf(stderr, "kernel_launch: hipGetDevice / hipDeviceGetAttribute failed\n"); grid = -1; return; }
        if (hipFuncSetAttribute((const void*)yoco_fwd, hipFuncAttributeMaxDynamicSharedMemorySize, LDS_BYTES) != hipSuccess) { fprintf(stderr, "kernel_launch: hipFuncSetAttribute failed\n"); grid = -1; return; }
        if (hipOccupancyMaxActiveBlocksPerMultiprocessor(&per_cu, (const void*)yoco_fwd, NWAVES * 64, LDS_BYTES) != hipSuccess || per_cu < 1)
            fprintf(stderr, "kernel_launch: note: occupancy query reports %d workgroups per CU\n", per_cu);
        (void)hipGetLastError();
        grid = cus & ~1;
    }
    if (grid < 0) return;
    if (hipMemsetAsync((char*)d_ws + WS_CTL, 0, CTL_ZERO_BYTES, stream) != hipSuccess) { fprintf(stderr, "kernel_launch: hipMemsetAsync failed\n"); return; }
    Args a{};
    for (int i = 0; i < 20; ++i) a.in[i] = (const float*)d_in[i];
    a.out = (float*)d_out; a.ws = (unsigned char*)d_ws;
    hipLaunchKernelGGL(yoco_fwd, dim3(grid), dim3(NWAVES * 64), LDS_BYTES, stream, a);
    const hipError_t le = hipPeekAtLastError();
    if (le != hipSuccess) fprintf(stderr, "kernel_launch: launch failed: %s\n", hipGetErrorName(le));
}
```

```cpp
#include <hip/hip_runtime.h>
#include <hip/hip_bf16.h>
#include <cstdio>
#include <cstdint>
#include <cmath>
namespace pg8 {
#define PG8_LAS __attribute__((address_space(3)))
typedef unsigned short bf16_t;
typedef short bf16x8 __attribute__((ext_vector_type(8)));
typedef float f32x4 __attribute__((ext_vector_type(4)));
typedef unsigned u32x4 __attribute__((ext_vector_type(4)));
constexpr int BM = 256, BK = 64, HALF = 128, HTB = HALF * BK * 2  , STAGE_BYTES = 8 * HTB, NXCD = 8, WGM = 8;

__host__ __device__ __forceinline__ int lds_byte(int r, int c) { const int st = (r >> 4) * 2 + (c >> 5), rr = r & 15, cc = c & 31, ob = rr * 64 + cc * 2; return st * 1024 + (ob ^ (((ob >> 9) & 1) << 5)); }
__host__ __device__ __forceinline__ void stage_rc(int b, int& R, int& C) { const int st = b / 1024, sb = b % 1024, swz = sb ^ (((sb >> 9) & 1) << 5); R = (st >> 1) * 16 + swz / 64; C = (st & 1) * 32 + (swz % 64) / 2; }
__host__ __device__ __forceinline__ int perm32(int rho) { const int n = rho >> 4, i = rho & 15; return 8 * (i >> 2) + 4 * n + (i & 3); }

struct Unit { int pm, pn, x0, x1, x2; };

struct StaticOrder {
    int nM, nN, nwg, G, c, nx;
    __device__ __forceinline__ void init(int M, int N, int G_, int c_, int nx_) { nM = M / BM; nN = N / BM; nwg = nM * nN; G = G_; c = c_; nx = nx_; }
    __device__ __forceinline__ bool next(int i, Unit& u) const {
        const long L = (long)i * G + c; if (L >= nwg) return false;
        int wgid = (int)L; { const int q = nwg / nx, r = nwg % nx, xcd = wgid % nx, off = wgid / nx; wgid = (xcd < r ? xcd * (q + 1) : r * (q + 1) + (xcd - r) * q) + off; }
        const int nig = WGM * nN, gid = wgid / nig, fm = gid * WGM, gsz = (nM - fm) < WGM ? (nM - fm) : WGM;
        u.pm = fm + ((wgid % nig) % gsz); u.pn = (wgid % nig) / gsz; u.x0 = 0; u.x1 = 0; u.x2 = 0; return true;
    }
};
struct MoeOrder {
    const PG8_LAS int* tbl; int G, c;
    __device__ __forceinline__ bool next(int i, Unit& u) const {
        const int L = i * G + c; const int ntl = __builtin_amdgcn_readfirstlane(tbl[0]);
        if (L >= ntl * 4) return false;
        const int rt = L >> 2; u.pm = rt; u.pn = L & 3; u.x0 = __builtin_amdgcn_readfirstlane(tbl[1 + 3 * rt]); u.x1 = __builtin_amdgcn_readfirstlane(tbl[2 + 3 * rt]); u.x2 = __builtin_amdgcn_readfirstlane(tbl[3 + 3 * rt]); return true;
    }
};

struct AdRow {
    static constexpr bool GATHER = false;
    const char* abase; const char* bbase; int lda, ldb, acolpn;
    __device__ __forceinline__ const char* a_ptr(const Unit& u, int h, int kt) const { return abase + ((size_t)(u.pm * BM + h * HALF) * lda + u.pn * acolpn) * 2 + (size_t)kt * (BK * 2); }
    __device__ __forceinline__ void a_offs(const Unit&, const int (&)[2], const int (&)[2], unsigned (&)[2][2]) const {}
    __device__ __forceinline__ const char* b_ptr(const Unit& u, int h, int kt) const { return bbase + (size_t)(u.pn * BM + h * HALF) * ldb * 2 + (size_t)kt * (BK * 2); }
};
struct AdMoeUp {
    static constexpr bool GATHER = true;
    const char* abase; const int* tokrow; const char* wg; const char* wu; int lda, ldb;
    __device__ __forceinline__ const char* a_ptr(const Unit&, int, int kt) const { return abase + (size_t)kt * (BK * 2); }
    __device__ __forceinline__ void a_offs(const Unit& u, const int (&R)[2], const int (&C)[2], unsigned (&v)[2][2]) const {
#pragma unroll
        for (int h = 0; h < 2; ++h)
#pragma unroll
            for (int i = 0; i < 2; ++i) { const int rl = h * HALF + R[i]; const int tok = rl < u.x1 ? tokrow[u.x2 + rl] : 0; v[h][i] = (unsigned)(tok * 1024 + C[i]) * 2u; }
    }
    __device__ __forceinline__ const char* b_ptr(const Unit& u, int h, int kt) const {
        const int e = (u.pn >> 1) ? ((u.x0 >> 8) & 0xff) : (u.x0 & 0xff);
        return (h ? wu : wg) + (size_t)(e * 256 + (u.pn & 1) * HALF) * 1024 * 2 + (size_t)kt * (BK * 2);
    }
};
struct AdMoeDown {
    static constexpr bool GATHER = false;
    const char* abase; const char* wd; int lda, ldb;
    __device__ __forceinline__ const char* a_ptr(const Unit& u, int h, int kt) const { return abase + (size_t)(u.pm * BM + h * HALF) * 512 * 2 + (size_t)kt * (BK * 2); }
    __device__ __forceinline__ void a_offs(const Unit&, const int (&)[2], const int (&)[2], unsigned (&)[2][2]) const {}
    __device__ __forceinline__ const char* b_ptr(const Unit& u, int h, int kt) const {
        const int e = (kt >> 2) ? ((u.x0 >> 8) & 0xff) : (u.x0 & 0xff);
        return wd + (size_t)(e * 1024 + u.pn * BM + h * HALF) * 256 * 2 + (size_t)(kt & 3) * (BK * 2);
    }
};

template <int MASK> __device__ __forceinline__ float xor_lane(float v) {
    const int x = __builtin_bit_cast(int, v); int r;
    if constexpr (MASK == 1) r = __builtin_amdgcn_mov_dpp(x, 0xB1, 0xf, 0xf, true);
    else if constexpr (MASK == 2) r = __builtin_amdgcn_mov_dpp(x, 0x4E, 0xf, 0xf, true);
    else if constexpr (MASK == 4) r = __builtin_amdgcn_mov_dpp(__builtin_amdgcn_mov_dpp(x, 0x141, 0xf, 0xf, true), 0x1B, 0xf, 0xf, true);
    else if constexpr (MASK == 8) r = __builtin_amdgcn_mov_dpp(__builtin_amdgcn_mov_dpp(x, 0x140, 0xf, 0xf, true), 0x141, 0xf, 0xf, true);
    else if constexpr (MASK == 16) { const auto q = __builtin_amdgcn_permlane16_swap((unsigned)x, (unsigned)x, false, false); r = (int)(((threadIdx.x >> 4) & 1) ? q[0] : q[1]); }
    else { const auto q = __builtin_amdgcn_permlane32_swap((unsigned)x, (unsigned)x, false, false); r = (int)(((threadIdx.x >> 5) & 1) ? q[0] : q[1]); }
    return __builtin_bit_cast(float, r);
}
__device__ __forceinline__ unsigned cvt_pk_bf16(float lo, float hi) { unsigned r; asm volatile("v_cvt_pk_bf16_f32 %0, %1, %2" : "=v"(r) : "v"(lo), "v"(hi)); return r; }

struct EpiBf16 {
    static constexpr bool PERM = true;
    bf16_t* O; int ldc; int split_cols; size_t split_stride; float scale0; unsigned* nq; unsigned* nk;
    __device__ __forceinline__ void operator()(const f32x4 (&acc)[2][2][4][2], const Unit& u, int wr, int wc, int fr, int fq) const {
        const int row0 = u.pm * BM + wr * 64 + fr; int colt = u.pn * BM; bf16_t* base = O; int t = 0;
        float sc = 1.f; if (split_cols) { t = colt / split_cols; base += (size_t)t * split_stride; colt -= t * split_cols; if (t == 0) sc = scale0; }
        const int col0 = colt + wc * 32 + 8 * fq;
#pragma unroll
        for (int ai = 0; ai < 2; ++ai)
#pragma unroll
            for (int m = 0; m < 4; ++m) { bf16_t* rowp = base + (size_t)(row0 + ai * HALF + m * 16) * ldc + col0;
#pragma unroll
                for (int bj = 0; bj < 2; ++bj) { f32x4 v0 = acc[ai][bj][m][0] * sc, v1 = acc[ai][bj][m][1] * sc;
                    u32x4 w; w.x = cvt_pk_bf16(v0[0], v0[1]); w.y = cvt_pk_bf16(v0[2], v0[3]); w.z = cvt_pk_bf16(v1[0], v1[1]); w.w = cvt_pk_bf16(v1[2], v1[3]);
                    *(u32x4*)(rowp + bj * HALF) = w; } }
        if (nq && t < 2) {
#pragma unroll
            for (int bj = 0; bj < 2; ++bj) { float mx = 0.f;
#pragma unroll
                for (int ai = 0; ai < 2; ++ai)
#pragma unroll
                    for (int m = 0; m < 4; ++m) { const f32x4 v0 = acc[ai][bj][m][0] * sc, v1 = acc[ai][bj][m][1] * sc;
                        float s = (v0[0] * v0[0] + v0[1] * v0[1]) + (v0[2] * v0[2] + v0[3] * v0[3]) + (v1[0] * v1[0] + v1[1] * v1[1]) + (v1[2] * v1[2] + v1[3] * v1[3]);
                        { const auto r_ = __builtin_amdgcn_permlane16_swap(__float_as_uint(s), __float_as_uint(s), false, false); s = __uint_as_float(r_[0]) + __uint_as_float(r_[1]); }
                        { const auto r_ = __builtin_amdgcn_permlane32_swap(__float_as_uint(s), __float_as_uint(s), false, false); s = __uint_as_float(r_[0]) + __uint_as_float(r_[1]); }
                        mx = fmaxf(mx, s); }
                mx = fmaxf(mx, xor_lane<1>(mx)); mx = fmaxf(mx, xor_lane<2>(mx)); mx = fmaxf(mx, xor_lane<4>(mx)); mx = fmaxf(mx, xor_lane<8>(mx));
                if (fr == 0 && fq == 0) { const int head = (colt >> 8) * 4 + 2 * bj + (wc >> 1), half = wc & 1;
                    unsigned* p = t == 0 ? nq + ((u.pm * 16 + head) * 2 + half) : nk + (((u.pm >> 5) * 16 + head) * 2 + half);
                    __hip_atomic_fetch_max(p, __float_as_uint(mx), __ATOMIC_RELAXED, __HIP_MEMORY_SCOPE_AGENT); } }
        }
    }
};
struct EpiResF32 {
    static constexpr bool PERM = false;
    const float* base; float* out; int ldc;
    __device__ __forceinline__ void operator()(const f32x4 (&acc)[2][2][4][2], const Unit& u, int wr, int wc, int fr, int fq) const {
        const size_t off0 = (size_t)(u.pm * BM + wr * 64 + fr) * ldc + u.pn * BM + wc * 32 + 4 * fq;
        f32x4 buf[3][4];
#define PG8_RES_LOAD(g) do { const size_t o_ = off0 + (size_t)(((g) >> 2) * HALF + ((g) & 3) * 16) * ldc; _Pragma("unroll") for (int q_ = 0; q_ < 4; ++q_) buf[(g) % 3][q_] = *(const f32x4*)(base + o_ + (q_ >> 1) * HALF + (q_ & 1) * 16); } while (0)
        PG8_RES_LOAD(0); PG8_RES_LOAD(1);
#pragma unroll
        for (int g = 0; g < 8; ++g) {
            if (g + 2 < 8) PG8_RES_LOAD(g + 2);
            const size_t o = off0 + (size_t)((g >> 2) * HALF + (g & 3) * 16) * ldc;
#pragma unroll
            for (int q = 0; q < 4; ++q) *(f32x4*)(out + o + (q >> 1) * HALF + (q & 1) * 16) = buf[g % 3][q] + acc[g >> 2][q >> 1][g & 3][q & 1];
            asm volatile("" ::: "memory");
        }
#undef PG8_RES_LOAD
    }
};
__device__ __forceinline__ float silu_mul(float g, float u) { return g * u * __builtin_amdgcn_rcpf(1.0f + __builtin_amdgcn_exp2f(-1.4426950408889634f * g)); }
struct EpiMoeH {
    static constexpr bool PERM = true;
    bf16_t* H; const float* gaterow;
    __device__ __forceinline__ void operator()(const f32x4 (&acc)[2][2][4][2], const Unit& u, int wr, int wc, int fr, int fq) const {
        const int half = u.pn >> 1, col0 = half * 256 + (u.pn & 1) * HALF + wc * 32 + 8 * fq;
#pragma unroll
        for (int ai = 0; ai < 2; ++ai)
#pragma unroll
            for (int m = 0; m < 4; ++m) { const int rl = ai * HALF + wr * 64 + m * 16 + fr, row = u.pm * BM + rl; const float gw = rl < u.x1 ? gaterow[(size_t)(u.x2 + rl) * 2 + half] : 0.f;
                const f32x4 g0 = acc[ai][0][m][0], g1 = acc[ai][0][m][1], u0 = acc[ai][1][m][0], u1 = acc[ai][1][m][1];
                u32x4 w; w.x = cvt_pk_bf16(silu_mul(g0[0], u0[0]) * gw, silu_mul(g0[1], u0[1]) * gw); w.y = cvt_pk_bf16(silu_mul(g0[2], u0[2]) * gw, silu_mul(g0[3], u0[3]) * gw);
                w.z = cvt_pk_bf16(silu_mul(g1[0], u1[0]) * gw, silu_mul(g1[1], u1[1]) * gw); w.w = cvt_pk_bf16(silu_mul(g1[2], u1[2]) * gw, silu_mul(g1[3], u1[3]) * gw);
                *(u32x4*)(H + (size_t)row * 512 + col0) = w; }
    }
};
struct EpiMoeOutBf16 {
    static constexpr bool PERM = true;
    bf16_t* Y; const int* tokrow; bf16_t* trash;
    __device__ __forceinline__ void operator()(const f32x4 (&acc)[2][2][4][2], const Unit& u, int wr, int wc, int fr, int fq) const {
        const int col0 = u.pn * BM + wc * 32 + 8 * fq, nvalid = u.x1;
#pragma unroll
        for (int ai = 0; ai < 2; ++ai)
#pragma unroll
            for (int m = 0; m < 4; ++m) { const int rl = ai * HALF + wr * 64 + m * 16 + fr; const int tok = rl < nvalid ? tokrow[u.x2 + rl] : 0;
                bf16_t* rowp = (rl < nvalid ? Y + (size_t)tok * 1024 : trash) + col0;
#pragma unroll
                for (int bj = 0; bj < 2; ++bj) { const f32x4 v0 = acc[ai][bj][m][0], v1 = acc[ai][bj][m][1];
                    u32x4 w; w.x = cvt_pk_bf16(v0[0], v0[1]); w.y = cvt_pk_bf16(v0[2], v0[3]); w.z = cvt_pk_bf16(v1[0], v1[1]); w.w = cvt_pk_bf16(v1[2], v1[3]);
                    *(u32x4*)(rowp + bj * HALF) = w; } }
    }
};

template <class Epi, class Sched, class AD, bool ALIGN_EPI>
__device__ __forceinline__ void gemm_phase(PG8_LAS unsigned char* lds, const int nt, const Sched& S, const Epi& E, const AD& ad) {
    int tid = threadIdx.x; asm volatile("" : "+v"(tid));
    const int wid = __builtin_amdgcn_readfirstlane(tid >> 6), lane = tid & 63, wr = wid >> 2, wc = wid & 3, fr = lane & 15, fq = lane >> 4;
    int Rs[2], Cs[2]; unsigned voffA[2], voffB[2];
#pragma unroll
    for (int i = 0; i < 2; ++i) { stage_rc(tid * 16 + i * 8192, Rs[i], Cs[i]); const int Rb = Epi::PERM ? ((Rs[i] & ~31) + perm32(Rs[i] & 31)) : Rs[i];
        voffA[i] = (unsigned)(Rs[i] * ad.lda + Cs[i]) * 2u; voffB[i] = (unsigned)(Rb * ad.ldb + Cs[i]) * 2u; }
    const unsigned ldsw = (unsigned)wid * 1024u;
    const int aoff = lds_byte(wr * 64 + fr, fq * 8), boff = lds_byte(wc * 32 + fr, fq * 8);
#define PG8_SA(b, h) (((b) * 2 + (h)) * HTB)
#define PG8_SB(b, h) ((4 + (b) * 2 + (h)) * HTB)
#define PG8_STAGE(bufoff, gbase, voff) do { _Pragma("unroll") for (int _i = 0; _i < 2; ++_i) \
        __builtin_amdgcn_global_load_lds((const unsigned*)((const char*)(gbase) + (voff)[_i]), (PG8_LAS unsigned*)(lds + (bufoff) + ldsw + _i * 8192), 16, 0, 0); } while (0)
#define PG8_STAGE_A(bufoff, U, h, kt, VG) do { if constexpr (AD::GATHER) PG8_STAGE(bufoff, ad.a_ptr(U, h, kt), (VG)[h]); else PG8_STAGE(bufoff, ad.a_ptr(U, h, kt), voffA); } while (0)
#define PG8_LDA(dst, b, h) do { _Pragma("unroll") for (int m = 0; m < 4; ++m) _Pragma("unroll") for (int k = 0; k < 2; ++k) dst[m][k] = *(const PG8_LAS bf16x8*)(lds + PG8_SA(b, h) + aoff + m * 2048 + k * 1024); } while (0)
#define PG8_LDB(dst, b, h) do { _Pragma("unroll") for (int n = 0; n < 2; ++n) _Pragma("unroll") for (int k = 0; k < 2; ++k) dst[n][k] = *(const PG8_LAS bf16x8*)(lds + PG8_SB(b, h) + boff + n * 2048 + k * 1024); } while (0)
#define PG8_MMA(ai, bj, At, Bt) do { __builtin_amdgcn_s_setprio(1); _Pragma("unroll") for (int m = 0; m < 4; ++m) _Pragma("unroll") for (int n = 0; n < 2; ++n) _Pragma("unroll") for (int k = 0; k < 2; ++k) \
        acc[ai][bj][m][n] = __builtin_amdgcn_mfma_f32_16x16x32_bf16(Bt[n][k], At[m][k], acc[ai][bj][m][n], 0, 0, 0); __builtin_amdgcn_s_setprio(0); } while (0)
#define PG8_WAIT_V(n) asm volatile("s_waitcnt vmcnt(" #n ")" ::: "memory")
#define PG8_WAIT_L(n) asm volatile("s_waitcnt lgkmcnt(" #n ")" ::: "memory")
#define PG8_BAR __builtin_amdgcn_s_barrier()
#define PG8_SCHED __builtin_amdgcn_sched_barrier(0)
    Unit cur, nxt; int ui = 0;
    if (!S.next(0, cur)) return;
    f32x4 acc[2][2][4][2];
#pragma unroll
    for (int a = 0; a < 2; ++a)
#pragma unroll
        for (int b = 0; b < 2; ++b)
#pragma unroll
            for (int m = 0; m < 4; ++m)
#pragma unroll
                for (int n = 0; n < 2; ++n) acc[a][b][m][n] = (f32x4){0.f, 0.f, 0.f, 0.f};
    bf16x8 At[4][2], B0[2][2], B1[2][2];
    unsigned vAc[2][2], vAn[2][2];
    ad.a_offs(cur, Rs, Cs, vAc);
    PG8_STAGE(PG8_SB(0, 0), ad.b_ptr(cur, 0, 0), voffB); PG8_STAGE(PG8_SB(0, 1), ad.b_ptr(cur, 1, 0), voffB); PG8_STAGE_A(PG8_SA(0, 0), cur, 0, 0, vAc); PG8_STAGE_A(PG8_SA(0, 1), cur, 1, 0, vAc);
    if (wr == 1) PG8_BAR;
    PG8_WAIT_V(2); PG8_BAR;
    PG8_STAGE(PG8_SB(1, 0), ad.b_ptr(cur, 0, 1), voffB); PG8_STAGE_A(PG8_SA(1, 0), cur, 0, 1, vAc); PG8_STAGE(PG8_SB(1, 1), ad.b_ptr(cur, 1, 1), voffB);
    PG8_WAIT_V(6); PG8_BAR;
    for (;;) {
        const bool has_next = S.next(ui + 1, nxt);
        if (!has_next) nxt = cur;
        if constexpr (AD::GATHER) {
            if (has_next) ad.a_offs(nxt, Rs, Cs, vAn);
            else {
#pragma unroll
                for (int h = 0; h < 2; ++h)
#pragma unroll
                    for (int i = 0; i < 2; ++i) vAn[h][i] = vAc[h][i]; } }
#pragma clang loop unroll(disable)
        for (int t = 0; t < nt; t += 2) {
            const bool last = (t == nt - 2);
            const Unit u2 = last ? nxt : cur; const int k2 = last ? 0 : t + 2, k3 = k2 + 1;
            unsigned v2[2][2];
            if constexpr (AD::GATHER) {
#pragma unroll
                for (int h = 0; h < 2; ++h)
#pragma unroll
                    for (int i = 0; i < 2; ++i) v2[h][i] = last ? vAn[h][i] : vAc[h][i]; }
            PG8_LDB(B0, 0, 0); PG8_LDB(B1, 0, 1); PG8_SCHED; PG8_LDA(At, 0, 0); PG8_STAGE_A(PG8_SA(1, 1), cur, 1, t + 1, vAc);
            PG8_WAIT_V(8); PG8_WAIT_L(0); PG8_BAR; PG8_MMA(0, 0, At, B0); PG8_MMA(0, 1, At, B1); PG8_BAR; PG8_SCHED;
            PG8_LDA(At, 0, 1); PG8_STAGE(PG8_SB(0, 0), ad.b_ptr(u2, 0, k2), voffB); PG8_STAGE(PG8_SB(0, 1), ad.b_ptr(u2, 1, k2), voffB); PG8_STAGE_A(PG8_SA(0, 0), u2, 0, k2, v2);
            PG8_WAIT_V(8); PG8_WAIT_L(0); PG8_BAR; PG8_MMA(1, 0, At, B0); PG8_MMA(1, 1, At, B1); PG8_BAR; PG8_SCHED;
            PG8_LDB(B0, 1, 0); PG8_LDB(B1, 1, 1); PG8_SCHED; PG8_LDA(At, 1, 0); PG8_STAGE_A(PG8_SA(0, 1), u2, 1, k2, v2);
            PG8_WAIT_V(8); PG8_WAIT_L(0); PG8_BAR; PG8_MMA(0, 0, At, B0); PG8_MMA(0, 1, At, B1); PG8_BAR; PG8_SCHED;
            PG8_LDA(At, 1, 1); PG8_STAGE(PG8_SB(1, 0), ad.b_ptr(u2, 0, k3), voffB); PG8_STAGE(PG8_SB(1, 1), ad.b_ptr(u2, 1, k3), voffB); PG8_STAGE_A(PG8_SA(1, 0), u2, 0, k3, v2);
            PG8_WAIT_V(8); PG8_WAIT_L(0); PG8_BAR; PG8_MMA(1, 0, At, B0); PG8_MMA(1, 1, At, B1); PG8_BAR; PG8_SCHED;
        }
        if constexpr (ALIGN_EPI) { if (wr == 0) PG8_BAR; }
        E(acc, cur, wr, wc, fr, fq);
        if (!has_next) break;
#pragma unroll
        for (int a = 0; a < 2; ++a)
#pragma unroll
            for (int b = 0; b < 2; ++b)
#pragma unroll
                for (int m = 0; m < 4; ++m)
#pragma unroll
                    for (int n = 0; n < 2; ++n) acc[a][b][m][n] = (f32x4){0.f, 0.f, 0.f, 0.f};
        cur = nxt; ++ui;
        if constexpr (AD::GATHER) {
#pragma unroll
            for (int h = 0; h < 2; ++h)
#pragma unroll
                for (int i = 0; i < 2; ++i) vAc[h][i] = vAn[h][i]; }
        if constexpr (ALIGN_EPI) { if (wr == 1) PG8_BAR; }
    }
    PG8_WAIT_V(0);
    if constexpr (!ALIGN_EPI) { if (wr == 0) PG8_BAR; }
    PG8_BAR;
#undef PG8_SA
#undef PG8_SB
#undef PG8_STAGE
#undef PG8_STAGE_A
#undef PG8_LDA
#undef PG8_LDB
#undef PG8_MMA
#undef PG8_WAIT_V
#undef PG8_WAIT_L
#undef PG8_BAR
#undef PG8_SCHED
}
}
namespace attn_body {
using bf16=__hip_bfloat16;
using bf16x8=__attribute__((ext_vector_type(8)))short;
using s16x4=__attribute__((ext_vector_type(4)))short;
using f32x16=__attribute__((ext_vector_type(16)))float;
using f32x2_t=__attribute__((ext_vector_type(2)))float;
using u32x4=__attribute__((ext_vector_type(4)))unsigned;
constexpr int BATCH=2,NHEAD=16,SEQ=8192,D=64,DM=NHEAD*D;
constexpr int NW=8,QBLK=32,QB=QBLK*NW,KVBLK=64,NQB=SEQ/QB;
constexpr int ATTN_PITCH=DM, ATTN_UNIT_ROWS=QB;
__device__ __forceinline__ int crow(int r,int hi){return (r&3)+8*(r>>2)+4*hi;}
#define SBAR() __builtin_amdgcn_sched_barrier(0)
__device__ __forceinline__ void cmask(f32x16&p0,f32x16&p1,int jb,int qrel,int hi){
  const float NEG=-INFINITY; int kb=64*jb+4*hi;
  #pragma unroll
  for(int r=0;r<16;++r){int kv=kb+(r&3)+8*(r>>2); if(kv>qrel)p0[r]=NEG; if(kv+32>qrel)p1[r]=NEG;}
}

constexpr int NSLOT=3, SLOTB=8192;
constexpr int LDS_K=0, LDS_V=NSLOT*SLOTB, LDS_WS=2*NSLOT*SLOTB, LDS_OST=LDS_WS+NW*64*4, LDS_BIAS=LDS_OST+NW*4096, LDS_TKT=LDS_BIAS+SEQ*4, LDS_BYTES=LDS_TKT+16;
constexpr float C2=0.125f*1.4426950408889634f;
__device__ __forceinline__ void glds16(const void*gsrc,unsigned lds_dst){unsigned keep;
  asm volatile("s_mov_b32 %0, m0\n\ts_mov_b32 m0, %2\n\ts_nop 0\n\tglobal_load_lds_dwordx4 %1, off\n\ts_mov_b32 m0, %0":"=&s"(keep):"v"(gsrc),"s"(lds_dst):"memory");}
__device__ __forceinline__ void glds16s(const void*sbase,unsigned voff,unsigned lds_dst){unsigned keep;
  asm volatile("s_mov_b32 %0, m0\n\ts_mov_b32 m0, %3\n\ts_nop 0\n\tglobal_load_lds_dwordx4 %1, %2\n\ts_mov_b32 m0, %0":"=&s"(keep):"v"(voff),"s"(sbase),"s"(lds_dst):"memory");}
__device__ __forceinline__ float max3f(float a,float b,float c){float r;asm("v_max3_f32 %0, %1, %2, %3":"=v"(r):"v"(a),"v"(b),"v"(c));return r;}
__device__ __forceinline__ float max2f(float a,float b){float r;asm("v_max_f32_e32 %0, %1, %2":"=v"(r):"v"(a),"v"(b));return r;}
__device__ __forceinline__ float fadd_s(float a,float b){float r;asm("v_add_f32_e32 %0, %1, %2":"=v"(r):"v"(a),"v"(b));return r;}
__device__ __forceinline__ float fsub_s(float a,float b){float r;asm("v_sub_f32_e32 %0, %1, %2":"=v"(r):"v"(a),"v"(b));return r;}
typedef float f32x2_t __attribute__((ext_vector_type(2))); typedef __bf16 bf16x2_t __attribute__((ext_vector_type(2)));
__device__ __forceinline__ unsigned cvtpk_s(float lo,float hi){f32x2_t v={lo,hi};bf16x2_t b=__builtin_convertvector(v,bf16x2_t);return __builtin_bit_cast(unsigned,b);}
#define WAIT_BAR(N) asm volatile("s_waitcnt vmcnt(" #N ") lgkmcnt(0)\n\ts_barrier":::"memory")

__device__ __forceinline__ void qkt(f32x16&p0,f32x16&p1,const char*Kslot,const bf16x8*qr,const f32x16&negm,int r32,int hi){
  const char*kb=Kslot+hi*1024+r32*16;
  #pragma unroll
  for(int d0=0;d0<4;++d0){
    const bf16x8 b0=*reinterpret_cast<const bf16x8*>(kb+d0*2048);
    const bf16x8 b1=*reinterpret_cast<const bf16x8*>(kb+d0*2048+512);
    if(d0==0){p0=__builtin_amdgcn_mfma_f32_32x32x16_bf16(b0,qr[0],negm,0,0,0);p1=__builtin_amdgcn_mfma_f32_32x32x16_bf16(b1,qr[0],negm,0,0,0);}
    else{p0=__builtin_amdgcn_mfma_f32_32x32x16_bf16(b0,qr[d0],p0,0,0,0);p1=__builtin_amdgcn_mfma_f32_32x32x16_bf16(b1,qr[d0],p1,0,0,0);}}
}
typedef __attribute__((address_space(3))) const char* lds_cptr;
typedef short v4i16_t __attribute__((ext_vector_type(4)));
__device__ __forceinline__ void kload8(bf16x8*kf,lds_cptr kp){
  kf[0]=*(const __attribute__((address_space(3))) bf16x8*)(kp);      kf[1]=*(const __attribute__((address_space(3))) bf16x8*)(kp+512);
  kf[2]=*(const __attribute__((address_space(3))) bf16x8*)(kp+2048); kf[3]=*(const __attribute__((address_space(3))) bf16x8*)(kp+2560);
  kf[4]=*(const __attribute__((address_space(3))) bf16x8*)(kp+4096); kf[5]=*(const __attribute__((address_space(3))) bf16x8*)(kp+4608);
  kf[6]=*(const __attribute__((address_space(3))) bf16x8*)(kp+6144); kf[7]=*(const __attribute__((address_space(3))) bf16x8*)(kp+6656);
}
__device__ __forceinline__ void kload2(bf16x8*kf,lds_cptr kp,int j){ kf[2*j]=*(const __attribute__((address_space(3))) bf16x8*)(kp+j*2048); kf[2*j+1]=*(const __attribute__((address_space(3))) bf16x8*)(kp+j*2048+512); }
__device__ __forceinline__ s16x4 vtr(lds_cptr p){ return __builtin_bit_cast(s16x4,__builtin_amdgcn_ds_read_tr16_b64_v4i16((__attribute__((address_space(3))) v4i16_t*)p)); }
__device__ __forceinline__ float rowmax(const f32x16&p0,const f32x16&p1){
  float a=max3f(p0[0],p0[1],p1[0]),b=max3f(p0[2],p0[3],p1[1]);a=max3f(a,p1[2],p1[3]);
  #pragma unroll
  for(int r=4;r<16;r+=4){a=max3f(a,p0[r],p0[r+1]);b=max3f(b,p0[r+2],p0[r+3]);a=max3f(a,p1[r],p1[r+1]);b=max3f(b,p1[r+2],p1[r+3]);}
  const float m=max2f(a,b);
  auto rr=__builtin_amdgcn_permlane32_swap(__float_as_uint(m),__float_as_uint(m),false,false);
  return max2f(__uint_as_float(rr[0]),__uint_as_float(rr[1]));
}
__device__ __forceinline__ void pv(f32x16*o,int vb,bf16x8 pa0,bf16x8 pa1,bf16x8 pa2,bf16x8 pa3){
  #pragma unroll
  for(int d0=0;d0<2;++d0){s16x4 lo[4],hi[4];
    #pragma unroll
    for(int ks=0;ks<4;++ks){
      asm volatile("ds_read_b64_tr_b16 %0,%1 offset:%c2":"=&v"(lo[ks]):"v"(vb),"i"(d0*4096+ks*1024):"memory");
      asm volatile("ds_read_b64_tr_b16 %0,%1 offset:%c2":"=&v"(hi[ks]):"v"(vb),"i"(d0*4096+ks*1024+512):"memory");}
    asm volatile("s_waitcnt lgkmcnt(0)":::"memory");SBAR();
    #define PK(k) (bf16x8){lo[k][0],lo[k][1],lo[k][2],lo[k][3],hi[k][0],hi[k][1],hi[k][2],hi[k][3]}
    o[d0]=__builtin_amdgcn_mfma_f32_32x32x16_bf16(pa0,PK(0),o[d0],0,0,0);
    o[d0]=__builtin_amdgcn_mfma_f32_32x32x16_bf16(pa1,PK(1),o[d0],0,0,0);
    o[d0]=__builtin_amdgcn_mfma_f32_32x32x16_bf16(pa2,PK(2),o[d0],0,0,0);
    o[d0]=__builtin_amdgcn_mfma_f32_32x32x16_bf16(pa3,PK(3),o[d0],0,0,0);
    #undef PK
  }
}

#ifndef ATTN_STORE16
#define ATTN_STORE16(p,v) (*(u32x4*)(p)=(v))
#endif
template<int THRL> __device__ __forceinline__ void attn_unit(int b,int h,int qb,const bf16*Q,const bf16*__restrict__ K,const bf16*__restrict__ V,bf16*O,const float*Fm,const unsigned*NQ,const unsigned*NK,unsigned*ctr,char*shm){
  int tid=threadIdx.x; asm volatile("":"+v"(tid));
  const int lane=tid&63,r32=lane&31,hi=lane>>5; const int wid=__builtin_amdgcn_readfirstlane(tid>>6);
  const long rowbase=(long)b*SEQ; const int q0=qb*QB;
  typedef __attribute__((address_space(3))) float lds_f32; typedef __attribute__((address_space(3))) const f32x2_t* lds_cf2;
  int t_start; const float*Fh=Fm+(long)(b*NHEAD+h)*SEQ; float fref;
  int tid2=tid; asm volatile("":"+v"(tid2));
  { fref=__hip_atomic_load(Fh+q0,__ATOMIC_RELAXED,__HIP_MEMORY_SCOPE_AGENT);
    const unsigned*nq=NQ+((b*NQB+qb)*NHEAD+h)*2; const unsigned*nk=NK+(b*NHEAD+h)*2;
    const float q2=__uint_as_float(__hip_atomic_load(nq,__ATOMIC_RELAXED,__HIP_MEMORY_SCOPE_AGENT))+__uint_as_float(__hip_atomic_load(nq+1,__ATOMIC_RELAXED,__HIP_MEMORY_SCOPE_AGENT));
    const float k2=__uint_as_float(__hip_atomic_load(nk,__ATOMIC_RELAXED,__HIP_MEMORY_SCOPE_AGENT))+__uint_as_float(__hip_atomic_load(nk+1,__ATOMIC_RELAXED,__HIP_MEMORY_SCOPE_AGENT));
    const float thr=43.3f+2.02f*sqrtf(q2*k2);
    const int NTf=(q0+QB)/KVBLK; int cnt=0;
    _Pragma("unroll") for(int jj=0;jj<2;++jj){ const int j=1+(tid2&63)+64*jj; bool ok=false; if(j<=NTf-4) ok=((fref-Fh[64*j-1])*1.4426950408889634f<=-thr); cnt+=__popcll(__ballot(ok)); }
    t_start=__builtin_amdgcn_readfirstlane(cnt&~1);
  }
  const lds_cf2 bias2=(lds_cf2)((__attribute__((address_space(3))) const char*)shm+LDS_BIAS)+2*hi+t_start*32;
  const bf16*Qw=Q+(rowbase+q0+wid*QBLK)*DM+h*D;
  const bf16*Kh=K+(rowbase+(long)t_start*KVBLK)*DM+h*D,*Vh=V+(rowbase+(long)t_start*KVBLK)*DM+h*D;
  const unsigned lds0=(unsigned)(uintptr_t)shm;
  float*wsf=(float*)(shm+LDS_WS)+wid*64;
  const bf16*ksrc=Kh+wid*8;
  const bf16*vsrc=Vh+(long)(16*(wid&3))*DM+(wid>>2)*32;
  const unsigned kvoff=(unsigned)lane*(DM*2), vvoff=(unsigned)((lane>>2)*DM+(lane&3)*8)*2u;
  const unsigned kdst=lds0+LDS_K+wid*1024, vdst=lds0+LDS_V+wid*1024;
  #define DMA_K(t,slot) glds16s(ksrc+(long)(t)*KVBLK*DM,kvoff,(unsigned)__builtin_amdgcn_readfirstlane(kdst+(slot)))
  #define DMA_V(t,slot) glds16s(vsrc+(long)(t)*KVBLK*DM,vvoff,(unsigned)__builtin_amdgcn_readfirstlane(vdst+(slot)))
  const char*Kbase=shm+LDS_K; bf16x8 kf[8];
  const lds_cptr shm3=(lds_cptr)shm; const lds_cptr kp0=shm3+LDS_K+hi*1024+r32*16; const lds_cptr vp0=shm3+LDS_V+((lane>>4)&1)*32+(lane&3)*8+(4*hi+((lane&15)>>2))*64;
  const int NT=(q0+QB)/KVBLK-t_start;
  DMA_K(0,0);DMA_V(0,0);DMA_K(1,SLOTB);
  bf16x8 qr[4];
  #pragma unroll
  for(int d0=0;d0<4;++d0)qr[d0]=*reinterpret_cast<const bf16x8*>(&Qw[(long)r32*DM+d0*16+hi*8]);
  { lds_f32*bl=(lds_f32*)((__attribute__((address_space(3))) char*)shm+LDS_BIAS);
    _Pragma("clang loop unroll(disable) vectorize(disable)")
    for(int s0=t_start*KVBLK+tid2;s0<q0+QB;s0+=4*NW*64){ float f_[4];
      _Pragma("unroll") for(int u_=0;u_<4;++u_){ const int s_=s0+u_*NW*64; f_[u_]=Fh[s_<q0+QB?s_:q0]; }
      _Pragma("unroll") for(int u_=0;u_<4;++u_){ const int s_=s0+u_*NW*64; if(s_<q0+QB)bl[s_]=(fref-f_[u_])*1.4426950408889634f; } } }
  float mhat=0.f,l_reg=0.f;f32x16 o[2];o[0]=f32x16{};o[1]=f32x16{};f32x16 negm=f32x16{};asm volatile("":"+v"(negm));
  const int qrel=wid*QBLK+r32;
  #define CMASK(P0,P1,t) do{int jb_=(t)-(NT-4); if(jb_>=0)cmask(P0,P1,jb_,qrel,hi);}while(0)
  #define BIASADD(P0,P1,t) do{ const lds_cf2 bp_=bias2+(t)*32; \
    _Pragma("unroll") for(int j_=0;j_<4;++j_){ SBAR(); \
      const f32x2_t b0_=bp_[4*j_], b1_=bp_[4*j_+1], b2_=bp_[4*j_+16], b3_=bp_[4*j_+17];     \
      P0[4*j_]+=b0_[0]; P0[4*j_+1]+=b0_[1]; P0[4*j_+2]+=b1_[0]; P0[4*j_+3]+=b1_[1]; \
      P1[4*j_]+=b2_[0]; P1[4*j_+1]+=b2_[1]; P1[4*j_+2]+=b3_[0]; P1[4*j_+3]+=b3_[1]; } SBAR(); }while(0)
  bool resc=false;
  #define START(P0,P1) do{ const float rm=rowmax(P0,P1); resc=false; \
    { const float dl=rm; mhat=fadd_s(mhat,dl); \
      _Pragma("unroll") for(int r=0;r<16;++r){P0[r]=fsub_s(P0[r],dl);P1[r]=fsub_s(P1[r],dl);} \
      _Pragma("unroll") for(int r=0;r<16;++r)negm[r]=-mhat; asm volatile("":"+v"(negm)); } \
    _Pragma("unroll") for(int r=0;r<16;++r)P0[r]=__builtin_amdgcn_exp2f(P0[r]); }while(0)
  #define RESC() do{ if(resc){ asm volatile("s_waitcnt lgkmcnt(0)":::"memory"); \
      _Pragma("unroll") for(int d_=0;d_<2;++d_) _Pragma("unroll") for(int r=0;r<16;++r)o[d_][r]*=wsf[crow(r,hi)]; } }while(0)
  f32x16 pA0,pA1,pB0,pB1;
  int sl_prev=0,sl_cur=0,sl_next=SLOTB;
  #define ROT() do{sl_prev=sl_cur;sl_cur=sl_next;sl_next=(sl_next==(NSLOT-1)*SLOTB)?0:sl_next+SLOTB;}while(0)
  DMA_K(2,2*SLOTB);
  WAIT_BAR(3);
  qkt(pA0,pA1,Kbase,qr,negm,r32,hi);asm volatile("s_nop 15\n\ts_nop 7":"+v"(pA0),"+v"(pA1));BIASADD(pA0,pA1,0);CMASK(pA0,pA1,0);
  START(pA0,pA1);
  _Pragma("unroll") for(int r=0;r<16;++r)pA1[r]=__builtin_amdgcn_exp2f(pA1[r]);
  WAIT_BAR(0);
  DMA_K(3,0);DMA_V(1,SLOTB);
  ROT();
  kload8(kf,kp0+sl_cur);
  WAIT_BAR(2);
  s16x4 vlo[8],vhi[8]; u32x4 pw0,pw1,pw2,pw3;
  #define PKW(P,B) cvtpk_s(P[B],P[B+1])
  #define PAF(k) __builtin_bit_cast(bf16x8,pw##k)
  #define VFR(i) (bf16x8){vlo[i][0],vlo[i][1],vlo[i][2],vlo[i][3],vhi[i][0],vhi[i][1],vhi[i][2],vhi[i][3]}
  #define PIN(x) asm volatile("":"+v"(x))
  #define MX3(a,b,c) __builtin_fmaxf(__builtin_fmaxf((a),(b)),(c))
  #define GAPA(MF,A0,A1,A2,A3,W0,W1,PW) do{ MF; sacc+=A0; sacc+=A1; sacc+=A2; sacc+=A3; PIN(sacc); W0; W1; PIN(PW); SBAR(); }while(0)
  #define EX(v) __builtin_amdgcn_exp2f(v)
  #define GAPB(MF,X,B) do{ MF; X[B]=EX(X[B]); X[B+1]=EX(X[B+1]); X[B+2]=EX(X[B+2]); X[B+3]=EX(X[B+3]); PIN(X); SBAR(); }while(0)
  #define VRD(i) do{ vlo[i]=vtr(vp_+(((i)>>2)*4096+((i)&3)*1024)); vhi[i]=vtr(vp_+(((i)>>2)*4096+((i)&3)*1024+512)); }while(0)
  #define KRD(G,j) do{ if(G){ kload2(kf,kp0+sl_next,j); SBAR(); } }while(0)
  #define STEP(C0,C1,P0,P1,t,GK,GV,GL) do{ SBAR(); \
    const lds_cptr vp_=vp0+sl_prev; \
    VRD(0); SBAR(); float sacc=(P0[0]+P0[1]); \
    GAPA(C0=__builtin_amdgcn_mfma_f32_32x32x16_bf16(kf[0],qr[0],negm,0,0,0), P0[2],P0[3],P0[4],P0[5],     pw0[0]=PKW(P0,0), pw0[1]=PKW(P0,2), pw0); \
    VRD(4); SBAR(); GAPA(C1=__builtin_amdgcn_mfma_f32_32x32x16_bf16(kf[1],qr[0],negm,0,0,0), P0[6],P0[7],P0[8],P0[9],     pw0[2]=PKW(P0,4), pw0[3]=PKW(P0,6), pw0); \
    VRD(1); SBAR(); GAPA(C0=__builtin_amdgcn_mfma_f32_32x32x16_bf16(kf[2],qr[1],C0,0,0,0),   P0[10],P0[11],P0[12],P0[13], pw1[0]=PKW(P0,8), pw1[1]=PKW(P0,10), pw1); \
    VRD(5); SBAR(); GAPA(C1=__builtin_amdgcn_mfma_f32_32x32x16_bf16(kf[3],qr[1],C1,0,0,0),   P0[14],P0[15],P1[0],P1[1],   pw1[2]=PKW(P0,12),pw1[3]=PKW(P0,14), pw1); \
    VRD(2); SBAR(); GAPA(C0=__builtin_amdgcn_mfma_f32_32x32x16_bf16(kf[4],qr[2],C0,0,0,0),   P1[2],P1[3],P1[4],P1[5],     pw2[0]=PKW(P1,0), pw2[1]=PKW(P1,2), pw2); \
    VRD(6); SBAR(); GAPA(C1=__builtin_amdgcn_mfma_f32_32x32x16_bf16(kf[5],qr[2],C1,0,0,0),   P1[6],P1[7],P1[8],P1[9],     pw2[2]=PKW(P1,4), pw2[3]=PKW(P1,6), pw2); \
    VRD(3); SBAR(); GAPA(C0=__builtin_amdgcn_mfma_f32_32x32x16_bf16(kf[6],qr[3],C0,0,0,0),   P1[10],P1[11],P1[12],P1[13], pw3[0]=PKW(P1,8), pw3[1]=PKW(P1,10), pw3); \
    VRD(7); SBAR(); GAPA(C1=__builtin_amdgcn_mfma_f32_32x32x16_bf16(kf[7],qr[3],C1,0,0,0),   P1[14],P1[15],0.f,0.f,       pw3[2]=PKW(P1,12),pw3[3]=PKW(P1,14), pw3); \
    l_reg+=sacc; \
    if(GK){DMA_K((t)+3,sl_cur);} if(GV){DMA_V((t)+1,sl_next);} \
    BIASADD(C0,C1,t); CMASK(C0,C1,t); \
    { float a=MX3(C0[0],C0[1],C1[0]),b=MX3(C0[2],C0[3],C1[1]); a=MX3(a,C1[2],C1[3]); \
      _Pragma("unroll") for(int r=4;r<16;r+=4){a=MX3(a,C0[r],C0[r+1]);b=MX3(b,C0[r+2],C0[r+3]);a=MX3(a,C1[r],C1[r+1]);b=MX3(b,C1[r+2],C1[r+3]);} \
      float rm=__builtin_fmaxf(a,b); { auto rr=__builtin_amdgcn_permlane32_swap(__float_as_uint(rm),__float_as_uint(rm),false,false); rm=__builtin_fmaxf(__uint_as_float(rr[0]),__uint_as_float(rr[1])); } \
      resc=false; \
      if(__builtin_expect(__any(rm>(float)THRL),0)){ const float dl=__builtin_fmaxf(rm,0.f); mhat+=dl; \
        _Pragma("unroll") for(int r=0;r<16;++r){C0[r]-=dl;C1[r]-=dl;} \
        _Pragma("unroll") for(int r=0;r<16;++r)negm[r]=-mhat; asm volatile("":"+v"(negm)); \
        const float f=__builtin_amdgcn_exp2f(-dl); l_reg*=f; if(hi==0)wsf[r32]=f; resc=true; } } \
    SBAR(); \
    GAPB(o[0]=__builtin_amdgcn_mfma_f32_32x32x16_bf16(PAF(0),VFR(0),o[0],0,0,0), C0,0); \
    GAPB(o[1]=__builtin_amdgcn_mfma_f32_32x32x16_bf16(PAF(0),VFR(4),o[1],0,0,0), C0,4); \
    KRD(GL,0); GAPB(o[0]=__builtin_amdgcn_mfma_f32_32x32x16_bf16(PAF(1),VFR(1),o[0],0,0,0), C0,8); \
    KRD(GL,1); GAPB(o[1]=__builtin_amdgcn_mfma_f32_32x32x16_bf16(PAF(1),VFR(5),o[1],0,0,0), C0,12); \
    KRD(GL,2); GAPB(o[0]=__builtin_amdgcn_mfma_f32_32x32x16_bf16(PAF(2),VFR(2),o[0],0,0,0), C1,0); \
    KRD(GL,3); GAPB(o[1]=__builtin_amdgcn_mfma_f32_32x32x16_bf16(PAF(2),VFR(6),o[1],0,0,0), C1,4); \
    GAPB(o[0]=__builtin_amdgcn_mfma_f32_32x32x16_bf16(PAF(3),VFR(3),o[0],0,0,0), C1,8); \
    GAPB(o[1]=__builtin_amdgcn_mfma_f32_32x32x16_bf16(PAF(3),VFR(7),o[1],0,0,0), C1,12); \
    }while(0)
  int t=1;
  #undef CMASK
  #define CMASK(P0,P1,t) do{}while(0)
  for(;t+5<NT;t+=2){
    STEP(pB0,pB1,pA0,pA1,t,true,true,true);     WAIT_BAR(2); RESC(); ROT();
    STEP(pA0,pA1,pB0,pB1,t+1,true,true,true);   WAIT_BAR(2); RESC(); ROT();
  }
  #undef CMASK
  #define CMASK(P0,P1,t) do{int jb_=(t)-(NT-4); if(jb_>=0)cmask(P0,P1,jb_,qrel,hi);}while(0)
  #define ENDW(tt) do{ if((tt)+3<NT){WAIT_BAR(2);} else if((tt)+2<NT){WAIT_BAR(1);} else {WAIT_BAR(0);} }while(0)
  for(;t+1<NT;t+=2){
    STEP(pB0,pB1,pA0,pA1,t,(t+3<NT),(t+1<NT),(t+1<NT));       ENDW(t);   RESC(); ROT();
    STEP(pA0,pA1,pB0,pB1,t+1,(t+4<NT),(t+2<NT),(t+2<NT));     ENDW(t+1); RESC(); ROT();
  }
  STEP(pB0,pB1,pA0,pA1,NT-1,false,false,false); RESC();
  { float sacc=pB0[0]+pB0[1]; _Pragma("unroll") for(int r=2;r<16;++r)sacc+=pB0[r]; _Pragma("unroll") for(int r=0;r<16;++r)sacc+=pB1[r]; l_reg+=sacc;
    pw0=(u32x4){PKW(pB0,0),PKW(pB0,2),PKW(pB0,4),PKW(pB0,6)};pw1=(u32x4){PKW(pB0,8),PKW(pB0,10),PKW(pB0,12),PKW(pB0,14)};pw2=(u32x4){PKW(pB1,0),PKW(pB1,2),PKW(pB1,4),PKW(pB1,6)};pw3=(u32x4){PKW(pB1,8),PKW(pB1,10),PKW(pB1,12),PKW(pB1,14)};
    const int vb0=(int)(lds0+LDS_V)+((lane>>4)&1)*32+(lane&3)*8+(4*hi+((lane&15)>>2))*64;
    SBAR(); pv(o,vb0+sl_cur,PAF(0),PAF(1),PAF(2),PAF(3)); }
  #undef PKW
  #undef PAF
  #undef VFR
  #undef PIN
  #undef MX3
  #undef GAPA
  #undef GAPB
  #undef EX
  #undef VRD
  #undef KRD
  #undef STEP
  #undef ENDW
  unsigned tk_=0u; if(tid==0)tk_=__hip_atomic_fetch_add(ctr,1u,__ATOMIC_RELAXED,__HIP_MEMORY_SCOPE_AGENT);
  {auto rr=__builtin_amdgcn_permlane32_swap(__float_as_uint(l_reg),__float_as_uint(l_reg),false,false);l_reg=__uint_as_float(rr[0])+__uint_as_float(rr[1]);}
  if(hi==0)wsf[32+r32]=l_reg;asm volatile("s_waitcnt lgkmcnt(0)":::"memory");
  float rli[16];
  #pragma unroll
  for(int r=0;r<16;++r)rli[r]=__builtin_amdgcn_rcpf(wsf[32+crow(r,hi)]);
  bf16*Ow=O+(rowbase+q0+wid*QBLK)*DM+h*D;
  { bf16*stg=(bf16*)(shm+LDS_OST)+wid*2048;
    #pragma unroll
    for(int r=0;r<16;++r){const int orow=crow(r,hi);
      #pragma unroll
      for(int d0=0;d0<2;++d0)stg[orow*64+d0*32+r32]=__float2bfloat16(o[d0][r]*rli[r]);}
    asm volatile("s_waitcnt lgkmcnt(0)":::"memory");
    #pragma unroll
    for(int i=0;i<4;++i){const int row=i*8+(lane>>3),ch=lane&7; const u32x4 v=*(const u32x4*)(stg+row*64+ch*8); ATTN_STORE16(Ow+(long)row*DM+ch*8,v);} }
  if(tid==0)*(__attribute__((address_space(3))) unsigned*)((__attribute__((address_space(3))) char*)shm+LDS_TKT)=tk_;
  asm volatile("s_waitcnt lgkmcnt(0)\n\ts_barrier":::"memory");
  #undef DMA_K
  #undef BIASADD
  #undef DMA_V
  #undef CMASK
  #undef START
  #undef RESC
  #undef ROT
}
constexpr int ATTN_LDS_BYTES=LDS_BYTES;
struct AttnTensors { const bf16* Q; const bf16* K; const bf16* V; bf16* O; const float* F; const unsigned* NQ; const unsigned* NK; };
struct AttnUnit { int bh; int qb; };
struct StaticOrder {
  int vcu,G;
  __device__ __forceinline__ explicit StaticOrder(int grid,int vcu_):vcu(vcu_),G(grid){}
  __device__ __forceinline__ bool next(int i,AttnUnit&u)const{ const int quad=(i>>2)*G+vcu; if(quad>=BATCH*NHEAD*8)return false; const int s=quad&7,j=i&3; u.bh=quad>>3; u.qb=(j==0)?s:(j==1)?15-s:(j==2)?16+s:31-s; return true; }
  __device__ __forceinline__ void a_ready(const AttnUnit&)const{}
  __device__ __forceinline__ void done(const AttnUnit&)const{}
};
constexpr int NUNITS=BATCH*NHEAD*NQB;
template<int THRL=60> __device__ __forceinline__ void attn_phase(char*lds,const AttnTensors&T,unsigned*ctr){
  __attribute__((address_space(3))) unsigned*tkt=(__attribute__((address_space(3))) unsigned*)((__attribute__((address_space(3))) char*)lds+LDS_TKT);
  if(threadIdx.x==0)*tkt=__hip_atomic_fetch_add(ctr,1u,__ATOMIC_RELAXED,__HIP_MEMORY_SCOPE_AGENT);
  asm volatile("s_waitcnt vmcnt(0) lgkmcnt(0)\n\ts_barrier":::"memory");
  for(;;){ const unsigned n=(unsigned)__builtin_amdgcn_readfirstlane((int)*tkt); if(n>=(unsigned)NUNITS)break;
    const int bh=(int)(n&31u),qb=NQB-1-(int)(n>>5);
    attn_unit<THRL>(bh/NHEAD,bh%NHEAD,qb,T.Q,T.K,T.V,T.O,T.F,T.NQ,T.NK,ctr,lds); }
}
#undef SBAR
#undef WAIT_BAR
}
constexpr int NWAVES = 8;
#ifndef MK_PER_PHASE
#define MK_PER_PHASE 0
#endif
constexpr int NPHASE = 15;

constexpr int BATCH = 4, T = 8192, D = 1024, H = 16, HD = 64;
constexpr int M = BATCH * T;
constexpr int NQKV = 3 * D;
constexpr int MH = M / 2, BH = BATCH / 2;
constexpr int NEXP = 16, DEXP = 256, NBUCKET = 24, MAXTILES = 88, HROWS = MAXTILES * 256, BCAP = MH;
constexpr int NBLK = MH / 128;
constexpr float RMS_EPS = 1e-6f;

constexpr size_t MiB = 1u << 20, KiB = 1u << 10;
constexpr size_t WS_CTL = 0, CTL_ZERO_BYTES = 128 * KiB;
constexpr size_t WS_TOKINFO = 1 * MiB, WS_TOKGATE = WS_TOKINFO + 128 * KiB, WS_HIST = WS_TOKGATE + 256 * KiB, WS_TILETBL = WS_HIST + 32 * KiB, WS_TOKROW = WS_TILETBL + 4 * KiB,
                 WS_GATEROW = WS_TOKROW + 160 * KiB, WS_BLKSUM = WS_GATEROW + 320 * KiB, WS_RWG = WS_BLKSUM + 16 * KiB, WS_WFG = WS_RWG + 160 * KiB, WS_TRASH = WS_WFG + 64 * KiB, WS_SMALL_END = WS_TRASH + 4 * KiB;
static_assert(WS_SMALL_END <= 4 * MiB, "small tables");
constexpr size_t WS_LF = 4 * MiB, WS_FM = 6 * MiB;
constexpr size_t WS_WPOOL = 8 * MiB, WS_WQKV = 9 * MiB, WS_WO = 15 * MiB, WS_WG = 17 * MiB, WS_WU = 33 * MiB, WS_WD = 49 * MiB;
constexpr size_t WS_XN = 66 * MiB;
constexpr size_t WS_QO = 130 * MiB, WS_K = 194 * MiB, WS_V = 258 * MiB;
constexpr size_t WS_HMID = 322 * MiB, WS_Y0 = 370 * MiB, WS_DPOOL = 434 * MiB, WS_TOKROW2 = 498 * MiB, WS_GATEROW2 = 501 * MiB, WS_END = 508 * MiB;
static_assert(WS_HMID + (size_t)2 * HROWS * 512 * 2 <= WS_Y0 && WS_TOKROW2 + (size_t)2 * NBUCKET * BCAP * 4 <= WS_GATEROW2 && WS_GATEROW2 + (size_t)2 * NBUCKET * BCAP * 8 <= WS_END && WS_V - WS_K == WS_K - WS_QO, "d_ws map");
constexpr int CW_BAR = 4096;
constexpr int CW_NRM = 8192;
constexpr int CW_CNT = 12800;
constexpr int CW_CONV = 13120;
constexpr int CW_BARH = 16384;
constexpr int CW_ATQ = 12544;
static_assert(CW_NRM + 4096 + 128 <= CW_ATQ && (CW_BARH + 2 * 3456) * 4 <= (int)CTL_ZERO_BYTES, "CTL words inside the memset region");

constexpr int RING_OFF = 0, RING_BYTES = 131072;
constexpr int LDSCTL_OFF = RING_BYTES, MISC_OFF = LDSCTL_OFF + 320;
constexpr int TBL_OFF = RING_BYTES + 1024;
constexpr int LDS_BYTES = 147456;
static_assert(MISC_OFF + 128 <= TBL_OFF && TBL_OFF + (1 + 3 * MAXTILES) * 4 <= LDS_BYTES, "LDS map");

#define GAS __attribute__((address_space(1)))
#define LAS __attribute__((address_space(3)))
typedef unsigned short bf16;
typedef unsigned v4u __attribute__((ext_vector_type(4)));
typedef float f32x4 __attribute__((ext_vector_type(4)));
typedef float f32x2 __attribute__((ext_vector_type(2)));
typedef GAS unsigned gu32;
#define RLX_AGENT __ATOMIC_RELAXED, __HIP_MEMORY_SCOPE_AGENT
#define LDS_WAIT() asm volatile("s_waitcnt lgkmcnt(0)" ::: "memory")
__device__ __forceinline__ unsigned f2bf(float f) { unsigned u = __builtin_bit_cast(unsigned, f); return (u + 0x7fffu + ((u >> 16) & 1u)) >> 16; }
__device__ __forceinline__ unsigned pk2(float lo, float hi) { return f2bf(lo) | (f2bf(hi) << 16); }

#define XB_TMO      128
#define XB_XCNT(j)  (256  + 64 * (j))
#define XB_XSUB(j)  (1280 + 64 * (j))
#define XB_XGEN(j)  (2304 + 64 * (j))
#define XB_TOP      3328
#define XB_TOPGEN   3392
#define XCD_BAR_WORDS 3456
#define XB_SPIN_CAP (1u << 18)

__device__ __forceinline__ unsigned xb_ld(unsigned* p)              { return __hip_atomic_load(p, __ATOMIC_RELAXED, __HIP_MEMORY_SCOPE_AGENT); }
__device__ __forceinline__ unsigned xb_add(unsigned* p, unsigned v) { return __hip_atomic_fetch_add(p, v, __ATOMIC_RELAXED, __HIP_MEMORY_SCOPE_AGENT); }
__device__ __forceinline__ unsigned xb_xcc_id() { return (unsigned)__builtin_amdgcn_s_getreg((3 << 11) | 20) & 0xFu; }
#define XB_SPIN(cond, bar) do { unsigned _sp = 0; while (cond) { __builtin_amdgcn_s_sleep(1); \
    if ((++_sp & 255u) == 0u) { if (xb_ld(&(bar)[XB_TMO])) break; if (_sp > XB_SPIN_CAP) { atomicAdd(&(bar)[XB_TMO], 1u); break; } } } } while (0)

struct XcdBarrier {
    unsigned* bar; unsigned x; unsigned G;
    volatile LAS unsigned* st;
};

__device__ __forceinline__ XcdBarrier xcd_barrier_post(unsigned* bar, volatile LAS unsigned* st, unsigned G) {
    XcdBarrier b; b.bar = bar; b.x = xb_xcc_id(); b.st = st; b.G = G;
    if (threadIdx.x == 0) (void)xb_add(&bar[XB_XCNT(b.x)], 1u);
    return b;
}
__device__ __forceinline__ void xcd_barrier_complete(unsigned* bar, unsigned x, unsigned& nloc, unsigned& nx, const unsigned G) {
    unsigned sum, cnt, mine, sp = 0u;
    for (;;) {
        sum = 0u; cnt = 0u; mine = 0u;
#pragma unroll
        for (unsigned j = 0; j < 16; ++j) { const unsigned c = xb_ld(&bar[XB_XCNT(j)]); sum += c; cnt += (c > 0u) ? 1u : 0u; mine = (j == x) ? c : mine; }
        if (sum == G) break;
        __builtin_amdgcn_s_sleep(1);
        if ((++sp & 255u) == 0u) { if (xb_ld(&bar[XB_TMO])) break; if (sp > XB_SPIN_CAP) { atomicAdd(&bar[XB_TMO], 1u); break; } }
    }
    nloc = mine > 0u ? mine : 1u; nx = cnt > 0u ? cnt : 1u;
}

__device__ __forceinline__ void xcd_barrier(const XcdBarrier& b) {
    asm volatile("s_waitcnt vmcnt(0)" ::: "memory");
    __syncthreads();
    if (threadIdx.x == 0) {
        unsigned* bar = b.bar;
        __builtin_amdgcn_s_waitcnt(0);
        unsigned nloc = b.st[0], nx = b.st[1];
        if (nloc == 0u) { xcd_barrier_complete(bar, b.x, nloc, nx, b.G); b.st[0] = nloc; b.st[1] = nx; }
        const unsigned old = xb_add(&bar[XB_XSUB(b.x)], 1u);
        const unsigned gen = old / nloc;
        if (old + 1u == (gen + 1u) * nloc) {
            __builtin_amdgcn_fence(__ATOMIC_RELEASE, "agent");
            asm volatile("s_waitcnt vmcnt(0)" ::: "memory");
            const unsigned og = xb_add(&bar[XB_TOP], 1u);
            const unsigned tg = og / nx;
            if (og + 1u == (tg + 1u) * nx) xb_add(&bar[XB_TOPGEN], 1u);
            else XB_SPIN(xb_ld(&bar[XB_TOPGEN]) == tg, bar);
            __builtin_amdgcn_fence(__ATOMIC_ACQUIRE, "agent");
            xb_add(&bar[XB_XGEN(b.x)], 1u);
            asm volatile("s_waitcnt vmcnt(0)" ::: "memory");
        } else {
            XB_SPIN(xb_ld(&bar[XB_XGEN(b.x)]) == gen, bar);
            __builtin_amdgcn_fence(__ATOMIC_ACQUIRE, "agent");
            asm volatile("s_waitcnt vmcnt(0)" ::: "memory");
        }
    }
    __syncthreads();
}
template <int I> __device__ __forceinline__ const float* kin() {
    const __attribute__((address_space(4))) volatile unsigned long long* kp = (const __attribute__((address_space(4))) volatile unsigned long long*)__builtin_amdgcn_kernarg_segment_ptr();
    const unsigned long long v = kp[I];
    return (const float*)(GAS const float*)v;
}
enum InIdx { I_X = 0, I_MIXN, I_FFNN, I_POOLW, I_POOLS, I_KVN, I_WK, I_WV, I_WF, I_BF, I_WQ, I_WO, I_RG, I_RGB, I_RE, I_REB, I_WGATE, I_WUP, I_WDOWN, I_FINN };
struct Frame {
    LAS unsigned char* lds;
    volatile LAS unsigned* MISC;
    int tid, lane, wave;
    int vcu, G;
    int half;
    float* out;
    unsigned char* ws;
#define WSP(name, T, OFF) __device__ __forceinline__ T* name() const { return (T*)(ws + (OFF)); }
#define WSH(name, T, OFF, PERHALF) __device__ __forceinline__ T* name() const { return (T*)(ws + (OFF)) + (size_t)half * (PERHALF); }
    WSP(WPOOL, bf16, WS_WPOOL) WSP(WQKV, bf16, WS_WQKV) WSP(WO, bf16, WS_WO) WSP(WG, bf16, WS_WG) WSP(WU, bf16, WS_WU) WSP(WD, bf16, WS_WD)
    WSH(XN, bf16, WS_XN, (size_t)MH * D) WSH(QO, bf16, WS_QO, (size_t)MH * D) WSH(KB, bf16, WS_K, (size_t)MH * D) WSH(VB, bf16, WS_V, (size_t)MH * D) WSH(HMID, bf16, WS_HMID, (size_t)HROWS * 512)
    WSH(TOKROW, int, WS_TOKROW2, (size_t)NBUCKET * BCAP) WSH(GATEROW, float, WS_GATEROW2, (size_t)NBUCKET * BCAP * 2)
    WSH(BLKSUM, float, WS_BLKSUM, NBLK * 16) WSP(RWG, float, WS_RWG) WSP(WFG, float, WS_WFG) WSH(LF, float, WS_LF, (size_t)MH * 16) WSH(FM, float, WS_FM, (size_t)BH * H * T) WSP(TRASH, bf16, WS_TRASH)
    WSH(DPOOL, bf16, WS_DPOOL, (size_t)MH * D) WSH(Y0, bf16, WS_Y0, (size_t)MH * D) WSH(DATT, bf16, WS_V, (size_t)MH * D) WSH(Y1, bf16, WS_QO, (size_t)MH * D) WSH(H3B, bf16, WS_K, (size_t)MH * D)
    __device__ __forceinline__ const float* X() const { return kin<I_X>() + (size_t)half * MH * D; }
#undef WSH
#undef WSP
};

__device__ __forceinline__ float dpp_add(float v, const int which) {
    const int x = __float_as_int(v);
    const int r = which == 0 ? __builtin_amdgcn_mov_dpp(x, 0xB1, 0xf, 0xf, true) : which == 1 ? __builtin_amdgcn_mov_dpp(x, 0x4E, 0xf, 0xf, true) : which == 2 ? __builtin_amdgcn_mov_dpp(x, 0x141, 0xf, 0xf, true) : __builtin_amdgcn_mov_dpp(x, 0x140, 0xf, 0xf, true);
    return v + __int_as_float(r);
}
__device__ __forceinline__ float xor16_sum(float v) { const auto r = __builtin_amdgcn_permlane16_swap(__float_as_uint(v), __float_as_uint(v), false, false); return __uint_as_float(r[0]) + __uint_as_float(r[1]); }
__device__ __forceinline__ float xor32_sum(float v) { const auto r = __builtin_amdgcn_permlane32_swap(__float_as_uint(v), __float_as_uint(v), false, false); return __uint_as_float(r[0]) + __uint_as_float(r[1]); }
__device__ __forceinline__ float wave_sum(float v) {
    v = dpp_add(v, 0); v = dpp_add(v, 1); v = dpp_add(v, 2); v = dpp_add(v, 3);
    return xor32_sum(xor16_sum(v));
}
template <int N, int MASK> __device__ __forceinline__ void halve(float (&v)[80], int lane) {
    const bool hi = (lane & MASK) != 0;
#pragma unroll
    for (int k = 0; k < N / 2; ++k) { const float keep = hi ? v[2 * k + 1] : v[2 * k], send = hi ? v[2 * k] : v[2 * k + 1]; v[k] = keep + pg8::xor_lane<MASK>(send); }
}

struct ConvItem { const float* W; bf16* WT; const float* ks; const float* ns; int K, N, item; };
struct ConvLoads { float wv[32]; f32x4 ks0, ks1; float nsv; };
__device__ __forceinline__ void conv_issue(const ConvItem& c, int lane, ConvLoads& L) {
    const int nblk = c.N / 32, kb = c.item / nblk, nb = c.item % nblk, k0 = 64 * kb, n0 = 32 * nb;
    const float* wp = c.W + (size_t)(k0 + (lane >> 5)) * c.N + n0 + (lane & 31);
#pragma unroll
    for (int i = 0; i < 32; ++i) L.wv[i] = wp[(size_t)(2 * i) * c.N];
    L.nsv = c.ns ? c.ns[n0 + (lane & 31)] : 1.0f;
    const int ch = lane & 7;
    if (c.ks) { L.ks0 = *(const f32x4*)(c.ks + k0 + 8 * ch); L.ks1 = *(const f32x4*)(c.ks + k0 + 8 * ch + 4); } else { L.ks0 = (f32x4){1.f, 1.f, 1.f, 1.f}; L.ks1 = L.ks0; }
}
__device__ __forceinline__ void conv_finish(const ConvItem& c, int lane, const ConvLoads& L, LAS float* scr) {
    const int nblk = c.N / 32, kb = c.item / nblk, nb = c.item % nblk, k0 = 64 * kb, n0 = 32 * nb;
#pragma unroll
    for (int i = 0; i < 32; ++i) scr[(2 * i + (lane >> 5)) * 33 + (lane & 31)] = L.wv[i] * L.nsv;
    LDS_WAIT(); asm volatile("" ::: "memory");
    const int ch = lane & 7;
#pragma unroll
    for (int j = 0; j < 4; ++j) { const int n = (lane >> 3) + 8 * j; const LAS float* s = scr + (8 * ch) * 33 + n;
        v4u o; o.x = pg8::cvt_pk_bf16(s[0 * 33] * L.ks0.x, s[1 * 33] * L.ks0.y); o.y = pg8::cvt_pk_bf16(s[2 * 33] * L.ks0.z, s[3 * 33] * L.ks0.w);
        o.z = pg8::cvt_pk_bf16(s[4 * 33] * L.ks1.x, s[5 * 33] * L.ks1.y); o.w = pg8::cvt_pk_bf16(s[6 * 33] * L.ks1.z, s[7 * 33] * L.ks1.w);
        *(v4u*)(c.WT + (size_t)(n0 + n) * c.K + k0 + 8 * ch) = o; }
    LDS_WAIT(); asm volatile("" ::: "memory");
}
template <int W> __device__ __forceinline__ void pool_walk(const float* xb, int t0, int tbeg, const LAS float* invs, bf16* outp) {
    f32x4 ring[16], cur[16], nxt[16];
#pragma unroll
    for (int u = 0; u < 16; ++u) { ring[u] = (f32x4){0.f, 0.f, 0.f, 0.f}; const int t = t0 + tbeg - 16 + u; cur[u] = *(const f32x4*)(xb + (size_t)(t < 0 ? 0 : t) * D); }
    for (int base = -16; base < 64; base += 16) {
        if (base + 16 < 64) {
#pragma unroll
            for (int u = 0; u < 16; ++u) nxt[u] = *(const f32x4*)(xb + (size_t)(t0 + tbeg + base + 16 + u) * D); }
#pragma unroll
        for (int u = 0; u < 16; ++u) {
            const int tt = tbeg + base + u, t = t0 + tt;
            const f32x4 v = cur[u] * invs[tt + 16];
            ring[u] = v;
            if (base >= 0) {
                f32x4 s = v;
#pragma unroll
                for (int j = 1; j < W; ++j) s += ring[(u - j) & 15];
                const float rc = 1.0f / (float)((t + 1 < W) ? (t + 1) : W);
                const f32x4 d = s * rc - v;
                *(unsigned long long*)(outp + (size_t)t * D) = (unsigned long long)pg8::cvt_pk_bf16(d.x, d.y) | ((unsigned long long)pg8::cvt_pk_bf16(d.z, d.w) << 32);
            }
        }
#pragma unroll
        for (int u = 0; u < 16; ++u) cur[u] = nxt[u];
    }
}
__device__ __forceinline__ void p0_pool_diff(Frame& F) {
    LAS float* invs = (LAS float*)(F.lds + RING_OFF);
    for (int blk = F.vcu; blk < NBLK; blk += F.G) {
        const int b = blk >> 6, t0 = (blk & 63) * 128;
        const float* xb = F.X() + (size_t)b * T * D;
        for (int kb = 0; kb < 18; kb += 6) {
            f32x4 v[6][4];
#pragma unroll
            for (int q = 0; q < 6; ++q) { const int t = t0 - 16 + F.wave + 8 * (kb + q); const f32x4* xr = (const f32x4*)(xb + (size_t)(t < 0 ? 0 : t) * D) + F.lane;
#pragma unroll
                for (int j = 0; j < 4; ++j) v[q][j] = xr[64 * j]; }
#pragma unroll
            for (int q = 0; q < 6; ++q) { const int tt = -16 + F.wave + 8 * (kb + q); float s = 0.f;
#pragma unroll
                for (int j = 0; j < 4; ++j) s += (v[q][j].x * v[q][j].x + v[q][j].y * v[q][j].y) + (v[q][j].z * v[q][j].z + v[q][j].w * v[q][j].w);
                const float inv = (t0 + tt >= 0) ? 1.0f / sqrtf(wave_sum(s) * (1.0f / D) + RMS_EPS) : 0.f;
                if (F.lane == 0) invs[tt + 16] = inv; }
        }
        __syncthreads();
        const int tq = F.tid & 255, tbeg = (F.tid >> 8) * 64;
        const float* xt = xb + 4 * tq; bf16* op = F.XN() + (size_t)b * T * D + 4 * tq;
        const int grp = F.wave & 3;
        if (grp == 0) pool_walk<2>(xt, t0, tbeg, invs, op); else if (grp == 1) pool_walk<4>(xt, t0, tbeg, invs, op); else if (grp == 2) pool_walk<8>(xt, t0, tbeg, invs, op); else pool_walk<16>(xt, t0, tbeg, invs, op);
        __syncthreads();
    }
}
constexpr int CONV_EARLY = 4224, CONV_ALL = 14464;
__device__ __forceinline__ ConvItem conv_decode(Frame& F, int it) {
    ConvItem c; int r = it;
    if (r < 128) { const int g = r >> 5; c = ConvItem{kin<I_POOLW>() + g * 65536, F.WPOOL() + g * 65536, kin<I_MIXN>() + g * 256, kin<I_POOLS>() + g * 256, 256, 256, r & 31}; return c; } r -= 128;
    if (r < 4096) { const int up = r >> 11, mat = (r >> 7) & 15;
        c = ConvItem{(up ? kin<I_WUP>() : kin<I_WGATE>()) + (size_t)mat * 262144, (up ? F.WU() : F.WG()) + (size_t)mat * 262144, kin<I_FFNN>(), nullptr, D, DEXP, r & 127}; return c; } r -= 4096;
    if (r < 2048) { const int mat = r >> 7; c = ConvItem{kin<I_WDOWN>() + (size_t)mat * 262144, F.WD() + (size_t)mat * 262144, nullptr, nullptr, DEXP, D, r & 127}; return c; } r -= 2048;
    if (r < 2048) { const int mt = r >> 9;
        const float* W = mt == 0 ? kin<I_WQ>() : mt == 1 ? kin<I_WK>() : mt == 2 ? kin<I_WV>() : kin<I_WO>(); bf16* WT = mt < 3 ? F.WQKV() + (size_t)mt * D * D : F.WO();
        const float* ks = mt == 0 ? kin<I_MIXN>() + D : (mt < 3 ? kin<I_KVN>() : nullptr);
        c = ConvItem{W, WT, ks, nullptr, D, D, r & 511}; return c; } r -= 2048;
    if (r < 4096) { const int up = r >> 11, mat = 16 + ((r >> 7) & 15);
        c = ConvItem{(up ? kin<I_WUP>() : kin<I_WGATE>()) + (size_t)mat * 262144, (up ? F.WU() : F.WG()) + (size_t)mat * 262144, kin<I_FFNN>() + D, nullptr, D, DEXP, r & 127}; return c; } r -= 4096;
    { const int mat = 16 + (r >> 7); c = ConvItem{kin<I_WDOWN>() + (size_t)mat * 262144, F.WD() + (size_t)mat * 262144, nullptr, nullptr, DEXP, D, r & 127}; return c; }
}
__device__ __forceinline__ void p0_convert(Frame& F, int it0, int it1, int gw, int ngw) {
    LAS float* scr = (LAS float*)(F.lds + RING_OFF + 4096 + F.wave * 12288);
    int it = it0 + gw; if (it >= it1) return;
    ConvItem c = conv_decode(F, it); ConvLoads L; conv_issue(c, F.lane, L);
    for (;;) {
        const int itn = it + ngw; const bool more = itn < it1;
        ConvItem cn = c; ConvLoads Ln;
        if (more) { cn = conv_decode(F, itn); conv_issue(cn, F.lane, Ln); }
        conv_finish(c, F.lane, L, scr);
        if (!more) break;
        c = cn; L = Ln; it = itn;
    }
}
__device__ __forceinline__ void p0_small(Frame& F, int gt, int NT) {
    const float* rg = kin<I_RG>(); const float* re = kin<I_RE>(); const float* ffnn = kin<I_FFNN>(); const float* kvn = kin<I_KVN>(); const float* wf = kin<I_WF>();
    float* RWG = F.RWG(); float* WFG = F.WFG();
    for (int i = gt; i < 2 * 20 * D; i += NT) { const int l = i / (20 * D), rem = i % (20 * D), col = rem / D, c = rem % D;
        const float w = col < 4 ? rg[(size_t)(l * D + c) * 4 + col] : re[(size_t)(l * D + c) * 16 + (col - 4)]; RWG[i] = ffnn[l * D + c] * w; }
    for (int i = gt; i < 16 * D; i += NT) { const int h = i / D, c = i % D; WFG[i] = kvn[c] * wf[c * 16 + h]; }
}

struct RowSrc { const float* base; const bf16* d1; const bf16* d2; const bf16* d3; bf16* hwb; };
__device__ __forceinline__ f32x4 bf4_to_f32(unsigned long long w) { const unsigned lo = (unsigned)w, hi = (unsigned)(w >> 32);
    return (f32x4){__uint_as_float(lo << 16), __uint_as_float(lo & 0xffff0000u), __uint_as_float(hi << 16), __uint_as_float(hi & 0xffff0000u)}; }
__device__ __forceinline__ void row_load(const RowSrc& S, size_t row, int lane, f32x4 (&v)[4]) {
    if (S.base) { const f32x4* xr = (const f32x4*)(S.base + row * D) + lane;
#pragma unroll
        for (int j = 0; j < 4; ++j) v[j] = xr[64 * j]; }
    else {
#pragma unroll
        for (int j = 0; j < 4; ++j) v[j] = (f32x4){0.f, 0.f, 0.f, 0.f}; }
    if (S.d1) { const unsigned long long* dr = (const unsigned long long*)(S.d1 + row * D) + lane;
#pragma unroll
        for (int j = 0; j < 4; ++j) v[j] += bf4_to_f32(dr[64 * j]); }
    if (S.d2) { const unsigned long long* dr = (const unsigned long long*)(S.d2 + row * D) + lane;
#pragma unroll
        for (int j = 0; j < 4; ++j) v[j] += bf4_to_f32(dr[64 * j]); }
    if (S.d3) { const unsigned long long* dr = (const unsigned long long*)(S.d3 + row * D) + lane;
#pragma unroll
        for (int j = 0; j < 4; ++j) v[j] += bf4_to_f32(dr[64 * j]); }
    if (S.hwb) { unsigned long long* hr = (unsigned long long*)(S.hwb + row * D) + lane;
#pragma unroll
        for (int j = 0; j < 4; ++j) hr[64 * j] = (unsigned long long)pg8::cvt_pk_bf16(v[j].x, v[j].y) | ((unsigned long long)pg8::cvt_pk_bf16(v[j].z, v[j].w) << 32); }
}
__device__ __forceinline__ void rows4_load_norm(Frame& F, const RowSrc& S, int row0, f32x4 (&xv)[4][4], float (&inv)[4]) {
#pragma unroll
    for (int r = 0; r < 4; ++r) row_load(S, (size_t)(row0 + r), F.lane, xv[r]);
#pragma unroll
    for (int r = 0; r < 4; ++r) { float s = 0.f;
#pragma unroll
        for (int j = 0; j < 4; ++j) s += (xv[r][j].x * xv[r][j].x + xv[r][j].y * xv[r][j].y) + (xv[r][j].z * xv[r][j].z + xv[r][j].w * xv[r][j].w);
        inv[r] = 1.0f / sqrtf(wave_sum(s) * (1.0f / D) + RMS_EPS); }
#pragma unroll
    for (int r = 0; r < 4; ++r) { unsigned long long* o8 = (unsigned long long*)(F.XN() + (size_t)(row0 + r) * D) + F.lane;
#pragma unroll
        for (int j = 0; j < 4; ++j) o8[64 * j] = (unsigned long long)pg8::cvt_pk_bf16(xv[r][j].x * inv[r], xv[r][j].y * inv[r]) | ((unsigned long long)pg8::cvt_pk_bf16(xv[r][j].z * inv[r], xv[r][j].w * inv[r]) << 32); }
}
template <int NCOL> __device__ __forceinline__ void rows4_dots(const LAS float* Wl, int lane, const f32x4 (&xv)[4][4], float (&acc)[80]) {
#pragma unroll
    for (int j = 0; j < 4; ++j)
#pragma unroll
        for (int col = 0; col < NCOL; ++col) { const f32x4 w = ((const LAS f32x4*)(Wl + col * D))[lane + 64 * j];
#pragma unroll
            for (int r = 0; r < 4; ++r) { float a = acc[4 * col + r]; a = __builtin_fmaf(xv[r][j].x, w.x, a); a = __builtin_fmaf(xv[r][j].y, w.y, a); a = __builtin_fmaf(xv[r][j].z, w.z, a); a = __builtin_fmaf(xv[r][j].w, w.w, a); acc[4 * col + r] = a; }
            if ((col & 3) == 3) __builtin_amdgcn_sched_barrier(0); }
}
__device__ __forceinline__ void row_router_phase(Frame& F, int l, const RowSrc& RS, unsigned* cnt) {
    LAS float* Wl = (LAS float*)(F.lds + RING_OFF);
    LAS float* sc = (LAS float*)(F.lds + RING_OFF + 81920);
    LAS int* hl = (LAS int*)(F.lds + RING_OFF + 81920 + 4096);
    LAS int* tb = hl + 64;
    LAS float* tg = (LAS float*)(tb + 128);
    { const f32x4* rw = (const f32x4*)(F.RWG() + (size_t)l * 20 * D) + F.tid; f32x4 t[10];
#pragma unroll
      for (int i = 0; i < 10; ++i) t[i] = rw[i * NWAVES * 64];
#pragma unroll
      for (int i = 0; i < 10; ++i) ((LAS f32x4*)Wl)[F.tid + i * NWAVES * 64] = t[i]; }
    const float* gb = kin<I_RGB>() + l * 4; const float* eb = kin<I_REB>() + l * 16;
    for (int blk = F.vcu; blk < NBLK; blk += F.G) {
        if (F.tid < 32) hl[F.tid] = 0;
        __syncthreads();
        for (int pass = 0; pass < 4; ++pass) {
            asm volatile("" ::: "memory");
            const int row0 = blk * 128 + F.wave * 16 + pass * 4;
            f32x4 xv[4][4]; float inv[4];
            rows4_load_norm(F, RS, row0, xv, inv);
            LAS float* sw = sc + F.wave * 80;
            float acc[80];
#pragma unroll
            for (int i = 0; i < 16; ++i) acc[i] = 0.f;
            rows4_dots<4>(Wl, F.lane, xv, acc);
            halve<16, 1>(acc, F.lane); halve<8, 2>(acc, F.lane); halve<4, 4>(acc, F.lane); halve<2, 8>(acc, F.lane);
            acc[0] = xor32_sum(xor16_sum(acc[0]));
            { const int p = F.lane & 15, r = p & 3, c = p >> 2; const float iv = r == 0 ? inv[0] : r == 1 ? inv[1] : r == 2 ? inv[2] : inv[3];
              if (F.lane < 16) sw[r * 8 + c] = acc[0] * iv + gb[c]; }
            LDS_WAIT(); asm volatile("" ::: "memory");
            int gsel[4];
#pragma unroll
            for (int r = 0; r < 4; ++r) { const f32x4 g = *(const LAS f32x4*)(sw + r * 8); int gi = 0; float gm = g.x; if (g.y > gm) { gm = g.y; gi = 1; } if (g.z > gm) { gm = g.z; gi = 2; } if (g.w > gm) { gm = g.w; gi = 3; }
                gsel[r] = __builtin_amdgcn_readfirstlane(gi); }
#pragma unroll
            for (int i = 0; i < 16; ++i) acc[i] = 0.f;
#pragma unroll
            for (int j = 0; j < 4; ++j)
#pragma unroll
                for (int r = 0; r < 4; ++r) {
#pragma unroll
                    for (int c = 0; c < 4; ++c) { const f32x4 w = ((const LAS f32x4*)(Wl + (4 + 4 * gsel[r] + c) * D))[F.lane + 64 * j];
                        float a = acc[4 * c + r]; a = __builtin_fmaf(xv[r][j].x, w.x, a); a = __builtin_fmaf(xv[r][j].y, w.y, a); a = __builtin_fmaf(xv[r][j].z, w.z, a); a = __builtin_fmaf(xv[r][j].w, w.w, a); acc[4 * c + r] = a; }
                    __builtin_amdgcn_sched_barrier(0); }
            halve<16, 1>(acc, F.lane); halve<8, 2>(acc, F.lane); halve<4, 4>(acc, F.lane); halve<2, 8>(acc, F.lane);
            acc[0] = xor32_sum(xor16_sum(acc[0]));
            if (F.lane < 16) sw[(F.lane & 3) * 8 + 4 + (F.lane >> 2)] = acc[0];
            LDS_WAIT(); asm volatile("" ::: "memory");
            if (F.lane < 4) {
                const int r = F.lane; const LAS float* sr = sw + r * 8;
                const float iv = r == 0 ? inv[0] : r == 1 ? inv[1] : r == 2 ? inv[2] : inv[3];
                const float g0 = sr[0], g1 = sr[1], g2 = sr[2], g3 = sr[3];
                int gi = 0; float gm = g0; if (g1 > gm) { gm = g1; gi = 1; } if (g2 > gm) { gm = g2; gi = 2; } if (g3 > gm) { gm = g3; gi = 3; }
                const float gwt = 1.0f / (expf(g0 - gm) + expf(g1 - gm) + expf(g2 - gm) + expf(g3 - gm));
                const LAS float* se = sr + 4; const float* ebg = eb + gi * 4;
                const float e0 = se[0] * iv + ebg[0], e1 = se[1] * iv + ebg[1], e2 = se[2] * iv + ebg[2], e3 = se[3] * iv + ebg[3];
                int i1 = 0; float v1 = e0; if (e1 > v1) { v1 = e1; i1 = 1; } if (e2 > v1) { v1 = e2; i1 = 2; } if (e3 > v1) { v1 = e3; i1 = 3; }
                int i2 = -1; float v2 = -INFINITY;
                if (i1 != 0 && e0 > v2) { v2 = e0; i2 = 0; } if (i1 != 1 && e1 > v2) { v2 = e1; i2 = 1; } if (i1 != 2 && e2 > v2) { v2 = e2; i2 = 2; } if (i1 != 3 && e3 > v2) { v2 = e3; i2 = 3; }
                const float p1 = 1.0f / (1.0f + expf(v2 - v1)), p2 = 1.0f - p1;
                const int lo = i1 < i2 ? i1 : i2, hi = i1 < i2 ? i2 : i1;
                const float wlo = (i1 < i2 ? p1 : p2) * gwt, whi = (i1 < i2 ? p2 : p1) * gwt;
                const int pidx = lo == 0 ? hi - 1 : (lo == 1 ? hi + 1 : 5);
                const int bucket = gi * 6 + pidx, tok = row0 + r;
                const int rank = __hip_atomic_fetch_add(hl + bucket, 1, __ATOMIC_RELAXED, __HIP_MEMORY_SCOPE_WORKGROUP);
                const int ti = tok - blk * 128; tb[ti] = bucket | (rank << 8); tg[2 * ti] = wlo; tg[2 * ti + 1] = whi;
            }
        }
        __syncthreads();
        if (F.tid < NBUCKET) { const int n = hl[F.tid]; hl[32 + F.tid] = n ? (int)__hip_atomic_fetch_add(cnt + F.tid, (unsigned)n, RLX_AGENT) : 0; }
        __syncthreads();
        if (F.tid < 128) { const int v = tb[F.tid], b = v & 0xff, pos = b * BCAP + hl[32 + b] + (v >> 8);
            F.TOKROW()[pos] = blk * 128 + F.tid; *(f32x2*)(F.GATEROW() + 2 * (size_t)pos) = (f32x2){tg[2 * F.tid], tg[2 * F.tid + 1]}; }
        __syncthreads();
    }
}
__device__ __forceinline__ void row_forget_phase(Frame& F, const RowSrc& RS) {
    LAS float* Wl = (LAS float*)(F.lds + RING_OFF);
    LAS float* wsum = (LAS float*)(F.lds + RING_OFF + 81920);
    { const f32x4* rw = (const f32x4*)F.WFG() + F.tid; f32x4 t[8];
#pragma unroll
      for (int i = 0; i < 8; ++i) t[i] = rw[i * NWAVES * 64];
#pragma unroll
      for (int i = 0; i < 8; ++i) ((LAS f32x4*)Wl)[F.tid + i * NWAVES * 64] = t[i]; }
    __syncthreads();
    const int h = F.lane >> 2, r = F.lane & 3; const float bfh = kin<I_BF>()[h];
    for (int blk = F.vcu; blk < NBLK; blk += F.G) {
        float bsum = 0.f;
        for (int pass = 0; pass < 4; ++pass) {
            asm volatile("" ::: "memory");
            const int row0 = blk * 128 + F.wave * 16 + pass * 4;
            f32x4 xv[4][4]; float inv[4];
            rows4_load_norm(F, RS, row0, xv, inv);
            float acc[80];
#pragma unroll
            for (int i = 0; i < 80; ++i) acc[i] = 0.f;
            rows4_dots<16>(Wl, F.lane, xv, acc);
            halve<64, 1>(acc, F.lane); halve<32, 2>(acc, F.lane); halve<16, 4>(acc, F.lane); halve<8, 8>(acc, F.lane); halve<4, 16>(acc, F.lane); halve<2, 32>(acc, F.lane);
            const float iv = r == 0 ? inv[0] : r == 1 ? inv[1] : r == 2 ? inv[2] : inv[3];
            const float z = acc[0] * iv + bfh;
            const float lf = fminf(z, 0.f) - log1pf(expf(-fabsf(z)));
            F.LF()[(size_t)(row0 + r) * 16 + h] = lf; bsum += lf;
        }
        bsum += pg8::xor_lane<1>(bsum); bsum += pg8::xor_lane<2>(bsum);
        if (r == 0) wsum[F.wave * 16 + h] = bsum;
        __syncthreads();
        if (F.tid < 16) { float s = 0.f;
#pragma unroll
            for (int w = 0; w < NWAVES; ++w) s += wsum[w * 16 + F.tid];
            F.BLKSUM()[blk * 16 + F.tid] = s; }
        __syncthreads();
    }
}
__device__ __forceinline__ void final_norm_phase(Frame& F, const RowSrc& RS, float* dst) {
    const int gw = F.vcu * NWAVES + F.wave, NGW = F.G * NWAVES;
    f32x4 g[4];
#pragma unroll
    for (int j = 0; j < 4; ++j) g[j] = ((const f32x4*)kin<I_FINN>())[F.lane + 64 * j];
    for (int m0 = gw * 4; m0 < MH; m0 += NGW * 4) {
        f32x4 v[4][4]; float inv[4];
#pragma unroll
        for (int r = 0; r < 4; ++r) row_load(RS, (size_t)(m0 + r), F.lane, v[r]);
#pragma unroll
        for (int r = 0; r < 4; ++r) { float s = 0.f;
#pragma unroll
            for (int j = 0; j < 4; ++j) s += (v[r][j].x * v[r][j].x + v[r][j].y * v[r][j].y) + (v[r][j].z * v[r][j].z + v[r][j].w * v[r][j].w);
            inv[r] = 1.0f / sqrtf(wave_sum(s) * (1.0f / D) + RMS_EPS); }
#pragma unroll
        for (int r = 0; r < 4; ++r)
#pragma unroll
            for (int j = 0; j < 4; ++j) ((f32x4*)(dst + (size_t)(m0 + r) * D) + F.lane)[64 * j] = v[r][j] * inv[r] * g[j];
    }
}
__device__ __forceinline__ void build_tile_table(Frame& F, const unsigned* cnt) {
    LAS int* tbl = (LAS int*)(F.lds + TBL_OFF);
    LAS int* cn = (LAS int*)(F.lds + RING_OFF);
    if (F.tid < NBUCKET) cn[F.tid] = (int)__hip_atomic_load(cnt + F.tid, RLX_AGENT);
    __syncthreads();
    if (F.tid == 0) { int ntl = 0; for (int b = 0; b < NBUCKET; ++b) { cn[32 + b] = ntl; ntl += (cn[b] + 255) >> 8; } tbl[0] = ntl < MAXTILES ? ntl : MAXTILES; }
    __syncthreads();
    if (F.tid < NBUCKET) { const int b = F.tid, g = b / 6, p = b % 6, lo = p < 3 ? 0 : (p < 5 ? 1 : 2), hi = p < 3 ? p + 1 : (p < 5 ? p - 1 : 3), n = cn[b]; int t = cn[32 + b];
        for (int k = 0; k * 256 < n && t < MAXTILES; ++k, ++t) { tbl[1 + 3 * t] = (g * 4 + lo) | ((g * 4 + hi) << 8); tbl[2 + 3 * t] = (n - 256 * k) < 256 ? (n - 256 * k) : 256; tbl[3 + 3 * t] = b * BCAP + 256 * k; } }
    __syncthreads();
}
__device__ __forceinline__ void fscan_phase(Frame& F) {
    LAS float* bs = (LAS float*)(F.lds + RING_OFF);
    LAS float* sg = bs + 16;
    for (int blk = F.vcu; blk < NBLK; blk += F.G) {
        const int b = blk >> 6, first = b * 64, tid = F.tid;
        { LAS float* ps = sg + 128;
          for (int i = tid; i < 64 * 16; i += NWAVES * 64) { const int j = first + (i >> 4); ps[i] = j < blk ? F.BLKSUM()[j * 16 + (i & 15)] : 0.f; }
          __syncthreads();
          if (tid < 16) { float s = 0.f; for (int j = 0; j < 64; ++j) s += ps[j * 16 + tid]; bs[tid] = s; } }
        const int h = tid & 15, seg = tid >> 4;
        float v[16];
        if (tid < 128) { float s = 0.f;
#pragma unroll
            for (int k = 0; k < 16; ++k) { v[k] = F.LF()[(size_t)(blk * 128 + seg * 16 + k) * 16 + h]; s += v[k]; }
            sg[seg * 16 + h] = s; }
        __syncthreads();
        if (tid < 128) { float run = bs[h]; for (int s2 = 0; s2 < seg; ++s2) run += sg[s2 * 16 + h];
            float* fo = F.FM() + (size_t)(b * 16 + h) * T + (blk & 63) * 128 + seg * 16;
#pragma unroll
            for (int k = 0; k < 16; ++k) { run += v[k]; fo[k] = run; } }
        __syncthreads();
    }
}
struct Args { const float* in[20]; float* out; unsigned char* ws; };
__global__ void __launch_bounds__(NWAVES * 64, 2) yoco_fwd(Args args) {
    extern __shared__ __attribute__((aligned(16))) unsigned char lds[];
    Frame F;
    F.lds = (LAS unsigned char*)lds;
    F.MISC = (volatile LAS unsigned*)(F.lds + MISC_OFF);
    F.tid = threadIdx.x; F.lane = F.tid & 63; F.wave = __builtin_amdgcn_readfirstlane(F.tid >> 6);
    const int GA = gridDim.x, bx = blockIdx.x, li = bx >> 1;
    F.half = bx & 1; F.G = GA >> 1; F.vcu = (F.G % 4 == 0) ? (li % 4) * (F.G / 4) + li / 4 : li;
    unsigned char* ws = args.ws;
    F.ws = ws; F.out = args.out + (size_t)F.half * MH * D;
    gu32* const ctl = (gu32*)(ws + WS_CTL);
    { int t0 = threadIdx.x; asm volatile("" : "+v"(t0));
      for (int u = t0; u < (LDS_BYTES - LDSCTL_OFF) / 4; u += NWAVES * 64) ((LAS unsigned*)(F.lds + LDSCTL_OFF))[u] = 0u; }
    __syncthreads();
    const XcdBarrier barAll = xcd_barrier_post((unsigned*)(ctl + CW_BAR), F.MISC + 8, (unsigned)GA);
    const XcdBarrier bar = xcd_barrier_post((unsigned*)(ctl + CW_BARH) + F.half * XCD_BAR_WORDS, F.MISC + 12, (unsigned)F.G);
    unsigned* const cnt0 = (unsigned*)(ctl + CW_CNT + 64 * (2 * F.half)); unsigned* const cnt1 = cnt0 + 64;
    unsigned* const nq = (unsigned*)(ctl + CW_NRM) + F.half * 2048; unsigned* const nk = (unsigned*)(ctl + CW_NRM) + 4096 + F.half * 64;

#ifndef PH_MASK
#define PH_MASK 0x7fff
#endif
#define IN(k) ((PH_MASK >> (k)) & 1)
#define RETID() Frame Fq = F; { int t_ = threadIdx.x; asm volatile("" : "+v"(t_)); Fq.tid = t_; Fq.lane = t_ & 63; }
#define SEAM(k) do { xcd_barrier(bar); } while (0)
    PG8_LAS unsigned char* ring = F.lds + RING_OFF;

    if (IN(0)) { RETID();
        p0_convert(Fq, 0, CONV_EARLY, bx * NWAVES + Fq.wave, GA * NWAVES);
        p0_small(Fq, bx * (NWAVES * 64) + Fq.tid, GA * NWAVES * 64);
        xcd_barrier(barAll);
        if (Fq.half == 1) {
            p0_convert(Fq, CONV_EARLY, CONV_ALL, li * NWAVES + Fq.wave, Fq.G * NWAVES);
            asm volatile("s_waitcnt vmcnt(0)" ::: "memory"); __syncthreads();
            if (Fq.tid == 0) { __builtin_amdgcn_fence(__ATOMIC_RELEASE, "agent"); asm volatile("s_waitcnt vmcnt(0)" ::: "memory"); __hip_atomic_fetch_add((unsigned*)(ctl + CW_CONV), 1u, RLX_AGENT); }
        }
        p0_pool_diff(Fq);
#ifdef SKEW_TICKS
        if (Fq.half == 1) { const unsigned long long t0_ = __builtin_amdgcn_s_memrealtime(); while (__builtin_amdgcn_s_memrealtime() - t0_ < SKEW_TICKS) __builtin_amdgcn_s_sleep(10); }
#endif
    } SEAM(0);

    if (IN(1)) { RETID();
        pg8::StaticOrder S; S.init(MH, D, Fq.G, li, 4);
        pg8::AdRow ad{(const char*)Fq.XN(), (const char*)Fq.WPOOL(), D, 256, 256};
        pg8::EpiBf16 E{Fq.DPOOL(), D, 0, 0, 1.f, nullptr, nullptr};
        pg8::gemm_phase<pg8::EpiBf16, pg8::StaticOrder, pg8::AdRow, true>(ring, 4, S, E, ad);
    } SEAM(1);

    if (IN(2)) { RETID(); const RowSrc RS{Fq.X(), Fq.DPOOL(), nullptr, nullptr, nullptr}; row_router_phase(Fq, 0, RS, cnt0); } SEAM(2);
    if (IN(4)) { RETID();
        build_tile_table(Fq, cnt0);
        pg8::MoeOrder S{(const PG8_LAS int*)(Fq.lds + TBL_OFF), Fq.G, Fq.vcu};
        pg8::AdMoeUp ad{(const char*)Fq.XN(), Fq.TOKROW(), (const char*)Fq.WG(), (const char*)Fq.WU(), D, D};
        pg8::EpiMoeH E{Fq.HMID(), Fq.GATEROW()};
        pg8::gemm_phase<pg8::EpiMoeH, pg8::MoeOrder, pg8::AdMoeUp, true>(ring, 16, S, E, ad);
    } SEAM(4);
    if (F.half == 0) {
        if (F.tid == 0) { unsigned sp = 0; while (__hip_atomic_load((unsigned*)(ctl + CW_CONV), RLX_AGENT) < (unsigned)F.G) { __builtin_amdgcn_s_sleep(2); if (++sp > (1u << 22)) break; }
            __builtin_amdgcn_fence(__ATOMIC_ACQUIRE, "agent"); asm volatile("s_waitcnt vmcnt(0)" ::: "memory"); }
        __syncthreads();
    }
    if (IN(5)) { RETID();
        build_tile_table(Fq, cnt0);
        pg8::MoeOrder S{(const PG8_LAS int*)(Fq.lds + TBL_OFF), Fq.G, Fq.vcu};
        pg8::AdMoeDown ad{(const char*)Fq.HMID(), (const char*)Fq.WD(), 512, 256};
        pg8::EpiMoeOutBf16 E{Fq.Y0(), Fq.TOKROW(), Fq.TRASH()};
        pg8::gemm_phase<pg8::EpiMoeOutBf16, pg8::MoeOrder, pg8::AdMoeDown, true>(ring, 8, S, E, ad);
    } SEAM(5);

    if (IN(6)) { RETID(); const RowSrc RS{Fq.X(), Fq.DPOOL(), Fq.Y0(), nullptr, nullptr}; row_forget_phase(Fq, RS); } SEAM(6);
    if (IN(7)) { RETID();
        fscan_phase(Fq);
        pg8::StaticOrder S; S.init(MH, NQKV, Fq.G, li, 4);
        pg8::AdRow ad{(const char*)Fq.XN(), (const char*)Fq.WQKV(), D, D, 0};
        pg8::EpiBf16 E{Fq.QO(), D, D, (size_t)(WS_K - WS_QO) / 2, attn_body::C2, nq, nk};
        pg8::gemm_phase<pg8::EpiBf16, pg8::StaticOrder, pg8::AdRow, true>(ring, 16, S, E, ad);
    } SEAM(7);

    if (IN(8)) { RETID();
        static_assert(attn_body::ATTN_LDS_BYTES <= RING_BYTES && attn_body::ATTN_PITCH == D && attn_body::BATCH == BH, "attention body geometry vs frame");
        const attn_body::AttnTensors AT{(const attn_body::bf16*)Fq.QO(), (const attn_body::bf16*)Fq.KB(), (const attn_body::bf16*)Fq.VB(), (attn_body::bf16*)Fq.XN(), Fq.FM(), nq, nk};
        attn_body::attn_phase<>((char*)lds + RING_OFF, AT, (unsigned*)(ctl + CW_ATQ + 64 * Fq.half));
    } SEAM(8);

    if (IN(9)) { RETID();
        pg8::StaticOrder S; S.init(MH, D, Fq.G, li, 4);
        pg8::AdRow ad{(const char*)Fq.XN(), (const char*)Fq.WO(), D, D, 0};
        pg8::EpiBf16 E{Fq.DATT(), D, 0, 0, 1.f, nullptr, nullptr};
        pg8::gemm_phase<pg8::EpiBf16, pg8::StaticOrder, pg8::AdRow, true>(ring, 16, S, E, ad);
    } SEAM(9);

    if (IN(10)) { RETID(); const RowSrc RS{Fq.X(), Fq.DPOOL(), Fq.Y0(), Fq.DATT(), Fq.H3B()}; row_router_phase(Fq, 1, RS, cnt1); } SEAM(10);
    if (IN(12)) { RETID();
        build_tile_table(Fq, cnt1);
        pg8::MoeOrder S{(const PG8_LAS int*)(Fq.lds + TBL_OFF), Fq.G, Fq.vcu};
        pg8::AdMoeUp ad{(const char*)Fq.XN(), Fq.TOKROW(), (const char*)(Fq.WG() + (size_t)NEXP * DEXP * D), (const char*)(Fq.WU() + (size_t)NEXP * DEXP * D), D, D};
        pg8::EpiMoeH E{Fq.HMID(), Fq.GATEROW()};
        pg8::gemm_phase<pg8::EpiMoeH, pg8::MoeOrder, pg8::AdMoeUp, true>(ring, 16, S, E, ad);
    } SEAM(12);
    if (IN(13)) { RETID();
        build_tile_table(Fq, cnt1);
        pg8::MoeOrder S{(const PG8_LAS int*)(Fq.lds + TBL_OFF), Fq.G, Fq.vcu};
        pg8::AdMoeDown ad{(const char*)Fq.HMID(), (const char*)(Fq.WD() + (size_t)NEXP * DEXP * D), 512, 256};
        pg8::EpiMoeOutBf16 E{Fq.Y1(), Fq.TOKROW(), Fq.TRASH()};
        pg8::gemm_phase<pg8::EpiMoeOutBf16, pg8::MoeOrder, pg8::AdMoeDown, true>(ring, 8, S, E, ad);
    } SEAM(13);

    if (IN(14)) { RETID(); const RowSrc RS{nullptr, Fq.H3B(), Fq.Y1(), nullptr, nullptr}; final_norm_phase(Fq, RS, Fq.out); }
#undef IN
#undef SEAM
}

extern "C" void kernel_launch(void* const* d_in, const int* in_sizes, int n_in, void* d_out, int out_size, void* d_ws, size_t ws_size, hipStream_t stream) {
    static int grid = 0;
    if (grid == 0) {
        if (n_in != 20 || in_sizes[0] != M * D || out_size != M * D || ws_size < WS_END) { fprintf(stderr, "kernel_launch: unexpected shapes (n_in %d, in0 %d, out %d, ws %zu); nothing launched\n", n_in, n_in > 0 ? in_sizes[0] : -1, out_size, ws_size); grid = -1; return; }
        int dev = 0, cus = 0, per_cu = 0;
        if (hipGetDevice(&dev) != hipSuccess || hipDeviceGetAttribute(&cus, hipDeviceAttributeMultiprocessorCount, dev) != hipSuccess) { fprintf(stderr, "kernel_launch: hipGetDevice / hipDeviceGetAttribute failed\n"); grid = -1; return; }
        if (hipFuncSetAttribute((const void*)yoco_fwd, hipFuncAttributeMaxDynamicSharedMemorySize, LDS_BYTES) != hipSuccess) { fprintf(stderr, "kernel_launch: hipFuncSetAttribute failed\n"); grid = -1; return; }
        if (hipOccupancyMaxActiveBlocksPerMultiprocessor(&per_cu, (const void*)yoco_fwd, NWAVES * 64, LDS_BYTES) != hipSuccess || per_cu < 1)
            fprintf(stderr, "kernel_launch: note: occupancy query reports %d workgroups per CU\n", per_cu);
        (void)hipGetLastError();
        grid = cus & ~1;
    }
    if (grid < 0) return;
    if (hipMemsetAsync((char*)d_ws + WS_CTL, 0, CTL_ZERO_BYTES, stream) != hipSuccess) { fprintf(stderr, "kernel_launch: hipMemsetAsync failed\n"); return; }
    Args a{};
    for (int i = 0; i < 20; ++i) a.in[i] = (const float*)d_in[i];
    a.out = (float*)d_out; a.ws = (unsigned char*)d_ws;
    hipLaunchKernelGGL(yoco_fwd, dim3(grid), dim3(NWAVES * 64), LDS_BYTES, stream, a);
    const hipError_t le = hipPeekAtLastError();
    if (le != hipSuccess) fprintf(stderr, "kernel_launch: launch failed: %s\n", hipGetErrorName(le));
}
```

```cpp
#include <hip/hip_runtime.h>
#include <hip/hip_bf16.h>
#include <cstdio>
#include <cstdint>
#include <cmath>
namespace pg8 {
#define PG8_LAS __attribute__((address_space(3)))
typedef unsigned short bf16_t;
typedef short bf16x8 __attribute__((ext_vector_type(8)));
typedef float f32x4 __attribute__((ext_vector_type(4)));
typedef unsigned u32x4 __attribute__((ext_vector_type(4)));
constexpr int BM = 256, BK = 64, HALF = 128, HTB = HALF * BK * 2  , STAGE_BYTES = 8 * HTB, NXCD = 8, WGM = 8;

__host__ __device__ __forceinline__ int lds_byte(int r, int c) { const int st = (r >> 4) * 2 + (c >> 5), rr = r & 15, cc = c & 31, ob = rr * 64 + cc * 2; return st * 1024 + (ob ^ (((ob >> 9) & 1) << 5)); }
__host__ __device__ __forceinline__ void stage_rc(int b, int& R, int& C) { const int st = b / 1024, sb = b % 1024, swz = sb ^ (((sb >> 9) & 1) << 5); R = (st >> 1) * 16 + swz / 64; C = (st & 1) * 32 + (swz % 64) / 2; }
__host__ __device__ __forceinline__ int perm32(int rho) { const int n = rho >> 4, i = rho & 15; return 8 * (i >> 2) + 4 * n + (i & 3); }

struct Unit { int pm, pn, x0, x1, x2; };

struct StaticOrder {
    int nM, nN, nwg, G, c, nx;
    __device__ __forceinline__ void init(int M, int N, int G_, int c_, int nx_) { nM = M / BM; nN = N / BM; nwg = nM * nN; G = G_; c = c_; nx = nx_; }
    __device__ __forceinline__ bool next(int i, Unit& u) const {
        const long L = (long)i * G + c; if (L >= nwg) return false;
        int wgid = (int)L; { const int q = nwg / nx, r = nwg % nx, xcd = wgid % nx, off = wgid / nx; wgid = (xcd < r ? xcd * (q + 1) : r * (q + 1) + (xcd - r) * q) + off; }
        const int nig = WGM * nN, gid = wgid / nig, fm = gid * WGM, gsz = (nM - fm) < WGM ? (nM - fm) : WGM;
        u.pm = fm + ((wgid % nig) % gsz); u.pn = (wgid % nig) / gsz; u.x0 = 0; u.x1 = 0; u.x2 = 0; return true;
    }
};
struct MoeOrder {
    const PG8_LAS int* tbl; int G, c;
    __device__ __forceinline__ bool next(int i, Unit& u) const {
        const int L = i * G + c; const int ntl = __builtin_amdgcn_readfirstlane(tbl[0]);
        if (L >= ntl * 4) return false;
        const int rt = L >> 2; u.pm = rt; u.pn = L & 3; u.x0 = __builtin_amdgcn_readfirstlane(tbl[1 + 3 * rt]); u.x1 = __builtin_amdgcn_readfirstlane(tbl[2 + 3 * rt]); u.x2 = __builtin_amdgcn_readfirstlane(tbl[3 + 3 * rt]); return true;
    }
};

struct AdRow {
    static constexpr bool GATHER = false;
    const char* abase; const char* bbase; int lda, ldb, acolpn;
    __device__ __forceinline__ const char* a_ptr(const Unit& u, int h, int kt) const { return abase + ((size_t)(u.pm * BM + h * HALF) * lda + u.pn * acolpn) * 2 + (size_t)kt * (BK * 2); }
    __device__ __forceinline__ void a_offs(const Unit&, const int (&)[2], const int (&)[2], unsigned (&)[2][2]) const {}
    __device__ __forceinline__ const char* b_ptr(const Unit& u, int h, int kt) const { return bbase + (size_t)(u.pn * BM + h * HALF) * ldb * 2 + (size_t)kt * (BK * 2); }
};
struct AdMoeUp {
    static constexpr bool GATHER = true;
    const char* abase; const int* tokrow; const char* wg; const char* wu; int lda, ldb;
    __device__ __forceinline__ const char* a_ptr(const Unit&, int, int kt) const { return abase + (size_t)kt * (BK * 2); }
    __device__ __forceinline__ void a_offs(const Unit& u, const int (&R)[2], const int (&C)[2], unsigned (&v)[2][2]) const {
#pragma unroll
        for (int h = 0; h < 2; ++h)
#pragma unroll
            for (int i = 0; i < 2; ++i) { const int rl = h * HALF + R[i]; const int tok = rl < u.x1 ? tokrow[u.x2 + rl] : 0; v[h][i] = (unsigned)(tok * 1024 + C[i]) * 2u; }
    }
    __device__ __forceinline__ const char* b_ptr(const Unit& u, int h, int kt) const {
        const int e = (u.pn >> 1) ? ((u.x0 >> 8) & 0xff) : (u.x0 & 0xff);
        return (h ? wu : wg) + (size_t)(e * 256 + (u.pn & 1) * HALF) * 1024 * 2 + (size_t)kt * (BK * 2);
    }
};
struct AdMoeDown {
    static constexpr bool GATHER = false;
    const char* abase; const char* wd; int lda, ldb;
    __device__ __forceinline__ const char* a_ptr(const Unit& u, int h, int kt) const { return abase + (size_t)(u.pm * BM + h * HALF) * 512 * 2 + (size_t)kt * (BK * 2); }
    __device__ __forceinline__ void a_offs(const Unit&, const int (&)[2], const int (&)[2], unsigned (&)[2][2]) const {}
    __device__ __forceinline__ const char* b_ptr(const Unit& u, int h, int kt) const {
        const int e = (kt >> 2) ? ((u.x0 >> 8) & 0xff) : (u.x0 & 0xff);
        return wd + (size_t)(e * 1024 + u.pn * BM + h * HALF) * 256 * 2 + (size_t)(kt & 3) * (BK * 2);
    }
};

template <int MASK> __device__ __forceinline__ float xor_lane(float v) {
    const int x = __builtin_bit_cast(int, v); int r;
    if constexpr (MASK == 1) r = __builtin_amdgcn_mov_dpp(x, 0xB1, 0xf, 0xf, true);
    else if constexpr (MASK == 2) r = __builtin_amdgcn_mov_dpp(x, 0x4E, 0xf, 0xf, true);
    else if constexpr (MASK == 4) r = __builtin_amdgcn_mov_dpp(__builtin_amdgcn_mov_dpp(x, 0x141, 0xf, 0xf, true), 0x1B, 0xf, 0xf, true);
    else if constexpr (MASK == 8) r = __builtin_amdgcn_mov_dpp(__builtin_amdgcn_mov_dpp(x, 0x140, 0xf, 0xf, true), 0x141, 0xf, 0xf, true);
    else if constexpr (MASK == 16) { const auto q = __builtin_amdgcn_permlane16_swap((unsigned)x, (unsigned)x, false, false); r = (int)(((threadIdx.x >> 4) & 1) ? q[0] : q[1]); }
    else { const auto q = __builtin_amdgcn_permlane32_swap((unsigned)x, (unsigned)x, false, false); r = (int)(((threadIdx.x >> 5) & 1) ? q[0] : q[1]); }
    return __builtin_bit_cast(float, r);
}
__device__ __forceinline__ unsigned cvt_pk_bf16(float lo, float hi) { unsigned r; asm volatile("v_cvt_pk_bf16_f32 %0, %1, %2" : "=v"(r) : "v"(lo), "v"(hi)); return r; }

struct EpiBf16 {
    static constexpr bool PERM = true;
    bf16_t* O; int ldc; int split_cols; size_t split_stride; float scale0; unsigned* nq; unsigned* nk;
    __device__ __forceinline__ void operator()(const f32x4 (&acc)[2][2][4][2], const Unit& u, int wr, int wc, int fr, int fq) const {
        const int row0 = u.pm * BM + wr * 64 + fr; int colt = u.pn * BM; bf16_t* base = O; int t = 0;
        float sc = 1.f; if (split_cols) { t = colt / split_cols; base += (size_t)t * split_stride; colt -= t * split_cols; if (t == 0) sc = scale0; }
        const int col0 = colt + wc * 32 + 8 * fq;
#pragma unroll
        for (int ai = 0; ai < 2; ++ai)
#pragma unroll
            for (int m = 0; m < 4; ++m) { bf16_t* rowp = base + (size_t)(row0 + ai * HALF + m * 16) * ldc + col0;
#pragma unroll
                for (int bj = 0; bj < 2; ++bj) { f32x4 v0 = acc[ai][bj][m][0] * sc, v1 = acc[ai][bj][m][1] * sc;
                    u32x4 w; w.x = cvt_pk_bf16(v0[0], v0[1]); w.y = cvt_pk_bf16(v0[2], v0[3]); w.z = cvt_pk_bf16(v1[0], v1[1]); w.w = cvt_pk_bf16(v1[2], v1[3]);
                    if (split_cols) *(u32x4*)(rowp + bj * HALF) = w; else __builtin_nontemporal_store(w, (u32x4*)(rowp + bj * HALF)); } }
        if (nq && t < 2) {
#pragma unroll
            for (int bj = 0; bj < 2; ++bj) { float mx = 0.f;
#pragma unroll
                for (int ai = 0; ai < 2; ++ai)
#pragma unroll
                    for (int m = 0; m < 4; ++m) { const f32x4 v0 = acc[ai][bj][m][0] * sc, v1 = acc[ai][bj][m][1] * sc;
                        float s = (v0[0] * v0[0] + v0[1] * v0[1]) + (v0[2] * v0[2] + v0[3] * v0[3]) + (v1[0] * v1[0] + v1[1] * v1[1]) + (v1[2] * v1[2] + v1[3] * v1[3]);
                        { const auto r_ = __builtin_amdgcn_permlane16_swap(__float_as_uint(s), __float_as_uint(s), false, false); s = __uint_as_float(r_[0]) + __uint_as_float(r_[1]); }
                        { const auto r_ = __builtin_amdgcn_permlane32_swap(__float_as_uint(s), __float_as_uint(s), false, false); s = __uint_as_float(r_[0]) + __uint_as_float(r_[1]); }
                        mx = fmaxf(mx, s); }
                mx = fmaxf(mx, xor_lane<1>(mx)); mx = fmaxf(mx, xor_lane<2>(mx)); mx = fmaxf(mx, xor_lane<4>(mx)); mx = fmaxf(mx, xor_lane<8>(mx));
                if (fr == 0 && fq == 0) { const int head = (colt >> 8) * 4 + 2 * bj + (wc >> 1), half = wc & 1;
                    unsigned* p = t == 0 ? nq + ((u.pm * 16 + head) * 2 + half) : nk + (((u.pm >> 5) * 16 + head) * 2 + half);
                    __hip_atomic_fetch_max(p, __float_as_uint(mx), __ATOMIC_RELAXED, __HIP_MEMORY_SCOPE_AGENT); } }
        }
    }
};
struct EpiResF32 {
    static constexpr bool PERM = false;
    const float* base; float* out; int ldc;
    __device__ __forceinline__ void operator()(const f32x4 (&acc)[2][2][4][2], const Unit& u, int wr, int wc, int fr, int fq) const {
        const size_t off0 = (size_t)(u.pm * BM + wr * 64 + fr) * ldc + u.pn * BM + wc * 32 + 4 * fq;
        f32x4 buf[3][4];
#define PG8_RES_LOAD(g) do { const size_t o_ = off0 + (size_t)(((g) >> 2) * HALF + ((g) & 3) * 16) * ldc; _Pragma("unroll") for (int q_ = 0; q_ < 4; ++q_) buf[(g) % 3][q_] = *(const f32x4*)(base + o_ + (q_ >> 1) * HALF + (q_ & 1) * 16); } while (0)
        PG8_RES_LOAD(0); PG8_RES_LOAD(1);
#pragma unroll
        for (int g = 0; g < 8; ++g) {
            if (g + 2 < 8) PG8_RES_LOAD(g + 2);
            const size_t o = off0 + (size_t)((g >> 2) * HALF + (g & 3) * 16) * ldc;
#pragma unroll
            for (int q = 0; q < 4; ++q) *(f32x4*)(out + o + (q >> 1) * HALF + (q & 1) * 16) = buf[g % 3][q] + acc[g >> 2][q >> 1][g & 3][q & 1];
            asm volatile("" ::: "memory");
        }
#undef PG8_RES_LOAD
    }
};
__device__ __forceinline__ float silu_mul(float g, float u) { return g * u * __builtin_amdgcn_rcpf(1.0f + __builtin_amdgcn_exp2f(-1.4426950408889634f * g)); }
struct EpiMoeH {
    static constexpr bool PERM = true;
    bf16_t* H; const float* gaterow;
    __device__ __forceinline__ void operator()(const f32x4 (&acc)[2][2][4][2], const Unit& u, int wr, int wc, int fr, int fq) const {
        const int half = u.pn >> 1, col0 = half * 256 + (u.pn & 1) * HALF + wc * 32 + 8 * fq;
#pragma unroll
        for (int ai = 0; ai < 2; ++ai)
#pragma unroll
            for (int m = 0; m < 4; ++m) { const int rl = ai * HALF + wr * 64 + m * 16 + fr, row = u.pm * BM + rl; const float gw = rl < u.x1 ? gaterow[(size_t)(u.x2 + rl) * 2 + half] : 0.f;
                const f32x4 g0 = acc[ai][0][m][0], g1 = acc[ai][0][m][1], u0 = acc[ai][1][m][0], u1 = acc[ai][1][m][1];
                u32x4 w; w.x = cvt_pk_bf16(silu_mul(g0[0], u0[0]) * gw, silu_mul(g0[1], u0[1]) * gw); w.y = cvt_pk_bf16(silu_mul(g0[2], u0[2]) * gw, silu_mul(g0[3], u0[3]) * gw);
                w.z = cvt_pk_bf16(silu_mul(g1[0], u1[0]) * gw, silu_mul(g1[1], u1[1]) * gw); w.w = cvt_pk_bf16(silu_mul(g1[2], u1[2]) * gw, silu_mul(g1[3], u1[3]) * gw);
                *(u32x4*)(H + (size_t)row * 512 + col0) = w; }
    }
};
struct EpiMoeOutBf16 {
    static constexpr bool PERM = true;
    bf16_t* Y; const int* tokrow; bf16_t* trash;
    __device__ __forceinline__ void operator()(const f32x4 (&acc)[2][2][4][2], const Unit& u, int wr, int wc, int fr, int fq) const {
        const int col0 = u.pn * BM + wc * 32 + 8 * fq, nvalid = u.x1;
#pragma unroll
        for (int ai = 0; ai < 2; ++ai)
#pragma unroll
            for (int m = 0; m < 4; ++m) { const int rl = ai * HALF + wr * 64 + m * 16 + fr; const int tok = rl < nvalid ? tokrow[u.x2 + rl] : 0;
                bf16_t* rowp = (rl < nvalid ? Y + (size_t)tok * 1024 : trash) + col0;
#pragma unroll
                for (int bj = 0; bj < 2; ++bj) { const f32x4 v0 = acc[ai][bj][m][0], v1 = acc[ai][bj][m][1];
                    u32x4 w; w.x = cvt_pk_bf16(v0[0], v0[1]); w.y = cvt_pk_bf16(v0[2], v0[3]); w.z = cvt_pk_bf16(v1[0], v1[1]); w.w = cvt_pk_bf16(v1[2], v1[3]);
                    __builtin_nontemporal_store(w, (u32x4*)(rowp + bj * HALF)); } }
    }
};

template <class Epi, class Sched, class AD, bool ALIGN_EPI>
__device__ __forceinline__ void gemm_phase(PG8_LAS unsigned char* lds, const int nt, const Sched& S, const Epi& E, const AD& ad) {
    int tid = threadIdx.x; asm volatile("" : "+v"(tid));
    const int wid = __builtin_amdgcn_readfirstlane(tid >> 6), lane = tid & 63, wr = wid >> 2, wc = wid & 3, fr = lane & 15, fq = lane >> 4;
    int Rs[2], Cs[2]; unsigned voffA[2], voffB[2];
#pragma unroll
    for (int i = 0; i < 2; ++i) { stage_rc(tid * 16 + i * 8192, Rs[i], Cs[i]); const int Rb = Epi::PERM ? ((Rs[i] & ~31) + perm32(Rs[i] & 31)) : Rs[i];
        voffA[i] = (unsigned)(Rs[i] * ad.lda + Cs[i]) * 2u; voffB[i] = (unsigned)(Rb * ad.ldb + Cs[i]) * 2u; }
    const unsigned ldsw = (unsigned)wid * 1024u;
    const int aoff = lds_byte(wr * 64 + fr, fq * 8), boff = lds_byte(wc * 32 + fr, fq * 8);
#define PG8_SA(b, h) (((b) * 2 + (h)) * HTB)
#define PG8_SB(b, h) ((4 + (b) * 2 + (h)) * HTB)
#define PG8_STAGE(bufoff, gbase, voff) do { _Pragma("unroll") for (int _i = 0; _i < 2; ++_i) \
        __builtin_amdgcn_global_load_lds((const unsigned*)((const char*)(gbase) + (voff)[_i]), (PG8_LAS unsigned*)(lds + (bufoff) + ldsw + _i * 8192), 16, 0, 0); } while (0)
#define PG8_STAGE_A(bufoff, U, h, kt, VG) do { if constexpr (AD::GATHER) PG8_STAGE(bufoff, ad.a_ptr(U, h, kt), (VG)[h]); else PG8_STAGE(bufoff, ad.a_ptr(U, h, kt), voffA); } while (0)
#define PG8_LDA(dst, b, h) do { _Pragma("unroll") for (int m = 0; m < 4; ++m) _Pragma("unroll") for (int k = 0; k < 2; ++k) dst[m][k] = *(const PG8_LAS bf16x8*)(lds + PG8_SA(b, h) + aoff + m * 2048 + k * 1024); } while (0)
#define PG8_LDB(dst, b, h) do { _Pragma("unroll") for (int n = 0; n < 2; ++n) _Pragma("unroll") for (int k = 0; k < 2; ++k) dst[n][k] = *(const PG8_LAS bf16x8*)(lds + PG8_SB(b, h) + boff + n * 2048 + k * 1024); } while (0)
#define PG8_MMA(ai, bj, At, Bt) do { __builtin_amdgcn_s_setprio(1); _Pragma("unroll") for (int m = 0; m < 4; ++m) _Pragma("unroll") for (int n = 0; n < 2; ++n) _Pragma("unroll") for (int k = 0; k < 2; ++k) \
        acc[ai][bj][m][n] = __builtin_amdgcn_mfma_f32_16x16x32_bf16(Bt[n][k], At[m][k], acc[ai][bj][m][n], 0, 0, 0); __builtin_amdgcn_s_setprio(0); } while (0)
#define PG8_WAIT_V(n) asm volatile("s_waitcnt vmcnt(" #n ")" ::: "memory")
#define PG8_WAIT_L(n) asm volatile("s_waitcnt lgkmcnt(" #n ")" ::: "memory")
#define PG8_BAR __builtin_amdgcn_s_barrier()
#define PG8_SCHED __builtin_amdgcn_sched_barrier(0)
    Unit cur, nxt; int ui = 0;
    if (!S.next(0, cur)) return;
    f32x4 acc[2][2][4][2];
#pragma unroll
    for (int a = 0; a < 2; ++a)
#pragma unroll
        for (int b = 0; b < 2; ++b)
#pragma unroll
            for (int m = 0; m < 4; ++m)
#pragma unroll
                for (int n = 0; n < 2; ++n) acc[a][b][m][n] = (f32x4){0.f, 0.f, 0.f, 0.f};
    bf16x8 At[4][2], B0[2][2], B1[2][2];
    unsigned vAc[2][2], vAn[2][2];
    ad.a_offs(cur, Rs, Cs, vAc);
    PG8_STAGE(PG8_SB(0, 0), ad.b_ptr(cur, 0, 0), voffB); PG8_STAGE(PG8_SB(0, 1), ad.b_ptr(cur, 1, 0), voffB); PG8_STAGE_A(PG8_SA(0, 0), cur, 0, 0, vAc); PG8_STAGE_A(PG8_SA(0, 1), cur, 1, 0, vAc);
    if (wr == 1) PG8_BAR;
    PG8_WAIT_V(2); PG8_BAR;
    PG8_STAGE(PG8_SB(1, 0), ad.b_ptr(cur, 0, 1), voffB); PG8_STAGE_A(PG8_SA(1, 0), cur, 0, 1, vAc); PG8_STAGE(PG8_SB(1, 1), ad.b_ptr(cur, 1, 1), voffB);
    PG8_WAIT_V(6); PG8_BAR;
    for (;;) {
        const bool has_next = S.next(ui + 1, nxt);
        if (!has_next) nxt = cur;
        if constexpr (AD::GATHER) {
            if (has_next) ad.a_offs(nxt, Rs, Cs, vAn);
            else {
#pragma unroll
                for (int h = 0; h < 2; ++h)
#pragma unroll
                    for (int i = 0; i < 2; ++i) vAn[h][i] = vAc[h][i]; } }
#pragma clang loop unroll(disable)
        for (int t = 0; t < nt; t += 2) {
            const bool last = (t == nt - 2);
            const Unit u2 = last ? nxt : cur; const int k2 = last ? 0 : t + 2, k3 = k2 + 1;
            unsigned v2[2][2];
            if constexpr (AD::GATHER) {
#pragma unroll
                for (int h = 0; h < 2; ++h)
#pragma unroll
                    for (int i = 0; i < 2; ++i) v2[h][i] = last ? vAn[h][i] : vAc[h][i]; }
            PG8_LDB(B0, 0, 0); PG8_LDB(B1, 0, 1); PG8_SCHED; PG8_LDA(At, 0, 0); PG8_STAGE_A(PG8_SA(1, 1), cur, 1, t + 1, vAc);
            PG8_WAIT_V(8); PG8_WAIT_L(0); PG8_BAR; PG8_MMA(0, 0, At, B0); PG8_MMA(0, 1, At, B1); PG8_BAR; PG8_SCHED;
            PG8_LDA(At, 0, 1); PG8_STAGE(PG8_SB(0, 0), ad.b_ptr(u2, 0, k2), voffB); PG8_STAGE(PG8_SB(0, 1), ad.b_ptr(u2, 1, k2), voffB); PG8_STAGE_A(PG8_SA(0, 0), u2, 0, k2, v2);
            PG8_WAIT_V(8); PG8_WAIT_L(0); PG8_BAR; PG8_MMA(1, 0, At, B0); PG8_MMA(1, 1, At, B1); PG8_BAR; PG8_SCHED;
            PG8_LDB(B0, 1, 0); PG8_LDB(B1, 1, 1); PG8_SCHED; PG8_LDA(At, 1, 0); PG8_STAGE_A(PG8_SA(0, 1), u2, 1, k2, v2);
            PG8_WAIT_V(8); PG8_WAIT_L(0); PG8_BAR; PG8_MMA(0, 0, At, B0); PG8_MMA(0, 1, At, B1); PG8_BAR; PG8_SCHED;
            PG8_LDA(At, 1, 1); PG8_STAGE(PG8_SB(1, 0), ad.b_ptr(u2, 0, k3), voffB); PG8_STAGE(PG8_SB(1, 1), ad.b_ptr(u2, 1, k3), voffB); PG8_STAGE_A(PG8_SA(1, 0), u2, 0, k3, v2);
            PG8_WAIT_V(8); PG8_WAIT_L(0); PG8_BAR; PG8_MMA(1, 0, At, B0); PG8_MMA(1, 1, At, B1); PG8_BAR; PG8_SCHED;
        }
        if constexpr (ALIGN_EPI) { if (wr == 0) PG8_BAR; }
        E(acc, cur, wr, wc, fr, fq);
        if (!has_next) break;
#pragma unroll
        for (int a = 0; a < 2; ++a)
#pragma unroll
            for (int b = 0; b < 2; ++b)
#pragma unroll
                for (int m = 0; m < 4; ++m)
#pragma unroll
                    for (int n = 0; n < 2; ++n) acc[a][b][m][n] = (f32x4){0.f, 0.f, 0.f, 0.f};
        cur = nxt; ++ui;
        if constexpr (AD::GATHER) {
#pragma unroll
            for (int h = 0; h < 2; ++h)
#pragma unroll
                for (int i = 0; i < 2; ++i) vAc[h][i] = vAn[h][i]; }
        if constexpr (ALIGN_EPI) { if (wr == 1) PG8_BAR; }
    }
    PG8_WAIT_V(0);
    if constexpr (!ALIGN_EPI) { if (wr == 0) PG8_BAR; }
    PG8_BAR;
#undef PG8_SA
#undef PG8_SB
#undef PG8_STAGE
#undef PG8_STAGE_A
#undef PG8_LDA
#undef PG8_LDB
#undef PG8_MMA
#undef PG8_WAIT_V
#undef PG8_WAIT_L
#undef PG8_BAR
#undef PG8_SCHED
}
}
namespace attn_body {
using bf16=__hip_bfloat16;
using bf16x8=__attribute__((ext_vector_type(8)))short;
using s16x4=__attribute__((ext_vector_type(4)))short;
using f32x16=__attribute__((ext_vector_type(16)))float;
using f32x2_t=__attribute__((ext_vector_type(2)))float;
using u32x4=__attribute__((ext_vector_type(4)))unsigned;
constexpr int BATCH=2,NHEAD=16,SEQ=8192,D=64,DM=NHEAD*D;
constexpr int NW=8,QBLK=32,QB=QBLK*NW,KVBLK=64,NQB=SEQ/QB;
constexpr int ATTN_PITCH=DM, ATTN_UNIT_ROWS=QB;
__device__ __forceinline__ int crow(int r,int hi){return (r&3)+8*(r>>2)+4*hi;}
#define SBAR() __builtin_amdgcn_sched_barrier(0)
__device__ __forceinline__ void cmask(f32x16&p0,f32x16&p1,int jb,int qrel,int hi){
  const float NEG=-INFINITY; int kb=64*jb+4*hi;
  #pragma unroll
  for(int r=0;r<16;++r){int kv=kb+(r&3)+8*(r>>2); if(kv>qrel)p0[r]=NEG; if(kv+32>qrel)p1[r]=NEG;}
}

constexpr int NSLOT=3, SLOTB=8192;
constexpr int LDS_K=0, LDS_V=NSLOT*SLOTB, LDS_WS=2*NSLOT*SLOTB, LDS_OST=LDS_WS+NW*64*4, LDS_BIAS=LDS_OST+NW*4096, LDS_TKT=LDS_BIAS+SEQ*4, LDS_BYTES=LDS_TKT+16;
constexpr float C2=0.125f*1.4426950408889634f;
__device__ __forceinline__ void glds16(const void*gsrc,unsigned lds_dst){unsigned keep;
  asm volatile("s_mov_b32 %0, m0\n\ts_mov_b32 m0, %2\n\ts_nop 0\n\tglobal_load_lds_dwordx4 %1, off\n\ts_mov_b32 m0, %0":"=&s"(keep):"v"(gsrc),"s"(lds_dst):"memory");}
__device__ __forceinline__ void glds16s(const void*sbase,unsigned voff,unsigned lds_dst){unsigned keep;
  asm volatile("s_mov_b32 %0, m0\n\ts_mov_b32 m0, %3\n\ts_nop 0\n\tglobal_load_lds_dwordx4 %1, %2\n\ts_mov_b32 m0, %0":"=&s"(keep):"v"(voff),"s"(sbase),"s"(lds_dst):"memory");}
__device__ __forceinline__ float max3f(float a,float b,float c){float r;asm("v_max3_f32 %0, %1, %2, %3":"=v"(r):"v"(a),"v"(b),"v"(c));return r;}
__device__ __forceinline__ float max2f(float a,float b){float r;asm("v_max_f32_e32 %0, %1, %2":"=v"(r):"v"(a),"v"(b));return r;}
__device__ __forceinline__ float fadd_s(float a,float b){float r;asm("v_add_f32_e32 %0, %1, %2":"=v"(r):"v"(a),"v"(b));return r;}
__device__ __forceinline__ float fsub_s(float a,float b){float r;asm("v_sub_f32_e32 %0, %1, %2":"=v"(r):"v"(a),"v"(b));return r;}
typedef float f32x2_t __attribute__((ext_vector_type(2))); typedef __bf16 bf16x2_t __attribute__((ext_vector_type(2)));
__device__ __forceinline__ unsigned cvtpk_s(float lo,float hi){f32x2_t v={lo,hi};bf16x2_t b=__builtin_convertvector(v,bf16x2_t);return __builtin_bit_cast(unsigned,b);}
#define WAIT_BAR(N) asm volatile("s_waitcnt vmcnt(" #N ") lgkmcnt(0)\n\ts_barrier":::"memory")

__device__ __forceinline__ void qkt(f32x16&p0,f32x16&p1,const char*Kslot,const bf16x8*qr,const f32x16&negm,int r32,int hi){
  const char*kb=Kslot+hi*1024+r32*16;
  #pragma unroll
  for(int d0=0;d0<4;++d0){
    const bf16x8 b0=*reinterpret_cast<const bf16x8*>(kb+d0*2048);
    const bf16x8 b1=*reinterpret_cast<const bf16x8*>(kb+d0*2048+512);
    if(d0==0){p0=__builtin_amdgcn_mfma_f32_32x32x16_bf16(b0,qr[0],negm,0,0,0);p1=__builtin_amdgcn_mfma_f32_32x32x16_bf16(b1,qr[0],negm,0,0,0);}
    else{p0=__builtin_amdgcn_mfma_f32_32x32x16_bf16(b0,qr[d0],p0,0,0,0);p1=__builtin_amdgcn_mfma_f32_32x32x16_bf16(b1,qr[d0],p1,0,0,0);}}
}
typedef __attribute__((address_space(3))) const char* lds_cptr;
typedef short v4i16_t __attribute__((ext_vector_type(4)));
__device__ __forceinline__ void kload8(bf16x8*kf,lds_cptr kp){
  kf[0]=*(const __attribute__((address_space(3))) bf16x8*)(kp);      kf[1]=*(const __attribute__((address_space(3))) bf16x8*)(kp+512);
  kf[2]=*(const __attribute__((address_space(3))) bf16x8*)(kp+2048); kf[3]=*(const __attribute__((address_space(3))) bf16x8*)(kp+2560);
  kf[4]=*(const __attribute__((address_space(3))) bf16x8*)(kp+4096); kf[5]=*(const __attribute__((address_space(3))) bf16x8*)(kp+4608);
  kf[6]=*(const __attribute__((address_space(3))) bf16x8*)(kp+6144); kf[7]=*(const __attribute__((address_space(3))) bf16x8*)(kp+6656);
}
__device__ __forceinline__ void kload2(bf16x8*kf,lds_cptr kp,int j){ kf[2*j]=*(const __attribute__((address_space(3))) bf16x8*)(kp+j*2048); kf[2*j+1]=*(const __attribute__((address_space(3))) bf16x8*)(kp+j*2048+512); }
__device__ __forceinline__ s16x4 vtr(lds_cptr p){ return __builtin_bit_cast(s16x4,__builtin_amdgcn_ds_read_tr16_b64_v4i16((__attribute__((address_space(3))) v4i16_t*)p)); }
__device__ __forceinline__ float rowmax(const f32x16&p0,const f32x16&p1){
  float a=max3f(p0[0],p0[1],p1[0]),b=max3f(p0[2],p0[3],p1[1]);a=max3f(a,p1[2],p1[3]);
  #pragma unroll
  for(int r=4;r<16;r+=4){a=max3f(a,p0[r],p0[r+1]);b=max3f(b,p0[r+2],p0[r+3]);a=max3f(a,p1[r],p1[r+1]);b=max3f(b,p1[r+2],p1[r+3]);}
  const float m=max2f(a,b);
  auto rr=__builtin_amdgcn_permlane32_swap(__float_as_uint(m),__float_as_uint(m),false,false);
  return max2f(__uint_as_float(rr[0]),__uint_as_float(rr[1]));
}
__device__ __forceinline__ void pv(f32x16*o,int vb,bf16x8 pa0,bf16x8 pa1,bf16x8 pa2,bf16x8 pa3){
  #pragma unroll
  for(int d0=0;d0<2;++d0){s16x4 lo[4],hi[4];
    #pragma unroll
    for(int ks=0;ks<4;++ks){
      asm volatile("ds_read_b64_tr_b16 %0,%1 offset:%c2":"=&v"(lo[ks]):"v"(vb),"i"(d0*4096+ks*1024):"memory");
      asm volatile("ds_read_b64_tr_b16 %0,%1 offset:%c2":"=&v"(hi[ks]):"v"(vb),"i"(d0*4096+ks*1024+512):"memory");}
    asm volatile("s_waitcnt lgkmcnt(0)":::"memory");SBAR();
    #define PK(k) (bf16x8){lo[k][0],lo[k][1],lo[k][2],lo[k][3],hi[k][0],hi[k][1],hi[k][2],hi[k][3]}
    o[d0]=__builtin_amdgcn_mfma_f32_32x32x16_bf16(pa0,PK(0),o[d0],0,0,0);
    o[d0]=__builtin_amdgcn_mfma_f32_32x32x16_bf16(pa1,PK(1),o[d0],0,0,0);
    o[d0]=__builtin_amdgcn_mfma_f32_32x32x16_bf16(pa2,PK(2),o[d0],0,0,0);
    o[d0]=__builtin_amdgcn_mfma_f32_32x32x16_bf16(pa3,PK(3),o[d0],0,0,0);
    #undef PK
  }
}

#ifndef ATTN_STORE16
#define ATTN_STORE16(p,v) (*(u32x4*)(p)=(v))
#endif
template<int THRL> __device__ __forceinline__ void attn_unit(int b,int h,int qb,const bf16*Q,const bf16*__restrict__ K,const bf16*__restrict__ V,bf16*O,const float*Fm,const unsigned*NQ,const unsigned*NK,unsigned*ctr,char*shm){
  int tid=threadIdx.x; asm volatile("":"+v"(tid));
  const int lane=tid&63,r32=lane&31,hi=lane>>5; const int wid=__builtin_amdgcn_readfirstlane(tid>>6);
  const long rowbase=(long)b*SEQ; const int q0=qb*QB;
  typedef __attribute__((address_space(3))) float lds_f32; typedef __attribute__((address_space(3))) const f32x2_t* lds_cf2;
  int t_start; const float*Fh=Fm+(long)(b*NHEAD+h)*SEQ; float fref;
  int tid2=tid; asm volatile("":"+v"(tid2));
  { fref=__hip_atomic_load(Fh+q0,__ATOMIC_RELAXED,__HIP_MEMORY_SCOPE_AGENT);
    const unsigned*nq=NQ+((b*NQB+qb)*NHEAD+h)*2; const unsigned*nk=NK+(b*NHEAD+h)*2;
    const float q2=__uint_as_float(__hip_atomic_load(nq,__ATOMIC_RELAXED,__HIP_MEMORY_SCOPE_AGENT))+__uint_as_float(__hip_atomic_load(nq+1,__ATOMIC_RELAXED,__HIP_MEMORY_SCOPE_AGENT));
    const float k2=__uint_as_float(__hip_atomic_load(nk,__ATOMIC_RELAXED,__HIP_MEMORY_SCOPE_AGENT))+__uint_as_float(__hip_atomic_load(nk+1,__ATOMIC_RELAXED,__HIP_MEMORY_SCOPE_AGENT));
    const float thr=43.3f+2.02f*sqrtf(q2*k2);
    const int NTf=(q0+QB)/KVBLK; int cnt=0;
    _Pragma("unroll") for(int jj=0;jj<2;++jj){ const int j=1+(tid2&63)+64*jj; bool ok=false; if(j<=NTf-4) ok=((fref-Fh[64*j-1])*1.4426950408889634f<=-thr); cnt+=__popcll(__ballot(ok)); }
    t_start=__builtin_amdgcn_readfirstlane(cnt&~1);
  }
  const lds_cf2 bias2=(lds_cf2)((__attribute__((address_space(3))) const char*)shm+LDS_BIAS)+2*hi+t_start*32;
  const bf16*Qw=Q+(rowbase+q0+wid*QBLK)*DM+h*D;
  const bf16*Kh=K+(rowbase+(long)t_start*KVBLK)*DM+h*D,*Vh=V+(rowbase+(long)t_start*KVBLK)*DM+h*D;
  const unsigned lds0=(unsigned)(uintptr_t)shm;
  float*wsf=(float*)(shm+LDS_WS)+wid*64;
  const bf16*ksrc=Kh+wid*8;
  const bf16*vsrc=Vh+(long)(16*(wid&3))*DM+(wid>>2)*32;
  const unsigned kvoff=(unsigned)lane*(DM*2), vvoff=(unsigned)((lane>>2)*DM+(lane&3)*8)*2u;
  const unsigned kdst=lds0+LDS_K+wid*1024, vdst=lds0+LDS_V+wid*1024;
  #define DMA_K(t,slot) glds16s(ksrc+(long)(t)*KVBLK*DM,kvoff,(unsigned)__builtin_amdgcn_readfirstlane(kdst+(slot)))
  #define DMA_V(t,slot) glds16s(vsrc+(long)(t)*KVBLK*DM,vvoff,(unsigned)__builtin_amdgcn_readfirstlane(vdst+(slot)))
  const char*Kbase=shm+LDS_K; bf16x8 kf[8];
  const lds_cptr shm3=(lds_cptr)shm; const lds_cptr kp0=shm3+LDS_K+hi*1024+r32*16; const lds_cptr vp0=shm3+LDS_V+((lane>>4)&1)*32+(lane&3)*8+(4*hi+((lane&15)>>2))*64;
  const int NT=(q0+QB)/KVBLK-t_start;
  DMA_K(0,0);DMA_V(0,0);DMA_K(1,SLOTB);
  bf16x8 qr[4];
  #pragma unroll
  for(int d0=0;d0<4;++d0)qr[d0]=*reinterpret_cast<const bf16x8*>(&Qw[(long)r32*DM+d0*16+hi*8]);
  { lds_f32*bl=(lds_f32*)((__attribute__((address_space(3))) char*)shm+LDS_BIAS);
    _Pragma("clang loop unroll(disable) vectorize(disable)")
    for(int s0=t_start*KVBLK+tid2;s0<q0+QB;s0+=4*NW*64){ float f_[4];
      _Pragma("unroll") for(int u_=0;u_<4;++u_){ const int s_=s0+u_*NW*64; f_[u_]=Fh[s_<q0+QB?s_:q0]; }
      _Pragma("unroll") for(int u_=0;u_<4;++u_){ const int s_=s0+u_*NW*64; if(s_<q0+QB)bl[s_]=(fref-f_[u_])*1.4426950408889634f; } } }
  float mhat=0.f,l_reg=0.f;f32x16 o[2];o[0]=f32x16{};o[1]=f32x16{};f32x16 negm=f32x16{};asm volatile("":"+v"(negm));
  const int qrel=wid*QBLK+r32;
  #define CMASK(P0,P1,t) do{int jb_=(t)-(NT-4); if(jb_>=0)cmask(P0,P1,jb_,qrel,hi);}while(0)
  #define BIASADD(P0,P1,t) do{ const lds_cf2 bp_=bias2+(t)*32; \
    _Pragma("unroll") for(int j_=0;j_<4;++j_){ SBAR(); \
      const f32x2_t b0_=bp_[4*j_], b1_=bp_[4*j_+1], b2_=bp_[4*j_+16], b3_=bp_[4*j_+17];     \
      P0[4*j_]+=b0_[0]; P0[4*j_+1]+=b0_[1]; P0[4*j_+2]+=b1_[0]; P0[4*j_+3]+=b1_[1]; \
      P1[4*j_]+=b2_[0]; P1[4*j_+1]+=b2_[1]; P1[4*j_+2]+=b3_[0]; P1[4*j_+3]+=b3_[1]; } SBAR(); }while(0)
  bool resc=false;
  #define START(P0,P1) do{ const float rm=rowmax(P0,P1); resc=false; \
    { const float dl=rm; mhat=fadd_s(mhat,dl); \
      _Pragma("unroll") for(int r=0;r<16;++r){P0[r]=fsub_s(P0[r],dl);P1[r]=fsub_s(P1[r],dl);} \
      _Pragma("unroll") for(int r=0;r<16;++r)negm[r]=-mhat; asm volatile("":"+v"(negm)); } \
    _Pragma("unroll") for(int r=0;r<16;++r)P0[r]=__builtin_amdgcn_exp2f(P0[r]); }while(0)
  #define RESC() do{ if(resc){ asm volatile("s_waitcnt lgkmcnt(0)":::"memory"); \
      _Pragma("unroll") for(int d_=0;d_<2;++d_) _Pragma("unroll") for(int r=0;r<16;++r)o[d_][r]*=wsf[crow(r,hi)]; } }while(0)
  f32x16 pA0,pA1,pB0,pB1;
  int sl_prev=0,sl_cur=0,sl_next=SLOTB;
  #define ROT() do{sl_prev=sl_cur;sl_cur=sl_next;sl_next=(sl_next==(NSLOT-1)*SLOTB)?0:sl_next+SLOTB;}while(0)
  DMA_K(2,2*SLOTB);
  WAIT_BAR(3);
  qkt(pA0,pA1,Kbase,qr,negm,r32,hi);asm volatile("s_nop 15\n\ts_nop 7":"+v"(pA0),"+v"(pA1));BIASADD(pA0,pA1,0);CMASK(pA0,pA1,0);
  START(pA0,pA1);
  _Pragma("unroll") for(int r=0;r<16;++r)pA1[r]=__builtin_amdgcn_exp2f(pA1[r]);
  WAIT_BAR(0);
  DMA_K(3,0);DMA_V(1,SLOTB);
  ROT();
  kload8(kf,kp0+sl_cur);
  WAIT_BAR(2);
  s16x4 vlo[8],vhi[8]; u32x4 pw0,pw1,pw2,pw3;
  #define PKW(P,B) cvtpk_s(P[B],P[B+1])
  #define PAF(k) __builtin_bit_cast(bf16x8,pw##k)
  #define VFR(i) (bf16x8){vlo[i][0],vlo[i][1],vlo[i][2],vlo[i][3],vhi[i][0],vhi[i][1],vhi[i][2],vhi[i][3]}
  #define PIN(x) asm volatile("":"+v"(x))
  #define MX3(a,b,c) __builtin_fmaxf(__builtin_fmaxf((a),(b)),(c))
  #define GAPA(MF,A0,A1,A2,A3,W0,W1,PW) do{ MF; sacc+=A0; sacc+=A1; sacc+=A2; sacc+=A3; PIN(sacc); W0; W1; PIN(PW); SBAR(); }while(0)
  #define EX(v) __builtin_amdgcn_exp2f(v)
  #define GAPB(MF,X,B) do{ MF; X[B]=EX(X[B]); X[B+1]=EX(X[B+1]); X[B+2]=EX(X[B+2]); X[B+3]=EX(X[B+3]); PIN(X); SBAR(); }while(0)
  #define VRD(i) do{ vlo[i]=vtr(vp_+(((i)>>2)*4096+((i)&3)*1024)); vhi[i]=vtr(vp_+(((i)>>2)*4096+((i)&3)*1024+512)); }while(0)
  #define KRD(G,j) do{ if(G){ kload2(kf,kp0+sl_next,j); SBAR(); } }while(0)
  #define STEP(C0,C1,P0,P1,t,GK,GV,GL) do{ SBAR(); \
    const lds_cptr vp_=vp0+sl_prev; \
    VRD(0); SBAR(); float sacc=(P0[0]+P0[1]); \
    GAPA(C0=__builtin_amdgcn_mfma_f32_32x32x16_bf16(kf[0],qr[0],negm,0,0,0), P0[2],P0[3],P0[4],P0[5],     pw0[0]=PKW(P0,0), pw0[1]=PKW(P0,2), pw0); \
    VRD(4); SBAR(); GAPA(C1=__builtin_amdgcn_mfma_f32_32x32x16_bf16(kf[1],qr[0],negm,0,0,0), P0[6],P0[7],P0[8],P0[9],     pw0[2]=PKW(P0,4), pw0[3]=PKW(P0,6), pw0); \
    VRD(1); SBAR(); GAPA(C0=__builtin_amdgcn_mfma_f32_32x32x16_bf16(kf[2],qr[1],C0,0,0,0),   P0[10],P0[11],P0[12],P0[13], pw1[0]=PKW(P0,8), pw1[1]=PKW(P0,10), pw1); \
    VRD(5); SBAR(); GAPA(C1=__builtin_amdgcn_mfma_f32_32x32x16_bf16(kf[3],qr[1],C1,0,0,0),   P0[14],P0[15],P1[0],P1[1],   pw1[2]=PKW(P0,12),pw1[3]=PKW(P0,14), pw1); \
    VRD(2); SBAR(); GAPA(C0=__builtin_amdgcn_mfma_f32_32x32x16_bf16(kf[4],qr[2],C0,0,0,0),   P1[2],P1[3],P1[4],P1[5],     pw2[0]=PKW(P1,0), pw2[1]=PKW(P1,2), pw2); \
    VRD(6); SBAR(); GAPA(C1=__builtin_amdgcn_mfma_f32_32x32x16_bf16(kf[5],qr[2],C1,0,0,0),   P1[6],P1[7],P1[8],P1[9],     pw2[2]=PKW(P1,4), pw2[3]=PKW(P1,6), pw2); \
    VRD(3); SBAR(); GAPA(C0=__builtin_amdgcn_mfma_f32_32x32x16_bf16(kf[6],qr[3],C0,0,0,0),   P1[10],P1[11],P1[12],P1[13], pw3[0]=PKW(P1,8), pw3[1]=PKW(P1,10), pw3); \
    VRD(7); SBAR(); GAPA(C1=__builtin_amdgcn_mfma_f32_32x32x16_bf16(kf[7],qr[3],C1,0,0,0),   P1[14],P1[15],0.f,0.f,       pw3[2]=PKW(P1,12),pw3[3]=PKW(P1,14), pw3); \
    l_reg+=sacc; \
    if(GK){DMA_K((t)+3,sl_cur);} if(GV){DMA_V((t)+1,sl_next);} \
    BIASADD(C0,C1,t); CMASK(C0,C1,t); \
    { float a=MX3(C0[0],C0[1],C1[0]),b=MX3(C0[2],C0[3],C1[1]); a=MX3(a,C1[2],C1[3]); \
      _Pragma("unroll") for(int r=4;r<16;r+=4){a=MX3(a,C0[r],C0[r+1]);b=MX3(b,C0[r+2],C0[r+3]);a=MX3(a,C1[r],C1[r+1]);b=MX3(b,C1[r+2],C1[r+3]);} \
      float rm=__builtin_fmaxf(a,b); { auto rr=__builtin_amdgcn_permlane32_swap(__float_as_uint(rm),__float_as_uint(rm),false,false); rm=__builtin_fmaxf(__uint_as_float(rr[0]),__uint_as_float(rr[1])); } \
      resc=false; \
      if(__builtin_expect(__any(rm>(float)THRL),0)){ const float dl=__builtin_fmaxf(rm,0.f); mhat+=dl; \
        _Pragma("unroll") for(int r=0;r<16;++r){C0[r]-=dl;C1[r]-=dl;} \
        _Pragma("unroll") for(int r=0;r<16;++r)negm[r]=-mhat; asm volatile("":"+v"(negm)); \
        const float f=__builtin_amdgcn_exp2f(-dl); l_reg*=f; if(hi==0)wsf[r32]=f; resc=true; } } \
    SBAR(); \
    GAPB(o[0]=__builtin_amdgcn_mfma_f32_32x32x16_bf16(PAF(0),VFR(0),o[0],0,0,0), C0,0); \
    GAPB(o[1]=__builtin_amdgcn_mfma_f32_32x32x16_bf16(PAF(0),VFR(4),o[1],0,0,0), C0,4); \
    KRD(GL,0); GAPB(o[0]=__builtin_amdgcn_mfma_f32_32x32x16_bf16(PAF(1),VFR(1),o[0],0,0,0), C0,8); \
    KRD(GL,1); GAPB(o[1]=__builtin_amdgcn_mfma_f32_32x32x16_bf16(PAF(1),VFR(5),o[1],0,0,0), C0,12); \
    KRD(GL,2); GAPB(o[0]=__builtin_amdgcn_mfma_f32_32x32x16_bf16(PAF(2),VFR(2),o[0],0,0,0), C1,0); \
    KRD(GL,3); GAPB(o[1]=__builtin_amdgcn_mfma_f32_32x32x16_bf16(PAF(2),VFR(6),o[1],0,0,0), C1,4); \
    GAPB(o[0]=__builtin_amdgcn_mfma_f32_32x32x16_bf16(PAF(3),VFR(3),o[0],0,0,0), C1,8); \
    GAPB(o[1]=__builtin_amdgcn_mfma_f32_32x32x16_bf16(PAF(3),VFR(7),o[1],0,0,0), C1,12); \
    }while(0)
  int t=1;
  #undef CMASK
  #define CMASK(P0,P1,t) do{}while(0)
  for(;t+5<NT;t+=2){
    STEP(pB0,pB1,pA0,pA1,t,true,true,true);     WAIT_BAR(2); RESC(); ROT();
    STEP(pA0,pA1,pB0,pB1,t+1,true,true,true);   WAIT_BAR(2); RESC(); ROT();
  }
  #undef CMASK
  #define CMASK(P0,P1,t) do{int jb_=(t)-(NT-4); if(jb_>=0)cmask(P0,P1,jb_,qrel,hi);}while(0)
  #define ENDW(tt) do{ if((tt)+3<NT){WAIT_BAR(2);} else if((tt)+2<NT){WAIT_BAR(1);} else {WAIT_BAR(0);} }while(0)
  for(;t+1<NT;t+=2){
    STEP(pB0,pB1,pA0,pA1,t,(t+3<NT),(t+1<NT),(t+1<NT));       ENDW(t);   RESC(); ROT();
    STEP(pA0,pA1,pB0,pB1,t+1,(t+4<NT),(t+2<NT),(t+2<NT));     ENDW(t+1); RESC(); ROT();
  }
  STEP(pB0,pB1,pA0,pA1,NT-1,false,false,false); RESC();
  { float sacc=pB0[0]+pB0[1]; _Pragma("unroll") for(int r=2;r<16;++r)sacc+=pB0[r]; _Pragma("unroll") for(int r=0;r<16;++r)sacc+=pB1[r]; l_reg+=sacc;
    pw0=(u32x4){PKW(pB0,0),PKW(pB0,2),PKW(pB0,4),PKW(pB0,6)};pw1=(u32x4){PKW(pB0,8),PKW(pB0,10),PKW(pB0,12),PKW(pB0,14)};pw2=(u32x4){PKW(pB1,0),PKW(pB1,2),PKW(pB1,4),PKW(pB1,6)};pw3=(u32x4){PKW(pB1,8),PKW(pB1,10),PKW(pB1,12),PKW(pB1,14)};
    const int vb0=(int)(lds0+LDS_V)+((lane>>4)&1)*32+(lane&3)*8+(4*hi+((lane&15)>>2))*64;
    SBAR(); pv(o,vb0+sl_cur,PAF(0),PAF(1),PAF(2),PAF(3)); }
  #undef PKW
  #undef PAF
  #undef VFR
  #undef PIN
  #undef MX3
  #undef GAPA
  #undef GAPB
  #undef EX
  #undef VRD
  #undef KRD
  #undef STEP
  #undef ENDW
  unsigned tk_=0u; if(tid==0)tk_=__hip_atomic_fetch_add(ctr,1u,__ATOMIC_RELAXED,__HIP_MEMORY_SCOPE_AGENT);
  {auto rr=__builtin_amdgcn_permlane32_swap(__float_as_uint(l_reg),__float_as_uint(l_reg),false,false);l_reg=__uint_as_float(rr[0])+__uint_as_float(rr[1]);}
  if(hi==0)wsf[32+r32]=l_reg;asm volatile("s_waitcnt lgkmcnt(0)":::"memory");
  float rli[16];
  #pragma unroll
  for(int r=0;r<16;++r)rli[r]=__builtin_amdgcn_rcpf(wsf[32+crow(r,hi)]);
  bf16*Ow=O+(rowbase+q0+wid*QBLK)*DM+h*D;
  { bf16*stg=(bf16*)(shm+LDS_OST)+wid*2048;
    #pragma unroll
    for(int r=0;r<16;++r){const int orow=crow(r,hi);
      #pragma unroll
      for(int d0=0;d0<2;++d0)stg[orow*64+d0*32+r32]=__float2bfloat16(o[d0][r]*rli[r]);}
    asm volatile("s_waitcnt lgkmcnt(0)":::"memory");
    #pragma unroll
    for(int i=0;i<4;++i){const int row=i*8+(lane>>3),ch=lane&7; const u32x4 v=*(const u32x4*)(stg+row*64+ch*8); ATTN_STORE16(Ow+(long)row*DM+ch*8,v);} }
  if(tid==0)*(__attribute__((address_space(3))) unsigned*)((__attribute__((address_space(3))) char*)shm+LDS_TKT)=tk_;
  asm volatile("s_waitcnt lgkmcnt(0)\n\ts_barrier":::"memory");
  #undef DMA_K
  #undef BIASADD
  #undef DMA_V
  #undef CMASK
  #undef START
  #undef RESC
  #undef ROT
}
constexpr int ATTN_LDS_BYTES=LDS_BYTES;
struct AttnTensors { const bf16* Q; const bf16* K; const bf16* V; bf16* O; const float* F; const unsigned* NQ; const unsigned* NK; };
struct AttnUnit { int bh; int qb; };
struct StaticOrder {
  int vcu,G;
  __device__ __forceinline__ explicit StaticOrder(int grid,int vcu_):vcu(vcu_),G(grid){}
  __device__ __forceinline__ bool next(int i,AttnUnit&u)const{ const int quad=(i>>2)*G+vcu; if(quad>=BATCH*NHEAD*8)return false; const int s=quad&7,j=i&3; u.bh=quad>>3; u.qb=(j==0)?s:(j==1)?15-s:(j==2)?16+s:31-s; return true; }
  __device__ __forceinline__ void a_ready(const AttnUnit&)const{}
  __device__ __forceinline__ void done(const AttnUnit&)const{}
};
constexpr int NUNITS=BATCH*NHEAD*NQB;
template<int THRL=60> __device__ __forceinline__ void attn_phase(char*lds,const AttnTensors&T,unsigned*ctr){
  __attribute__((address_space(3))) unsigned*tkt=(__attribute__((address_space(3))) unsigned*)((__attribute__((address_space(3))) char*)lds+LDS_TKT);
  if(threadIdx.x==0)*tkt=__hip_atomic_fetch_add(ctr,1u,__ATOMIC_RELAXED,__HIP_MEMORY_SCOPE_AGENT);
  asm volatile("s_waitcnt vmcnt(0) lgkmcnt(0)\n\ts_barrier":::"memory");
  for(;;){ const unsigned n=(unsigned)__builtin_amdgcn_readfirstlane((int)*tkt); if(n>=(unsigned)NUNITS)break;
    const int bh=(int)(n&31u),qb=NQB-1-(int)(n>>5);
    attn_unit<THRL>(bh/NHEAD,bh%NHEAD,qb,T.Q,T.K,T.V,T.O,T.F,T.NQ,T.NK,ctr,lds); }
}
#undef SBAR
#undef WAIT_BAR
}
constexpr int NWAVES = 8;
#ifndef MK_PER_PHASE
#define MK_PER_PHASE 0
#endif
constexpr int NPHASE = 15;

constexpr int BATCH = 4, T = 8192, D = 1024, H = 16, HD = 64;
constexpr int M = BATCH * T;
constexpr int NQKV = 3 * D;
constexpr int MH = M / 2, BH = BATCH / 2;
constexpr int NEXP = 16, DEXP = 256, NBUCKET = 24, MAXTILES = 88, HROWS = MAXTILES * 256, BCAP = MH;
constexpr int NBLK = MH / 128;
constexpr float RMS_EPS = 1e-6f;

constexpr size_t MiB = 1u << 20, KiB = 1u << 10;
constexpr size_t WS_CTL = 0, CTL_ZERO_BYTES = 128 * KiB;
constexpr size_t WS_TOKINFO = 1 * MiB, WS_TOKGATE = WS_TOKINFO + 128 * KiB, WS_HIST = WS_TOKGATE + 256 * KiB, WS_TILETBL = WS_HIST + 32 * KiB, WS_TOKROW = WS_TILETBL + 4 * KiB,
                 WS_GATEROW = WS_TOKROW + 160 * KiB, WS_BLKSUM = WS_GATEROW + 320 * KiB, WS_RWG = WS_BLKSUM + 16 * KiB, WS_WFG = WS_RWG + 160 * KiB, WS_TRASH = WS_WFG + 64 * KiB, WS_SMALL_END = WS_TRASH + 4 * KiB;
static_assert(WS_SMALL_END <= 4 * MiB, "small tables");
constexpr size_t WS_LF = 4 * MiB, WS_FM = 6 * MiB;
constexpr size_t WS_WPOOL = 8 * MiB, WS_WQKV = 9 * MiB, WS_WO = 15 * MiB, WS_WG = 17 * MiB, WS_WU = 33 * MiB, WS_WD = 49 * MiB;
constexpr size_t WS_XN = 66 * MiB;
constexpr size_t WS_QO = 130 * MiB, WS_K = 194 * MiB, WS_V = 258 * MiB;
constexpr size_t WS_HMID = 322 * MiB, WS_Y0 = 370 * MiB, WS_DPOOL = 434 * MiB, WS_TOKROW2 = 498 * MiB, WS_GATEROW2 = 501 * MiB, WS_END = 508 * MiB;
static_assert(WS_HMID + (size_t)2 * HROWS * 512 * 2 <= WS_Y0 && WS_TOKROW2 + (size_t)2 * NBUCKET * BCAP * 4 <= WS_GATEROW2 && WS_GATEROW2 + (size_t)2 * NBUCKET * BCAP * 8 <= WS_END && WS_V - WS_K == WS_K - WS_QO, "d_ws map");
constexpr int CW_BAR = 4096;
constexpr int CW_NRM = 8192;
constexpr int CW_CNT = 12800;
constexpr int CW_CONV = 13120;
constexpr int CW_BARH = 16384;
constexpr int CW_ATQ = 12544;
static_assert(CW_NRM + 4096 + 128 <= CW_ATQ && (CW_BARH + 2 * 3456) * 4 <= (int)CTL_ZERO_BYTES, "CTL words inside the memset region");

constexpr int RING_OFF = 0, RING_BYTES = 131072;
constexpr int LDSCTL_OFF = RING_BYTES, MISC_OFF = LDSCTL_OFF + 320;
constexpr int TBL_OFF = RING_BYTES + 1024;
constexpr int LDS_BYTES = 147456;
static_assert(MISC_OFF + 128 <= TBL_OFF && TBL_OFF + (1 + 3 * MAXTILES) * 4 <= LDS_BYTES, "LDS map");

#define GAS __attribute__((address_space(1)))
#define LAS __attribute__((address_space(3)))
typedef unsigned short bf16;
typedef unsigned v4u __attribute__((ext_vector_type(4)));
typedef float f32x4 __attribute__((ext_vector_type(4)));
typedef float f32x2 __attribute__((ext_vector_type(2)));
typedef GAS unsigned gu32;
#define RLX_AGENT __ATOMIC_RELAXED, __HIP_MEMORY_SCOPE_AGENT
#define LDS_WAIT() asm volatile("s_waitcnt lgkmcnt(0)" ::: "memory")
__device__ __forceinline__ unsigned f2bf(float f) { unsigned u = __builtin_bit_cast(unsigned, f); return (u + 0x7fffu + ((u >> 16) & 1u)) >> 16; }
__device__ __forceinline__ unsigned pk2(float lo, float hi) { return f2bf(lo) | (f2bf(hi) << 16); }

#define XB_TMO      128
#define XB_XCNT(j)  (256  + 64 * (j))
#define XB_XSUB(j)  (1280 + 64 * (j))
#define XB_XGEN(j)  (2304 + 64 * (j))
#define XB_TOP      3328
#define XB_TOPGEN   3392
#define XCD_BAR_WORDS 3456
#define XB_SPIN_CAP (1u << 18)

__device__ __forceinline__ unsigned xb_ld(unsigned* p)              { return __hip_atomic_load(p, __ATOMIC_RELAXED, __HIP_MEMORY_SCOPE_AGENT); }
__device__ __forceinline__ unsigned xb_add(unsigned* p, unsigned v) { return __hip_atomic_fetch_add(p, v, __ATOMIC_RELAXED, __HIP_MEMORY_SCOPE_AGENT); }
__device__ __forceinline__ unsigned xb_xcc_id() { return (unsigned)__builtin_amdgcn_s_getreg((3 << 11) | 20) & 0xFu; }
#define XB_SPIN(cond, bar) do { unsigned _sp = 0; while (cond) { __builtin_amdgcn_s_sleep(1); \
    if ((++_sp & 255u) == 0u) { if (xb_ld(&(bar)[XB_TMO])) break; if (_sp > XB_SPIN_CAP) { atomicAdd(&(bar)[XB_TMO], 1u); break; } } } } while (0)

struct XcdBarrier {
    unsigned* bar; unsigned x; unsigned G;
    volatile LAS unsigned* st;
};

__device__ __forceinline__ XcdBarrier xcd_barrier_post(unsigned* bar, volatile LAS unsigned* st, unsigned G) {
    XcdBarrier b; b.bar = bar; b.x = xb_xcc_id(); b.st = st; b.G = G;
    if (threadIdx.x == 0) (void)xb_add(&bar[XB_XCNT(b.x)], 1u);
    return b;
}
__device__ __forceinline__ void xcd_barrier_complete(unsigned* bar, unsigned x, unsigned& nloc, unsigned& nx, const unsigned G) {
    unsigned sum, cnt, mine, sp = 0u;
    for (;;) {
        sum = 0u; cnt = 0u; mine = 0u;
#pragma unroll
        for (unsigned j = 0; j < 16; ++j) { const unsigned c = xb_ld(&bar[XB_XCNT(j)]); sum += c; cnt += (c > 0u) ? 1u : 0u; mine = (j == x) ? c : mine; }
        if (sum == G) break;
        __builtin_amdgcn_s_sleep(1);
        if ((++sp & 255u) == 0u) { if (xb_ld(&bar[XB_TMO])) break; if (sp > XB_SPIN_CAP) { atomicAdd(&bar[XB_TMO], 1u); break; } }
    }
    nloc = mine > 0u ? mine : 1u; nx = cnt > 0u ? cnt : 1u;
}

__device__ __forceinline__ void xcd_barrier(const XcdBarrier& b) {
    asm volatile("s_waitcnt vmcnt(0)" ::: "memory");
    __syncthreads();
    if (threadIdx.x == 0) {
        unsigned* bar = b.bar;
        __builtin_amdgcn_s_waitcnt(0);
        unsigned nloc = b.st[0], nx = b.st[1];
        if (nloc == 0u) { xcd_barrier_complete(bar, b.x, nloc, nx, b.G); b.st[0] = nloc; b.st[1] = nx; }
        const unsigned old = xb_add(&bar[XB_XSUB(b.x)], 1u);
        const unsigned gen = old / nloc;
        if (old + 1u == (gen + 1u) * nloc) {
            __builtin_amdgcn_fence(__ATOMIC_RELEASE, "agent");
            asm volatile("s_waitcnt vmcnt(0)" ::: "memory");
            const unsigned og = xb_add(&bar[XB_TOP], 1u);
            const unsigned tg = og / nx;
            if (og + 1u == (tg + 1u) * nx) xb_add(&bar[XB_TOPGEN], 1u);
            else XB_SPIN(xb_ld(&bar[XB_TOPGEN]) == tg, bar);
            __builtin_amdgcn_fence(__ATOMIC_ACQUIRE, "agent");
            xb_add(&bar[XB_XGEN(b.x)], 1u);
            asm volatile("s_waitcnt vmcnt(0)" ::: "memory");
        } else {
            XB_SPIN(xb_ld(&bar[XB_XGEN(b.x)]) == gen, bar);
            __builtin_amdgcn_fence(__ATOMIC_ACQUIRE, "agent");
            asm volatile("s_waitcnt vmcnt(0)" ::: "memory");
        }
    }
    __syncthreads();
}
template <int I> __device__ __forceinline__ const float* kin() {
    const __attribute__((address_space(4))) volatile unsigned long long* kp = (const __attribute__((address_space(4))) volatile unsigned long long*)__builtin_amdgcn_kernarg_segment_ptr();
    const unsigned long long v = kp[I];
    return (const float*)(GAS const float*)v;
}
enum InIdx { I_X = 0, I_MIXN, I_FFNN, I_POOLW, I_POOLS, I_KVN, I_WK, I_WV, I_WF, I_BF, I_WQ, I_WO, I_RG, I_RGB, I_RE, I_REB, I_WGATE, I_WUP, I_WDOWN, I_FINN };
struct Frame {
    LAS unsigned char* lds;
    volatile LAS unsigned* MISC;
    int tid, lane, wave;
    int vcu, G;
    int half;
    float* out;
    unsigned char* ws;
#define WSP(name, T, OFF) __device__ __forceinline__ T* name() const { return (T*)(ws + (OFF)); }
#define WSH(name, T, OFF, PERHALF) __device__ __forceinline__ T* name() const { return (T*)(ws + (OFF)) + (size_t)half * (PERHALF); }
    WSP(WPOOL, bf16, WS_WPOOL) WSP(WQKV, bf16, WS_WQKV) WSP(WO, bf16, WS_WO) WSP(WG, bf16, WS_WG) WSP(WU, bf16, WS_WU) WSP(WD, bf16, WS_WD)
    WSH(XN, bf16, WS_XN, (size_t)MH * D) WSH(QO, bf16, WS_QO, (size_t)MH * D) WSH(KB, bf16, WS_K, (size_t)MH * D) WSH(VB, bf16, WS_V, (size_t)MH * D) WSH(HMID, bf16, WS_HMID, (size_t)HROWS * 512)
    WSH(TOKROW, int, WS_TOKROW2, (size_t)NBUCKET * BCAP) WSH(GATEROW, float, WS_GATEROW2, (size_t)NBUCKET * BCAP * 2)
    WSH(BLKSUM, float, WS_BLKSUM, NBLK * 16) WSP(RWG, float, WS_RWG) WSP(WFG, float, WS_WFG) WSH(LF, float, WS_LF, (size_t)MH * 16) WSH(FM, float, WS_FM, (size_t)BH * H * T) WSP(TRASH, bf16, WS_TRASH)
    WSH(DPOOL, bf16, WS_DPOOL, (size_t)MH * D) WSH(Y0, bf16, WS_Y0, (size_t)MH * D) WSH(DATT, bf16, WS_V, (size_t)MH * D) WSH(Y1, bf16, WS_QO, (size_t)MH * D) WSH(H3B, bf16, WS_K, (size_t)MH * D)
    __device__ __forceinline__ const float* X() const { return kin<I_X>() + (size_t)half * MH * D; }
#undef WSH
#undef WSP
};

__device__ __forceinline__ float dpp_add(float v, const int which) {
    const int x = __float_as_int(v);
    const int r = which == 0 ? __builtin_amdgcn_mov_dpp(x, 0xB1, 0xf, 0xf, true) : which == 1 ? __builtin_amdgcn_mov_dpp(x, 0x4E, 0xf, 0xf, true) : which == 2 ? __builtin_amdgcn_mov_dpp(x, 0x141, 0xf, 0xf, true) : __builtin_amdgcn_mov_dpp(x, 0x140, 0xf, 0xf, true);
    return v + __int_as_float(r);
}
__device__ __forceinline__ float xor16_sum(float v) { const auto r = __builtin_amdgcn_permlane16_swap(__float_as_uint(v), __float_as_uint(v), false, false); return __uint_as_float(r[0]) + __uint_as_float(r[1]); }
__device__ __forceinline__ float xor32_sum(float v) { const auto r = __builtin_amdgcn_permlane32_swap(__float_as_uint(v), __float_as_uint(v), false, false); return __uint_as_float(r[0]) + __uint_as_float(r[1]); }
__device__ __forceinline__ float wave_sum(float v) {
    v = dpp_add(v, 0); v = dpp_add(v, 1); v = dpp_add(v, 2); v = dpp_add(v, 3);
    return xor32_sum(xor16_sum(v));
}
template <int N, int MASK> __device__ __forceinline__ void halve(float (&v)[80], int lane) {
    const bool hi = (lane & MASK) != 0;
#pragma unroll
    for (int k = 0; k < N / 2; ++k) { const float keep = hi ? v[2 * k + 1] : v[2 * k], send = hi ? v[2 * k] : v[2 * k + 1]; v[k] = keep + pg8::xor_lane<MASK>(send); }
}

struct ConvItem { const float* W; bf16* WT; const float* ks; const float* ns; int K, N, item; };
struct ConvLoads { float wv[32]; f32x4 ks0, ks1; float nsv; };
__device__ __forceinline__ void conv_issue(const ConvItem& c, int lane, ConvLoads& L) {
    const int nblk = c.N / 32, kb = c.item / nblk, nb = c.item % nblk, k0 = 64 * kb, n0 = 32 * nb;
    const float* wp = c.W + (size_t)(k0 + (lane >> 5)) * c.N + n0 + (lane & 31);
#pragma unroll
    for (int i = 0; i < 32; ++i) L.wv[i] = __builtin_nontemporal_load(wp + (size_t)(2 * i) * c.N);
    L.nsv = c.ns ? c.ns[n0 + (lane & 31)] : 1.0f;
    const int ch = lane & 7;
    if (c.ks) { L.ks0 = *(const f32x4*)(c.ks + k0 + 8 * ch); L.ks1 = *(const f32x4*)(c.ks + k0 + 8 * ch + 4); } else { L.ks0 = (f32x4){1.f, 1.f, 1.f, 1.f}; L.ks1 = L.ks0; }
}
__device__ __forceinline__ void conv_finish(const ConvItem& c, int lane, const ConvLoads& L, LAS float* scr) {
    const int nblk = c.N / 32, kb = c.item / nblk, nb = c.item % nblk, k0 = 64 * kb, n0 = 32 * nb;
#pragma unroll
    for (int i = 0; i < 32; ++i) scr[(2 * i + (lane >> 5)) * 33 + (lane & 31)] = L.wv[i] * L.nsv;
    LDS_WAIT(); asm volatile("" ::: "memory");
    const int ch = lane & 7;
#pragma unroll
    for (int j = 0; j < 4; ++j) { const int n = (lane >> 3) + 8 * j; const LAS float* s = scr + (8 * ch) * 33 + n;
        v4u o; o.x = pg8::cvt_pk_bf16(s[0 * 33] * L.ks0.x, s[1 * 33] * L.ks0.y); o.y = pg8::cvt_pk_bf16(s[2 * 33] * L.ks0.z, s[3 * 33] * L.ks0.w);
        o.z = pg8::cvt_pk_bf16(s[4 * 33] * L.ks1.x, s[5 * 33] * L.ks1.y); o.w = pg8::cvt_pk_bf16(s[6 * 33] * L.ks1.z, s[7 * 33] * L.ks1.w);
        *(v4u*)(c.WT + (size_t)(n0 + n) * c.K + k0 + 8 * ch) = o; }
    LDS_WAIT(); asm volatile("" ::: "memory");
}
template <int W> __device__ __forceinline__ void pool_walk(const float* xb, int t0, int tbeg, const LAS float* invs, bf16* outp) {
    f32x4 ring[16], cur[16], nxt[16];
#pragma unroll
    for (int u = 0; u < 16; ++u) { ring[u] = (f32x4){0.f, 0.f, 0.f, 0.f}; const int t = t0 + tbeg - 16 + u; cur[u] = __builtin_nontemporal_load((const f32x4*)(xb + (size_t)(t < 0 ? 0 : t) * D)); }
    for (int base = -16; base < 64; base += 16) {
        if (base + 16 < 64) {
#pragma unroll
            for (int u = 0; u < 16; ++u) nxt[u] = __builtin_nontemporal_load((const f32x4*)(xb + (size_t)(t0 + tbeg + base + 16 + u) * D)); }
#pragma unroll
        for (int u = 0; u < 16; ++u) {
            const int tt = tbeg + base + u, t = t0 + tt;
            const f32x4 v = cur[u] * invs[tt + 16];
            ring[u] = v;
            if (base >= 0) {
                f32x4 s = v;
#pragma unroll
                for (int j = 1; j < W; ++j) s += ring[(u - j) & 15];
                const float rc = 1.0f / (float)((t + 1 < W) ? (t + 1) : W);
                const f32x4 d = s * rc - v;
                *(unsigned long long*)(outp + (size_t)t * D) = (unsigned long long)pg8::cvt_pk_bf16(d.x, d.y) | ((unsigned long long)pg8::cvt_pk_bf16(d.z, d.w) << 32);
            }
        }
#pragma unroll
        for (int u = 0; u < 16; ++u) cur[u] = nxt[u];
    }
}
__device__ __forceinline__ void p0_pool_diff(Frame& F) {
    LAS float* invs = (LAS float*)(F.lds + RING_OFF);
    for (int blk = F.vcu; blk < NBLK; blk += F.G) {
        const int b = blk >> 6, t0 = (blk & 63) * 128;
        const float* xb = F.X() + (size_t)b * T * D;
        for (int kb = 0; kb < 18; kb += 6) {
            f32x4 v[6][4];
#pragma unroll
            for (int q = 0; q < 6; ++q) { const int t = t0 - 16 + F.wave + 8 * (kb + q); const f32x4* xr = (const f32x4*)(xb + (size_t)(t < 0 ? 0 : t) * D) + F.lane;
#pragma unroll
                for (int j = 0; j < 4; ++j) v[q][j] = __builtin_nontemporal_load(xr + 64 * j); }
#pragma unroll
            for (int q = 0; q < 6; ++q) { const int tt = -16 + F.wave + 8 * (kb + q); float s = 0.f;
#pragma unroll
                for (int j = 0; j < 4; ++j) s += (v[q][j].x * v[q][j].x + v[q][j].y * v[q][j].y) + (v[q][j].z * v[q][j].z + v[q][j].w * v[q][j].w);
                const float inv = (t0 + tt >= 0) ? 1.0f / sqrtf(wave_sum(s) * (1.0f / D) + RMS_EPS) : 0.f;
                if (F.lane == 0) invs[tt + 16] = inv; }
        }
        __syncthreads();
        const int tq = F.tid & 255, tbeg = (F.tid >> 8) * 64;
        const float* xt = xb + 4 * tq; bf16* op = F.XN() + (size_t)b * T * D + 4 * tq;
        const int grp = F.wave & 3;
        if (grp == 0) pool_walk<2>(xt, t0, tbeg, invs, op); else if (grp == 1) pool_walk<4>(xt, t0, tbeg, invs, op); else if (grp == 2) pool_walk<8>(xt, t0, tbeg, invs, op); else pool_walk<16>(xt, t0, tbeg, invs, op);
        __syncthreads();
    }
}
constexpr int CONV_EARLY = 4224, CONV_ALL = 14464;
__device__ __forceinline__ ConvItem conv_decode(Frame& F, int it) {
    ConvItem c; int r = it;
    if (r < 128) { const int g = r >> 5; c = ConvItem{kin<I_POOLW>() + g * 65536, F.WPOOL() + g * 65536, kin<I_MIXN>() + g * 256, kin<I_POOLS>() + g * 256, 256, 256, r & 31}; return c; } r -= 128;
    if (r < 4096) { const int up = r >> 11, mat = (r >> 7) & 15;
        c = ConvItem{(up ? kin<I_WUP>() : kin<I_WGATE>()) + (size_t)mat * 262144, (up ? F.WU() : F.WG()) + (size_t)mat * 262144, kin<I_FFNN>(), nullptr, D, DEXP, r & 127}; return c; } r -= 4096;
    if (r < 2048) { const int mat = r >> 7; c = ConvItem{kin<I_WDOWN>() + (size_t)mat * 262144, F.WD() + (size_t)mat * 262144, nullptr, nullptr, DEXP, D, r & 127}; return c; } r -= 2048;
    if (r < 2048) { const int mt = r >> 9;
        const float* W = mt == 0 ? kin<I_WQ>() : mt == 1 ? kin<I_WK>() : mt == 2 ? kin<I_WV>() : kin<I_WO>(); bf16* WT = mt < 3 ? F.WQKV() + (size_t)mt * D * D : F.WO();
        const float* ks = mt == 0 ? kin<I_MIXN>() + D : (mt < 3 ? kin<I_KVN>() : nullptr);
        c = ConvItem{W, WT, ks, nullptr, D, D, r & 511}; return c; } r -= 2048;
    if (r < 4096) { const int up = r >> 11, mat = 16 + ((r >> 7) & 15);
        c = ConvItem{(up ? kin<I_WUP>() : kin<I_WGATE>()) + (size_t)mat * 262144, (up ? F.WU() : F.WG()) + (size_t)mat * 262144, kin<I_FFNN>() + D, nullptr, D, DEXP, r & 127}; return c; } r -= 4096;
    { const int mat = 16 + (r >> 7); c = ConvItem{kin<I_WDOWN>() + (size_t)mat * 262144, F.WD() + (size_t)mat * 262144, nullptr, nullptr, DEXP, D, r & 127}; return c; }
}
__device__ __forceinline__ void p0_convert(Frame& F, int it0, int it1, int gw, int ngw) {
    LAS float* scr = (LAS float*)(F.lds + RING_OFF + 4096 + F.wave * 12288);
    int it = it0 + gw; if (it >= it1) return;
    ConvItem c = conv_decode(F, it); ConvLoads L; conv_issue(c, F.lane, L);
    for (;;) {
        const int itn = it + ngw; const bool more = itn < it1;
        ConvItem cn = c; ConvLoads Ln;
        if (more) { cn = conv_decode(F, itn); conv_issue(cn, F.lane, Ln); }
        conv_finish(c, F.lane, L, scr);
        if (!more) break;
        c = cn; L = Ln; it = itn;
    }
}
__device__ __forceinline__ void p0_small(Frame& F, int gt, int NT) {
    const float* rg = kin<I_RG>(); const float* re = kin<I_RE>(); const float* ffnn = kin<I_FFNN>(); const float* kvn = kin<I_KVN>(); const float* wf = kin<I_WF>();
    float* RWG = F.RWG(); float* WFG = F.WFG();
    for (int i = gt; i < 2 * 20 * D; i += NT) { const int l = i / (20 * D), rem = i % (20 * D), col = rem / D, c = rem % D;
        const float w = col < 4 ? rg[(size_t)(l * D + c) * 4 + col] : re[(size_t)(l * D + c) * 16 + (col - 4)]; RWG[i] = ffnn[l * D + c] * w; }
    for (int i = gt; i < 16 * D; i += NT) { const int h = i / D, c = i % D; WFG[i] = kvn[c] * wf[c * 16 + h]; }
}

struct RowSrc { const float* base; const bf16* d1; const bf16* d2; const bf16* d3; bf16* hwb; };
__device__ __forceinline__ f32x4 bf4_to_f32(unsigned long long w) { const unsigned lo = (unsigned)w, hi = (unsigned)(w >> 32);
    return (f32x4){__uint_as_float(lo << 16), __uint_as_float(lo & 0xffff0000u), __uint_as_float(hi << 16), __uint_as_float(hi & 0xffff0000u)}; }
__device__ __forceinline__ void row_load(const RowSrc& S, size_t row, int lane, f32x4 (&v)[4]) {
    if (S.base) { const f32x4* xr = (const f32x4*)(S.base + row * D) + lane;
#pragma unroll
        for (int j = 0; j < 4; ++j) v[j] = __builtin_nontemporal_load(xr + 64 * j); }
    else {
#pragma unroll
        for (int j = 0; j < 4; ++j) v[j] = (f32x4){0.f, 0.f, 0.f, 0.f}; }
    if (S.d1) { const unsigned long long* dr = (const unsigned long long*)(S.d1 + row * D) + lane;
#pragma unroll
        for (int j = 0; j < 4; ++j) v[j] += bf4_to_f32(__builtin_nontemporal_load(dr + 64 * j)); }
    if (S.d2) { const unsigned long long* dr = (const unsigned long long*)(S.d2 + row * D) + lane;
#pragma unroll
        for (int j = 0; j < 4; ++j) v[j] += bf4_to_f32(__builtin_nontemporal_load(dr + 64 * j)); }
    if (S.d3) { const unsigned long long* dr = (const unsigned long long*)(S.d3 + row * D) + lane;
#pragma unroll
        for (int j = 0; j < 4; ++j) v[j] += bf4_to_f32(__builtin_nontemporal_load(dr + 64 * j)); }
    if (S.hwb) { unsigned long long* hr = (unsigned long long*)(S.hwb + row * D) + lane;
#pragma unroll
        for (int j = 0; j < 4; ++j) __builtin_nontemporal_store((unsigned long long)pg8::cvt_pk_bf16(v[j].x, v[j].y) | ((unsigned long long)pg8::cvt_pk_bf16(v[j].z, v[j].w) << 32), hr + 64 * j); }
}
__device__ __forceinline__ void rows4_load_norm(Frame& F, const RowSrc& S, int row0, f32x4 (&xv)[4][4], float (&inv)[4]) {
#pragma unroll
    for (int r = 0; r < 4; ++r) row_load(S, (size_t)(row0 + r), F.lane, xv[r]);
#pragma unroll
    for (int r = 0; r < 4; ++r) { float s = 0.f;
#pragma unroll
        for (int j = 0; j < 4; ++j) s += (xv[r][j].x * xv[r][j].x + xv[r][j].y * xv[r][j].y) + (xv[r][j].z * xv[r][j].z + xv[r][j].w * xv[r][j].w);
        inv[r] = 1.0f / sqrtf(wave_sum(s) * (1.0f / D) + RMS_EPS); }
#pragma unroll
    for (int r = 0; r < 4; ++r) { unsigned long long* o8 = (unsigned long long*)(F.XN() + (size_t)(row0 + r) * D) + F.lane;
#pragma unroll
        for (int j = 0; j < 4; ++j) o8[64 * j] = (unsigned long long)pg8::cvt_pk_bf16(xv[r][j].x * inv[r], xv[r][j].y * inv[r]) | ((unsigned long long)pg8::cvt_pk_bf16(xv[r][j].z * inv[r], xv[r][j].w * inv[r]) << 32); }
}
template <int NCOL> __device__ __forceinline__ void rows4_dots(const LAS float* Wl, int lane, const f32x4 (&xv)[4][4], float (&acc)[80]) {
#pragma unroll
    for (int j = 0; j < 4; ++j)
#pragma unroll
        for (int col = 0; col < NCOL; ++col) { const f32x4 w = ((const LAS f32x4*)(Wl + col * D))[lane + 64 * j];
#pragma unroll
            for (int r = 0; r < 4; ++r) { float a = acc[4 * col + r]; a = __builtin_fmaf(xv[r][j].x, w.x, a); a = __builtin_fmaf(xv[r][j].y, w.y, a); a = __builtin_fmaf(xv[r][j].z, w.z, a); a = __builtin_fmaf(xv[r][j].w, w.w, a); acc[4 * col + r] = a; }
            if ((col & 3) == 3) __builtin_amdgcn_sched_barrier(0); }
}
__device__ __forceinline__ void row_router_phase(Frame& F, int l, const RowSrc& RS, unsigned* cnt) {
    LAS float* Wl = (LAS float*)(F.lds + RING_OFF);
    LAS float* sc = (LAS float*)(F.lds + RING_OFF + 81920);
    LAS int* hl = (LAS int*)(F.lds + RING_OFF + 81920 + 4096);
    LAS int* tb = hl + 64;
    LAS float* tg = (LAS float*)(tb + 128);
    { const f32x4* rw = (const f32x4*)(F.RWG() + (size_t)l * 20 * D) + F.tid; f32x4 t[10];
#pragma unroll
      for (int i = 0; i < 10; ++i) t[i] = rw[i * NWAVES * 64];
#pragma unroll
      for (int i = 0; i < 10; ++i) ((LAS f32x4*)Wl)[F.tid + i * NWAVES * 64] = t[i]; }
    const float* gb = kin<I_RGB>() + l * 4; const float* eb = kin<I_REB>() + l * 16;
    for (int blk = F.vcu; blk < NBLK; blk += F.G) {
        if (F.tid < 32) hl[F.tid] = 0;
        __syncthreads();
        for (int pass = 0; pass < 4; ++pass) {
            asm volatile("" ::: "memory");
            const int row0 = blk * 128 + F.wave * 16 + pass * 4;
            f32x4 xv[4][4]; float inv[4];
            rows4_load_norm(F, RS, row0, xv, inv);
            LAS float* sw = sc + F.wave * 80;
            float acc[80];
#pragma unroll
            for (int i = 0; i < 16; ++i) acc[i] = 0.f;
            rows4_dots<4>(Wl, F.lane, xv, acc);
            halve<16, 1>(acc, F.lane); halve<8, 2>(acc, F.lane); halve<4, 4>(acc, F.lane); halve<2, 8>(acc, F.lane);
            acc[0] = xor32_sum(xor16_sum(acc[0]));
            { const int p = F.lane & 15, r = p & 3, c = p >> 2; const float iv = r == 0 ? inv[0] : r == 1 ? inv[1] : r == 2 ? inv[2] : inv[3];
              if (F.lane < 16) sw[r * 8 + c] = acc[0] * iv + gb[c]; }
            LDS_WAIT(); asm volatile("" ::: "memory");
            int gsel[4];
#pragma unroll
            for (int r = 0; r < 4; ++r) { const f32x4 g = *(const LAS f32x4*)(sw + r * 8); int gi = 0; float gm = g.x; if (g.y > gm) { gm = g.y; gi = 1; } if (g.z > gm) { gm = g.z; gi = 2; } if (g.w > gm) { gm = g.w; gi = 3; }
                gsel[r] = __builtin_amdgcn_readfirstlane(gi); }
#pragma unroll
            for (int i = 0; i < 16; ++i) acc[i] = 0.f;
#pragma unroll
            for (int j = 0; j < 4; ++j)
#pragma unroll
                for (int r = 0; r < 4; ++r) {
#pragma unroll
                    for (int c = 0; c < 4; ++c) { const f32x4 w = ((const LAS f32x4*)(Wl + (4 + 4 * gsel[r] + c) * D))[F.lane + 64 * j];
                        float a = acc[4 * c + r]; a = __builtin_fmaf(xv[r][j].x, w.x, a); a = __builtin_fmaf(xv[r][j].y, w.y, a); a = __builtin_fmaf(xv[r][j].z, w.z, a); a = __builtin_fmaf(xv[r][j].w, w.w, a); acc[4 * c + r] = a; }
                    __builtin_amdgcn_sched_barrier(0); }
            halve<16, 1>(acc, F.lane); halve<8, 2>(acc, F.lane); halve<4, 4>(acc, F.lane); halve<2, 8>(acc, F.lane);
            acc[0] = xor32_sum(xor16_sum(acc[0]));
            if (F.lane < 16) sw[(F.lane & 3) * 8 + 4 + (F.lane >> 2)] = acc[0];
            LDS_WAIT(); asm volatile("" ::: "memory");
            if (F.lane < 4) {
                const int r = F.lane; const LAS float* sr = sw + r * 8;
                const float iv = r == 0 ? inv[0] : r == 1 ? inv[1] : r == 2 ? inv[2] : inv[3];
                const float g0 = sr[0], g1 = sr[1], g2 = sr[2], g3 = sr[3];
                int gi = 0; float gm = g0; if (g1 > gm) { gm = g1; gi = 1; } if (g2 > gm) { gm = g2; gi = 2; } if (g3 > gm) { gm = g3; gi = 3; }
                const float gwt = 1.0f / (expf(g0 - gm) + expf(g1 - gm) + expf(g2 - gm) + expf(g3 - gm));
                const LAS float* se = sr + 4; const float* ebg = eb + gi * 4;
                const float e0 = se[0] * iv + ebg[0], e1 = se[1] * iv + ebg[1], e2 = se[2] * iv + ebg[2], e3 = se[3] * iv + ebg[3];
                int i1 = 0; float v1 = e0; if (e1 > v1) { v1 = e1; i1 = 1; } if (e2 > v1) { v1 = e2; i1 = 2; } if (e3 > v1) { v1 = e3; i1 = 3; }
                int i2 = -1; float v2 = -INFINITY;
                if (i1 != 0 && e0 > v2) { v2 = e0; i2 = 0; } if (i1 != 1 && e1 > v2) { v2 = e1; i2 = 1; } if (i1 != 2 && e2 > v2) { v2 = e2; i2 = 2; } if (i1 != 3 && e3 > v2) { v2 = e3; i2 = 3; }
                const float p1 = 1.0f / (1.0f + expf(v2 - v1)), p2 = 1.0f - p1;
                const int lo = i1 < i2 ? i1 : i2, hi = i1 < i2 ? i2 : i1;
                const float wlo = (i1 < i2 ? p1 : p2) * gwt, whi = (i1 < i2 ? p2 : p1) * gwt;
                const int pidx = lo == 0 ? hi - 1 : (lo == 1 ? hi + 1 : 5);
                const int bucket = gi * 6 + pidx, tok = row0 + r;
                const int rank = __hip_atomic_fetch_add(hl + bucket, 1, __ATOMIC_RELAXED, __HIP_MEMORY_SCOPE_WORKGROUP);
                const int ti = tok - blk * 128; tb[ti] = bucket | (rank << 8); tg[2 * ti] = wlo; tg[2 * ti + 1] = whi;
            }
        }
        __syncthreads();
        if (F.tid < NBUCKET) { const int n = hl[F.tid]; hl[32 + F.tid] = n ? (int)__hip_atomic_fetch_add(cnt + F.tid, (unsigned)n, RLX_AGENT) : 0; }
        __syncthreads();
        if (F.tid < 128) { const int v = tb[F.tid], b = v & 0xff, pos = b * BCAP + hl[32 + b] + (v >> 8);
            F.TOKROW()[pos] = blk * 128 + F.tid; *(f32x2*)(F.GATEROW() + 2 * (size_t)pos) = (f32x2){tg[2 * F.tid], tg[2 * F.tid + 1]}; }
        __syncthreads();
    }
}
__device__ __forceinline__ void row_forget_phase(Frame& F, const RowSrc& RS) {
    LAS float* Wl = (LAS float*)(F.lds + RING_OFF);
    LAS float* wsum = (LAS float*)(F.lds + RING_OFF + 81920);
    { const f32x4* rw = (const f32x4*)F.WFG() + F.tid; f32x4 t[8];
#pragma unroll
      for (int i = 0; i < 8; ++i) t[i] = rw[i * NWAVES * 64];
#pragma unroll
      for (int i = 0; i < 8; ++i) ((LAS f32x4*)Wl)[F.tid + i * NWAVES * 64] = t[i]; }
    __syncthreads();
    const int h = F.lane >> 2, r = F.lane & 3; const float bfh = kin<I_BF>()[h];
    for (int blk = F.vcu; blk < NBLK; blk += F.G) {
        float bsum = 0.f;
        for (int pass = 0; pass < 4; ++pass) {
            asm volatile("" ::: "memory");
            const int row0 = blk * 128 + F.wave * 16 + pass * 4;
            f32x4 xv[4][4]; float inv[4];
            rows4_load_norm(F, RS, row0, xv, inv);
            float acc[80];
#pragma unroll
            for (int i = 0; i < 80; ++i) acc[i] = 0.f;
            rows4_dots<16>(Wl, F.lane, xv, acc);
            halve<64, 1>(acc, F.lane); halve<32, 2>(acc, F.lane); halve<16, 4>(acc, F.lane); halve<8, 8>(acc, F.lane); halve<4, 16>(acc, F.lane); halve<2, 32>(acc, F.lane);
            const float iv = r == 0 ? inv[0] : r == 1 ? inv[1] : r == 2 ? inv[2] : inv[3];
            const float z = acc[0] * iv + bfh;
            const float lf = fminf(z, 0.f) - log1pf(expf(-fabsf(z)));
            F.LF()[(size_t)(row0 + r) * 16 + h] = lf; bsum += lf;
        }
        bsum += pg8::xor_lane<1>(bsum); bsum += pg8::xor_lane<2>(bsum);
        if (r == 0) wsum[F.wave * 16 + h] = bsum;
        __syncthreads();
        if (F.tid < 16) { float s = 0.f;
#pragma unroll
            for (int w = 0; w < NWAVES; ++w) s += wsum[w * 16 + F.tid];
            F.BLKSUM()[blk * 16 + F.tid] = s; }
        __syncthreads();
    }
}
__device__ __forceinline__ void final_norm_phase(Frame& F, const RowSrc& RS, float* dst) {
    const int gw = F.vcu * NWAVES + F.wave, NGW = F.G * NWAVES;
    f32x4 g[4];
#pragma unroll
    for (int j = 0; j < 4; ++j) g[j] = ((const f32x4*)kin<I_FINN>())[F.lane + 64 * j];
    for (int m0 = gw * 4; m0 < MH; m0 += NGW * 4) {
        f32x4 v[4][4]; float inv[4];
#pragma unroll
        for (int r = 0; r < 4; ++r) row_load(RS, (size_t)(m0 + r), F.lane, v[r]);
#pragma unroll
        for (int r = 0; r < 4; ++r) { float s = 0.f;
#pragma unroll
            for (int j = 0; j < 4; ++j) s += (v[r][j].x * v[r][j].x + v[r][j].y * v[r][j].y) + (v[r][j].z * v[r][j].z + v[r][j].w * v[r][j].w);
            inv[r] = 1.0f / sqrtf(wave_sum(s) * (1.0f / D) + RMS_EPS); }
#pragma unroll
        for (int r = 0; r < 4; ++r)
#pragma unroll
            for (int j = 0; j < 4; ++j) __builtin_nontemporal_store(v[r][j] * inv[r] * g[j], (f32x4*)(dst + (size_t)(m0 + r) * D) + F.lane + 64 * j);
    }
}
__device__ __forceinline__ void build_tile_table(Frame& F, const unsigned* cnt) {
    LAS int* tbl = (LAS int*)(F.lds + TBL_OFF);
    LAS int* cn = (LAS int*)(F.lds + RING_OFF);
    if (F.tid < NBUCKET) cn[F.tid] = (int)__hip_atomic_load(cnt + F.tid, RLX_AGENT);
    __syncthreads();
    if (F.tid == 0) { int ntl = 0; for (int b = 0; b < NBUCKET; ++b) { cn[32 + b] = ntl; ntl += (cn[b] + 255) >> 8; } tbl[0] = ntl < MAXTILES ? ntl : MAXTILES; }
    __syncthreads();
    if (F.tid < NBUCKET) { const int b = F.tid, g = b / 6, p = b % 6, lo = p < 3 ? 0 : (p < 5 ? 1 : 2), hi = p < 3 ? p + 1 : (p < 5 ? p - 1 : 3), n = cn[b]; int t = cn[32 + b];
        for (int k = 0; k * 256 < n && t < MAXTILES; ++k, ++t) { tbl[1 + 3 * t] = (g * 4 + lo) | ((g * 4 + hi) << 8); tbl[2 + 3 * t] = (n - 256 * k) < 256 ? (n - 256 * k) : 256; tbl[3 + 3 * t] = b * BCAP + 256 * k; } }
    __syncthreads();
}
__device__ __forceinline__ void fscan_phase(Frame& F) {
    LAS float* bs = (LAS float*)(F.lds + RING_OFF);
    LAS float* sg = bs + 16;
    for (int blk = F.vcu; blk < NBLK; blk += F.G) {
        const int b = blk >> 6, first = b * 64, tid = F.tid;
        { LAS float* ps = sg + 128;
          for (int i = tid; i < 64 * 16; i += NWAVES * 64) { const int j = first + (i >> 4); ps[i] = j < blk ? F.BLKSUM()[j * 16 + (i & 15)] : 0.f; }
          __syncthreads();
          if (tid < 16) { float s = 0.f; for (int j = 0; j < 64; ++j) s += ps[j * 16 + tid]; bs[tid] = s; } }
        const int h = tid & 15, seg = tid >> 4;
        float v[16];
        if (tid < 128) { float s = 0.f;
#pragma unroll
            for (int k = 0; k < 16; ++k) { v[k] = F.LF()[(size_t)(blk * 128 + seg * 16 + k) * 16 + h]; s += v[k]; }
            sg[seg * 16 + h] = s; }
        __syncthreads();
        if (tid < 128) { float run = bs[h]; for (int s2 = 0; s2 < seg; ++s2) run += sg[s2 * 16 + h];
            float* fo = F.FM() + (size_t)(b * 16 + h) * T + (blk & 63) * 128 + seg * 16;
#pragma unroll
            for (int k = 0; k < 16; ++k) { run += v[k]; fo[k] = run; } }
        __syncthreads();
    }
}
struct Args { const float* in[20]; float* out; unsigned char* ws; };
__global__ void __launch_bounds__(NWAVES * 64, 2) yoco_fwd(Args args) {
    extern __shared__ __attribute__((aligned(16))) unsigned char lds[];
    Frame F;
    F.lds = (LAS unsigned char*)lds;
    F.MISC = (volatile LAS unsigned*)(F.lds + MISC_OFF);
    F.tid = threadIdx.x; F.lane = F.tid & 63; F.wave = __builtin_amdgcn_readfirstlane(F.tid >> 6);
    const int GA = gridDim.x, bx = blockIdx.x, li = bx >> 1;
    F.half = bx & 1; F.G = GA >> 1; F.vcu = (F.G % 4 == 0) ? (li % 4) * (F.G / 4) + li / 4 : li;
    unsigned char* ws = args.ws;
    F.ws = ws; F.out = args.out + (size_t)F.half * MH * D;
    gu32* const ctl = (gu32*)(ws + WS_CTL);
    { int t0 = threadIdx.x; asm volatile("" : "+v"(t0));
      for (int u = t0; u < (LDS_BYTES - LDSCTL_OFF) / 4; u += NWAVES * 64) ((LAS unsigned*)(F.lds + LDSCTL_OFF))[u] = 0u; }
    __syncthreads();
    const XcdBarrier barAll = xcd_barrier_post((unsigned*)(ctl + CW_BAR), F.MISC + 8, (unsigned)GA);
    const XcdBarrier bar = xcd_barrier_post((unsigned*)(ctl + CW_BARH) + F.half * XCD_BAR_WORDS, F.MISC + 12, (unsigned)F.G);
    unsigned* const cnt0 = (unsigned*)(ctl + CW_CNT + 64 * (2 * F.half)); unsigned* const cnt1 = cnt0 + 64;
    unsigned* const nq = (unsigned*)(ctl + CW_NRM) + F.half * 2048; unsigned* const nk = (unsigned*)(ctl + CW_NRM) + 4096 + F.half * 64;

#ifndef PH_MASK
#define PH_MASK 0x7fff
#endif
#define IN(k) ((PH_MASK >> (k)) & 1)
#define RETID() Frame Fq = F; { int t_ = threadIdx.x; asm volatile("" : "+v"(t_)); Fq.tid = t_; Fq.lane = t_ & 63; }
#define SEAM(k) do { xcd_barrier(bar); } while (0)
    PG8_LAS unsigned char* ring = F.lds + RING_OFF;

    if (IN(0)) { RETID();
        p0_convert(Fq, 0, CONV_EARLY, bx * NWAVES + Fq.wave, GA * NWAVES);
        p0_small(Fq, bx * (NWAVES * 64) + Fq.tid, GA * NWAVES * 64);
        xcd_barrier(barAll);
        if (Fq.half == 1) {
            p0_convert(Fq, CONV_EARLY, CONV_ALL, li * NWAVES + Fq.wave, Fq.G * NWAVES);
            asm volatile("s_waitcnt vmcnt(0)" ::: "memory"); __syncthreads();
            if (Fq.tid == 0) { __builtin_amdgcn_fence(__ATOMIC_RELEASE, "agent"); asm volatile("s_waitcnt vmcnt(0)" ::: "memory"); __hip_atomic_fetch_add((unsigned*)(ctl + CW_CONV), 1u, RLX_AGENT); }
        }
        p0_pool_diff(Fq);
#ifdef SKEW_TICKS
        if (Fq.half == 1) { const unsigned long long t0_ = __builtin_amdgcn_s_memrealtime(); while (__builtin_amdgcn_s_memrealtime() - t0_ < SKEW_TICKS) __builtin_amdgcn_s_sleep(10); }
#endif
    } SEAM(0);

    if (IN(1)) { RETID();
        pg8::StaticOrder S; S.init(MH, D, Fq.G, li, 4);
        pg8::AdRow ad{(const char*)Fq.XN(), (const char*)Fq.WPOOL(), D, 256, 256};
        pg8::EpiBf16 E{Fq.DPOOL(), D, 0, 0, 1.f, nullptr, nullptr};
        pg8::gemm_phase<pg8::EpiBf16, pg8::StaticOrder, pg8::AdRow, true>(ring, 4, S, E, ad);
    } SEAM(1);

    if (IN(2)) { RETID(); const RowSrc RS{Fq.X(), Fq.DPOOL(), nullptr, nullptr, nullptr}; row_router_phase(Fq, 0, RS, cnt0); } SEAM(2);
    if (IN(4)) { RETID();
        build_tile_table(Fq, cnt0);
        pg8::MoeOrder S{(const PG8_LAS int*)(Fq.lds + TBL_OFF), Fq.G, Fq.vcu};
        pg8::AdMoeUp ad{(const char*)Fq.XN(), Fq.TOKROW(), (const char*)Fq.WG(), (const char*)Fq.WU(), D, D};
        pg8::EpiMoeH E{Fq.HMID(), Fq.GATEROW()};
        pg8::gemm_phase<pg8::EpiMoeH, pg8::MoeOrder, pg8::AdMoeUp, true>(ring, 16, S, E, ad);
    } SEAM(4);
    if (F.half == 0) {
        if (F.tid == 0) { unsigned sp = 0; while (__hip_atomic_load((unsigned*)(ctl + CW_CONV), RLX_AGENT) < (unsigned)F.G) { __builtin_amdgcn_s_sleep(2); if (++sp > (1u << 22)) break; }
            __builtin_amdgcn_fence(__ATOMIC_ACQUIRE, "agent"); asm volatile("s_waitcnt vmcnt(0)" ::: "memory"); }
        __syncthreads();
    }
    if (IN(5)) { RETID();
        build_tile_table(Fq, cnt0);
        pg8::MoeOrder S{(const PG8_LAS int*)(Fq.lds + TBL_OFF), Fq.G, Fq.vcu};
        pg8::AdMoeDown ad{(const char*)Fq.HMID(), (const char*)Fq.WD(), 512, 256};
        pg8::EpiMoeOutBf16 E{Fq.Y0(), Fq.TOKROW(), Fq.TRASH()};
        pg8::gemm_phase<pg8::EpiMoeOutBf16, pg8::MoeOrder, pg8::AdMoeDown, true>(ring, 8, S, E, ad);
    } SEAM(5);

    if (IN(6)) { RETID(); const RowSrc RS{Fq.X(), Fq.DPOOL(), Fq.Y0(), nullptr, nullptr}; row_forget_phase(Fq, RS); } SEAM(6);
    if (IN(7)) { RETID();
        fscan_phase(Fq);
        pg8::StaticOrder S; S.init(MH, NQKV, Fq.G, li, 4);
        pg8::AdRow ad{(const char*)Fq.XN(), (const char*)Fq.WQKV(), D, D, 0};
        pg8::EpiBf16 E{Fq.QO(), D, D, (size_t)(WS_K - WS_QO) / 2, attn_body::C2, nq, nk};
        pg8::gemm_phase<pg8::EpiBf16, pg8::StaticOrder, pg8::AdRow, true>(ring, 16, S, E, ad);
    } SEAM(7);

    if (IN(8)) { RETID();
        static_assert(attn_body::ATTN_LDS_BYTES <= RING_BYTES && attn_body::ATTN_PITCH == D && attn_body::BATCH == BH, "attention body geometry vs frame");
        const attn_body::AttnTensors AT{(const attn_body::bf16*)Fq.QO(), (const attn_body::bf16*)Fq.KB(), (const attn_body::bf16*)Fq.VB(), (attn_body::bf16*)Fq.XN(), Fq.FM(), nq, nk};
        attn_body::attn_phase<>((char*)lds + RING_OFF, AT, (unsigned*)(ctl + CW_ATQ + 64 * Fq.half));
    } SEAM(8);

    if (IN(9)) { RETID();
        pg8::StaticOrder S; S.init(MH, D, Fq.G, li, 4);
        pg8::AdRow ad{(const char*)Fq.XN(), (const char*)Fq.WO(), D, D, 0};
        pg8::EpiBf16 E{Fq.DATT(), D, 0, 0, 1.f, nullptr, nullptr};
        pg8::gemm_phase<pg8::EpiBf16, pg8::StaticOrder, pg8::AdRow, true>(ring, 16, S, E, ad);
    } SEAM(9);

    if (IN(10)) { RETID(); const RowSrc RS{Fq.X(), Fq.DPOOL(), Fq.Y0(), Fq.DATT(), Fq.H3B()}; row_router_phase(Fq, 1, RS, cnt1); } SEAM(10);
    if (IN(12)) { RETID();
        build_tile_table(Fq, cnt1);
        pg8::MoeOrder S{(const PG8_LAS int*)(Fq.lds + TBL_OFF), Fq.G, Fq.vcu};
        pg8::AdMoeUp ad{(const char*)Fq.XN(), Fq.TOKROW(), (const char*)(Fq.WG() + (size_t)NEXP * DEXP * D), (const char*)(Fq.WU() + (size_t)NEXP * DEXP * D), D, D};
        pg8::EpiMoeH E{Fq.HMID(), Fq.GATEROW()};
        pg8::gemm_phase<pg8::EpiMoeH, pg8::MoeOrder, pg8::AdMoeUp, true>(ring, 16, S, E, ad);
    } SEAM(12);
    if (IN(13)) { RETID();
        build_tile_table(Fq, cnt1);
        pg8::MoeOrder S{(const PG8_LAS int*)(Fq.lds + TBL_OFF), Fq.G, Fq.vcu};
        pg8::AdMoeDown ad{(const char*)Fq.HMID(), (const char*)(Fq.WD() + (size_t)NEXP * DEXP * D), 512, 256};
        pg8::EpiMoeOutBf16 E{Fq.Y1(), Fq.TOKROW(), Fq.TRASH()};
        pg8::gemm_phase<pg8::EpiMoeOutBf16, pg8::MoeOrder, pg8::AdMoeDown, true>(ring, 8, S, E, ad);
    } SEAM(13);

    if (IN(14)) { RETID(); const RowSrc RS{nullptr, Fq.H3B(), Fq.Y1(), nullptr, nullptr}; final_norm_phase(Fq, RS, Fq.out); }
#undef IN
#undef SEAM
}

extern "C" void kernel_launch(void* const* d_in, const int* in_sizes, int n_in, void* d_out, int out_size, void* d_ws, size_t ws_size, hipStream_t stream) {
    static int grid = 0;
    if (grid == 0) {
        if (n_in != 20 || in_sizes[0] != M * D || out_size != M * D || ws_size < WS_END) { fprintf(stderr, "kernel_launch: unexpected shapes (n_in %d, in0 %d, out %d, ws %zu); nothing launched\n", n_in, n_in > 0 ? in_sizes[0] : -1, out_size, ws_size); grid = -1; return; }
        int dev = 0, cus = 0, per_cu = 0;
        if (hipGetDevice(&dev) != hipSuccess || hipDeviceGetAttribute(&cus, hipDeviceAttributeMultiprocessorCount, dev) != hipSuccess) { fprintf(stderr, "kernel_launch: hipGetDevice / hipDeviceGetAttribute failed\n"); grid = -1; return; }
        if (hipFuncSetAttribute((const void*)yoco_fwd, hipFuncAttributeMaxDynamicSharedMemorySize, LDS_BYTES) != hipSuccess) { fprintf(stderr, "kernel_launch: hipFuncSetAttribute failed\n"); grid = -1; return; }
        if (hipOccupancyMaxActiveBlocksPerMultiprocessor(&per_cu, (const void*)yoco_fwd, NWAVES * 64, LDS_BYTES) != hipSuccess || per_cu < 1)
            fprintf(stderr, "kernel_launch: note: occupancy query reports %d workgroups per CU\n", per_cu);
        (void)hipGetLastError();
        grid = cus & ~1;
    }
    if (grid < 0) return;
    if (hipMemsetAsync((char*)d_ws + WS_CTL, 0, CTL_ZERO_BYTES, stream) != hipSuccess) { fprintf(stderr, "kernel_launch: hipMemsetAsync failed\n"); return; }
    Args a{};
    for (int i = 0; i < 20; ++i) a.in[i] = (const float*)d_in[i];
    a.out = (float*)d_out; a.ws = (unsigned char*)d_ws;
    hipLaunchKernelGGL(yoco_fwd, dim3(grid), dim3(NWAVES * 64), LDS_BYTES, stream, a);
    const hipError_t le = hipPeekAtLastError();
    if (le != hipSuccess) fprintf(stderr, "kernel_launch: launch failed: %s\n", hipGetErrorName(le));
}
```
